# Optimizing an MI355X kernel written in HIP

```python
import jax, jax.numpy as jnp
from jax import lax
import numpy as np

D_MODEL = 1024
BATCH = 16
SEQ = 256
DEPTH = 2
DEC_BATCH = 2
DEC_SEQ = 2048
PAST_LEN = 256

GRID_W = 64
MLA_HEADS = 6
MLA_Q_RANK = 384
MLA_KV_RANK = 256
MLA_NOPE_DIM = 64
MLA_ROPE_DIM = 32
MLA_V_DIM = 64
MLA_QK_DIM = MLA_NOPE_DIM + MLA_ROPE_DIM
MLA_WIDTH = MLA_HEADS * MLA_V_DIM
FNET_GROUPS = 4
FNET_GROUP_DIM = 64
FNET_WIDTH = FNET_GROUPS * FNET_GROUP_DIM
GQA_HEADS = 6
GQA_KV_HEADS = 2
GQA_HEAD_DIM = 64
GQA_GROUP = GQA_HEADS // GQA_KV_HEADS
GQA_WIDTH = GQA_HEADS * GQA_HEAD_DIM
MIX_WIDTH = MLA_WIDTH + FNET_WIDTH + GQA_WIDTH
IN_SIZES = (MLA_Q_RANK, MLA_KV_RANK, MLA_ROPE_DIM, FNET_WIDTH,
            GQA_WIDTH, GQA_KV_HEADS * GQA_HEAD_DIM, GQA_KV_HEADS * GQA_HEAD_DIM)
IN_WIDTH = sum(IN_SIZES)
D_FF = -(-8 * D_MODEL // (3 * 256)) * 256
ROPE_THETA = 10000.0
EPS = 1e-6
Q_BLOCK = 128

kernel_name = "hybrid_mla_fnet_gqa_diffusion_step"


def rms_norm(x, g):
    xf = x.astype(jnp.float32)
    y = xf * lax.rsqrt(jnp.mean(xf * xf, axis=-1, keepdims=True) + EPS)
    return (y * g.astype(jnp.float32)).astype(x.dtype)


def grid_angles(n_tokens, rot_dim):
    rows = n_tokens // GRID_W
    row = jnp.repeat(jnp.arange(rows, dtype=jnp.float32), GRID_W)
    col = jnp.tile(jnp.arange(GRID_W, dtype=jnp.float32), rows)
    n_axis = rot_dim // 4
    inv = ROPE_THETA ** (-jnp.arange(n_axis, dtype=jnp.float32) / n_axis)
    return jnp.concatenate([row[:, None] * inv, col[:, None] * inv], axis=-1)


def apply_rope(x, ang):
    half = x.shape[-1] // 2
    cos = jnp.cos(ang)[None, :, None, :]
    sin = jnp.sin(ang)[None, :, None, :]
    x1 = x[..., :half].astype(jnp.float32)
    x2 = x[..., half:].astype(jnp.float32)
    return jnp.concatenate([x1 * cos - x2 * sin, x2 * cos + x1 * sin], axis=-1).astype(x.dtype)


def block_attention(q, k, v, scale):
    b, sq = q.shape[:2]
    nb = sq // Q_BLOCK
    qb = q.reshape((b, nb, Q_BLOCK) + q.shape[2:]).swapaxes(0, 1)

    def one_block(qi):
        s = jnp.einsum('bqhgd,bkhd->bhgqk', qi, k, preferred_element_type=jnp.float32) * scale
        p = jax.nn.softmax(s, axis=-1)
        return jnp.einsum('bhgqk,bkhe->bqhge', p.astype(v.dtype), v)

    out = lax.map(one_block, qb)
    return out.swapaxes(0, 1).reshape((b, sq) + out.shape[3:])


def token_mixers(h, w_in, g_q_a, w_q_up, g_kv_a, w_kv_up, g_q_head, g_k_head, w_out, ctx):
    b, s, _ = h.shape
    proj = h @ w_in
    offs = [int(o) for o in np.cumsum(IN_SIZES)[:-1]]
    cq, ckv, krope, u, gq, gk, gv = jnp.split(proj, offs, axis=-1)

    q_mla = (rms_norm(cq, g_q_a) @ w_q_up).reshape(b, s, MLA_HEADS, MLA_QK_DIM)
    q_nope, q_rope = q_mla[..., :MLA_NOPE_DIM], q_mla[..., MLA_NOPE_DIM:]
    ckv = rms_norm(ckv, g_kv_a)
    krope = krope[:, :, None, :]
    gq = rms_norm(gq.reshape(b, s, GQA_HEADS, GQA_HEAD_DIM), g_q_head)
    gk = rms_norm(gk.reshape(b, s, GQA_KV_HEADS, GQA_HEAD_DIM), g_k_head)
    gv = gv.reshape(b, s, GQA_KV_HEADS, GQA_HEAD_DIM)

    if ctx is None:
        new_ctx = (ckv, krope[:, :, 0, :], gk, gv)
        ckv_all, krope_all, gk_all, gv_all = ckv, krope, gk, gv
    else:
        new_ctx = None
        ang_mla = grid_angles(s, MLA_ROPE_DIM)
        ang_gqa = grid_angles(s, GQA_HEAD_DIM)
        q_rope = apply_rope(q_rope, ang_mla)
        krope_l = apply_rope(krope, ang_mla)
        gq = apply_rope(gq, ang_gqa)
        gk_l = apply_rope(gk, ang_gqa)
        c_ckv, c_krope, c_gk, c_gv = ctx
        ckv_all = jnp.concatenate([c_ckv.astype(ckv.dtype), ckv], axis=1)
        krope_all = jnp.concatenate([c_krope[:, :, None, :].astype(krope.dtype), krope_l], axis=1)
        gk_all = jnp.concatenate([c_gk.astype(gk.dtype), gk_l], axis=1)
        gv_all = jnp.concatenate([c_gv.astype(gv.dtype), gv], axis=1)

    sk = ckv_all.shape[1]
    kv = (ckv_all @ w_kv_up).reshape(b, sk, MLA_HEADS, MLA_NOPE_DIM + MLA_V_DIM)
    k_nope, v_mla = kv[..., :MLA_NOPE_DIM], kv[..., MLA_NOPE_DIM:]
    k_mla = jnp.concatenate(
        [k_nope, jnp.broadcast_to(krope_all, (b, sk, MLA_HEADS, MLA_ROPE_DIM))], axis=-1)
    q_full = jnp.concatenate([q_nope, q_rope], axis=-1)[:, :, :, None, :]
    mla_out = block_attention(q_full, k_mla, v_mla, MLA_QK_DIM ** -0.5).reshape(b, s, MLA_WIDTH)

    uf = u.reshape(b, s, FNET_GROUPS, FNET_GROUP_DIM).astype(jnp.float32)
    fnet_out = jnp.fft.fft2(uf, axes=(1, 3), norm='ortho').real.astype(h.dtype).reshape(b, s, FNET_WIDTH)

    gq5 = gq.reshape(b, s, GQA_KV_HEADS, GQA_GROUP, GQA_HEAD_DIM)
    gqa_out = block_attention(gq5, gk_all, gv_all, GQA_HEAD_DIM ** -0.5).reshape(b, s, GQA_WIDTH)

    out = jnp.concatenate([mla_out, fnet_out, gqa_out], axis=-1) @ w_out
    return out, new_ctx


def trunk_layer(x, mod, g1, g2, w_in, g_q_a, w_q_up, g_kv_a, w_kv_up, g_q_head, g_k_head,
                w_out, w_gate, w_up, w_down, ctx):
    shift1, scale1, gate1, shift2, scale2, gate2 = jnp.split(mod.astype(x.dtype), 6, axis=-1)
    h = rms_norm(x, g1) * (1 + scale1) + shift1
    mix, new_ctx = token_mixers(h, w_in, g_q_a, w_q_up, g_kv_a, w_kv_up, g_q_head, g_k_head,
                                w_out, ctx)
    x = x + gate1 * mix
    h = rms_norm(x, g2) * (1 + scale2) + shift2
    x = x + gate2 * ((jax.nn.silu(h @ w_gate) * (h @ w_up)) @ w_down)
    return x, new_ctx


def setup_inputs(seed: int = 0) -> dict:
    key = jax.random.key(seed)
    ks = jax.random.split(key, 26)

    def nrm(k, shape, scale):
        return jax.random.normal(k, shape, jnp.float32) * scale

    def gain(k, shape):
        return 1.0 + 0.05 * jax.random.normal(k, shape, jnp.float32)

    return {
        "x_prompt": nrm(ks[0], (BATCH, SEQ, D_MODEL), 1.0),
        "x_sample": nrm(ks[1], (DEC_BATCH, DEC_SEQ, D_MODEL), 1.0),
        "cache_mla_ckv": nrm(ks[2], (DEC_BATCH, DEPTH, PAST_LEN, MLA_KV_RANK), 1.0),
        "cache_mla_krope": nrm(ks[3], (DEC_BATCH, DEPTH, PAST_LEN, MLA_ROPE_DIM), 1.0),
        "cache_gqa_k": nrm(ks[4], (DEC_BATCH, DEPTH, PAST_LEN, GQA_KV_HEADS, GQA_HEAD_DIM), 1.0),
        "cache_gqa_v": nrm(ks[5], (DEC_BATCH, DEPTH, PAST_LEN, GQA_KV_HEADS, GQA_HEAD_DIM), 1.0),
        "c": nrm(ks[6], (DEC_BATCH, D_MODEL), 1.0),
        "c_ctx": nrm(ks[7], (D_MODEL,), 1.0),
        "w_ada": nrm(ks[8], (DEPTH, D_MODEL, 6 * D_MODEL), 0.5 * D_MODEL ** -0.5),
        "b_ada": nrm(ks[9], (DEPTH, 6 * D_MODEL), 0.01),
        "g_norm1": gain(ks[10], (DEPTH, D_MODEL)),
        "g_norm2": gain(ks[11], (DEPTH, D_MODEL)),
        "w_in": nrm(ks[12], (DEPTH, D_MODEL, IN_WIDTH), D_MODEL ** -0.5),
        "g_q_a": gain(ks[13], (DEPTH, MLA_Q_RANK)),
        "w_q_up": nrm(ks[14], (DEPTH, MLA_Q_RANK, MLA_HEADS * MLA_QK_DIM), MLA_Q_RANK ** -0.5),
        "g_kv_a": gain(ks[15], (DEPTH, MLA_KV_RANK)),
        "w_kv_up": nrm(ks[16], (DEPTH, MLA_KV_RANK, MLA_HEADS * (MLA_NOPE_DIM + MLA_V_DIM)),
                       MLA_KV_RANK ** -0.5),
        "g_q_head": gain(ks[17], (DEPTH, GQA_HEAD_DIM)),
        "g_k_head": gain(ks[18], (DEPTH, GQA_HEAD_DIM)),
        "w_out": nrm(ks[19], (DEPTH, MIX_WIDTH, D_MODEL), MIX_WIDTH ** -0.5),
        "w_ffn_gate": nrm(ks[20], (DEPTH, D_MODEL, D_FF), D_MODEL ** -0.5),
        "w_ffn_up": nrm(ks[21], (DEPTH, D_MODEL, D_FF), D_MODEL ** -0.5),
        "w_ffn_down": nrm(ks[22], (DEPTH, D_FF, D_MODEL), D_FF ** -0.5),
        "g_final": gain(ks[23], (D_MODEL,)),
    }


def reference(x_prompt, x_sample, cache_mla_ckv, cache_mla_krope, cache_gqa_k, cache_gqa_v,
              c, c_ctx, w_ada, b_ada, g_norm1, g_norm2, w_in, g_q_a, w_q_up, g_kv_a, w_kv_up,
              g_q_head, g_k_head, w_out, w_ffn_gate, w_ffn_up, w_ffn_down, g_final):
    xp, xs = x_prompt, x_sample
    silu_ctx = jax.nn.silu(c_ctx)
    silu_c = jax.nn.silu(c)
    ckv_list, krope_list, gk_list, gv_list = [], [], [], []
    for l in range(DEPTH):
        w_l = (g_norm1[l], g_norm2[l], w_in[l], g_q_a[l], w_q_up[l], g_kv_a[l], w_kv_up[l],
               g_q_head[l], g_k_head[l], w_out[l], w_ffn_gate[l], w_ffn_up[l], w_ffn_down[l])
        mod_ctx = (silu_ctx @ w_ada[l] + b_ada[l])[None, None, :]
        xp, (ckv, krope, gk, gv) = trunk_layer(xp, mod_ctx, *w_l, None)
        ckv_list.append(ckv)
        krope_list.append(krope)
        gk_list.append(gk)
        gv_list.append(gv)
        mod_lat = (silu_c @ w_ada[l] + b_ada[l])[:, None, :]
        ctx_l = (cache_mla_ckv[:, l], cache_mla_krope[:, l], cache_gqa_k[:, l], cache_gqa_v[:, l])
        xs, _ = trunk_layer(xs, mod_lat, *w_l, ctx_l)
    y_prompt = rms_norm(xp, g_final)
    y_sample = rms_norm(xs, g_final)
    new_mla_ckv = jnp.stack(ckv_list, axis=1)
    new_mla_krope = jnp.stack(krope_list, axis=1)
    new_gqa_k = jnp.stack(gk_list, axis=1)
    new_gqa_v = jnp.stack(gv_list, axis=1)
    return (y_prompt, y_sample, new_mla_ckv, new_mla_krope, new_gqa_k, new_gqa_v)
```

```cpp
#include <hip/hip_runtime.h>
#include <hip/hip_cooperative_groups.h>
#include <stdint.h>
#include <stdio.h>
namespace cg = cooperative_groups;

#ifndef MULTI_LAUNCH
#define MULTI_LAUNCH 1
#endif

typedef unsigned short bf16_t;
typedef short bf16x8 __attribute__((ext_vector_type(8)));
typedef short s16x4 __attribute__((ext_vector_type(4)));
typedef float f32x16 __attribute__((ext_vector_type(16)));
typedef float f32x4 __attribute__((ext_vector_type(4)));
typedef float f32x2 __attribute__((ext_vector_type(2)));
typedef unsigned u32x4 __attribute__((ext_vector_type(4)));
typedef unsigned u32x2 __attribute__((ext_vector_type(2)));
#define DI __device__ __forceinline__
#define LAS __attribute__((address_space(3)))

constexpr int D = 1024, NTOK = 8192, NCTX = 4096, DFF = 2816;
constexpr int NINP = 1664;
constexpr float EPS = 1e-6f;
constexpr float LOG2E = 1.4426950408889634f;
constexpr size_t OFF_YP = 0, OFF_YS = 4194304, OFF_CKV = 8388608, OFF_KROPE = 10485760, OFF_GK = 10747904, OFF_GV = 11796480;
constexpr size_t SZ_WIN = (size_t)NINP * 1024, SZ_QUP = 640 * 384, SZ_KV = 768 * 256, SZ_WOUT = 1024 * 1024, SZ_GU = (size_t)5632 * 1024, SZ_DOWN = (size_t)1024 * 2816;

struct P {
    const float *x_prompt, *x_sample, *c_ckv, *c_krope, *c_gk, *c_gv, *c, *c_ctx, *w_ada, *b_ada, *g_norm1, *g_norm2, *w_in, *g_q_a, *w_q_up, *g_kv_a,
        *w_kv_up, *g_q_head, *g_k_head, *w_out, *w_gate, *w_up, *w_down, *g_final;
    float* out;
    unsigned* bar;
    unsigned* ctr;
    float* mod;
    bf16_t *wt_in, *wt_qup, *wt_kvg, *wt_kvp, *wt_out, *wt_gu, *wt_down;
    bf16_t *tab2048, *tab256, *bt_ch;
    f32x2 *rope_g, *rope_m;
    bf16_t* ckv_cache;
    bf16_t *h, *cq, *ckv, *u, *gq, *qmla, *mix, *hid;
    float *ssq_q, *ssq_kv;
    float *xa, *xb;
    bf16_t *kmla_ctx, *vtmla_ctx, *kgqa_ctx, *vtgqa_ctx;
    bf16_t *kmla_den, *vtmla_den, *kgqa_den, *vtgqa_den;
    bf16_t *zt_ctx, *zt_den;
    int never, ph0, ph1, pad;
};

typedef const volatile __attribute__((address_space(4))) P& KPR;
typedef const volatile __attribute__((address_space(4))) P* KP;
typedef __bf16 nbf16x2 __attribute__((ext_vector_type(2)));
DI unsigned pk_bf16(float lo, float hi) { f32x2 v = {lo, hi}; nbf16x2 b = __builtin_convertvector(v, nbf16x2); return __builtin_bit_cast(unsigned, b); }
DI bf16_t to_bf16(float x) { return (bf16_t)(pk_bf16(x, 0.f) & 0xffffu); }
DI int crow(int e, int h) { return (e & 3) + 8 * (e >> 2) + 4 * h; }
DI float silu(float x) { return x / (1.f + __expf(-x)); }
#define MFMA(a, b, c) __builtin_amdgcn_mfma_f32_32x32x16_bf16((a), (b), (c), 0, 0, 0)

#define XB_TMO 128
#define XB_XCNT(j) (256 + 64 * (j))
#define XB_XSUB(j) (1280 + 64 * (j))
#define XB_XGEN(j) (2304 + 64 * (j))
#define XB_TOP 3328
#define XB_TOPGEN 3392
#define XCD_BAR_WORDS 3456
#define XB_SPIN_CAP (1u << 20)
DI unsigned xb_ld(unsigned* p) { return __hip_atomic_load(p, __ATOMIC_RELAXED, __HIP_MEMORY_SCOPE_AGENT); }
DI unsigned xb_add(unsigned* p, unsigned v) { return __hip_atomic_fetch_add(p, v, __ATOMIC_RELAXED, __HIP_MEMORY_SCOPE_AGENT); }
DI unsigned xb_xcc_id() { return (unsigned)__builtin_amdgcn_s_getreg((3 << 11) | 20) & 0xFu; }
#define XB_SPIN(cond, bar)                                                                         \
    do {                                                                                           \
        unsigned _sp = 0;                                                                          \
        while (cond) {                                                                             \
            __builtin_amdgcn_s_sleep(1);                                                           \
            if ((++_sp & 255u) == 0u) {                                                            \
                if (xb_ld(&(bar)[XB_TMO])) break;                                                  \
                if (_sp > XB_SPIN_CAP) { atomicAdd(&(bar)[XB_TMO], 1u); break; }                   \
            }                                                                                      \
        }                                                                                          \
    } while (0)
struct XcdBarrier { unsigned* bar; unsigned x; volatile LAS unsigned* st; };
DI XcdBarrier xcd_barrier_post(unsigned* bar, volatile LAS unsigned* st) {
    XcdBarrier b; b.bar = bar; b.x = xb_xcc_id(); b.st = st;
    if (threadIdx.x == 0) (void)xb_add(&bar[XB_XCNT(b.x)], 1u);
    return b;
}
DI void xcd_barrier_complete(unsigned* bar, unsigned x, unsigned& nloc, unsigned& nx) {
    const unsigned G = gridDim.x * gridDim.y * gridDim.z;
    unsigned sum, cnt, mine, sp = 0u;
    for (;;) {
        sum = 0u; cnt = 0u; mine = 0u;
#pragma unroll
        for (unsigned j = 0; j < 16; ++j) { const unsigned c = xb_ld(&bar[XB_XCNT(j)]); sum += c; cnt += (c > 0u) ? 1u : 0u; mine = (j == x) ? c : mine; }
        if (sum == G) break;
        __builtin_amdgcn_s_sleep(1);
        if ((++sp & 255u) == 0u) { if (xb_ld(&bar[XB_TMO])) break; if (sp > XB_SPIN_CAP) { atomicAdd(&bar[XB_TMO], 1u); break; } }
    }
    nloc = mine > 0u ? mine : 1u; nx = cnt > 0u ? cnt : 1u;
}
DI void xcd_barrier(const XcdBarrier& b) {
    asm volatile("s_waitcnt vmcnt(0)" ::: "memory");
    __syncthreads();
    if (threadIdx.x == 0) {
        unsigned* bar = b.bar;
        __builtin_amdgcn_s_waitcnt(0);
        unsigned nloc = b.st[0], nx = b.st[1];
        if (nloc == 0u) { xcd_barrier_complete(bar, b.x, nloc, nx); b.st[0] = nloc; b.st[1] = nx; }
        const unsigned old = xb_add(&bar[XB_XSUB(b.x)], 1u);
        const unsigned gen = old / nloc;
        if (old + 1u == (gen + 1u) * nloc) {
            __builtin_amdgcn_fence(__ATOMIC_RELEASE, "agent");
            asm volatile("s_waitcnt vmcnt(0)" ::: "memory");
            const unsigned og = xb_add(&bar[XB_TOP], 1u);
            const unsigned tg = og / nx;
            if (og + 1u == (tg + 1u) * nx) xb_add(&bar[XB_TOPGEN], 1u);
            else XB_SPIN(xb_ld(&bar[XB_TOPGEN]) == tg, bar);
            __builtin_amdgcn_fence(__ATOMIC_ACQUIRE, "agent");
            xb_add(&bar[XB_XGEN(b.x)], 1u);
            asm volatile("s_waitcnt vmcnt(0)" ::: "memory");
        } else {
            XB_SPIN(xb_ld(&bar[XB_XGEN(b.x)]) == gen, bar);
            __builtin_amdgcn_fence(__ATOMIC_ACQUIRE, "agent");
            asm volatile("s_waitcnt vmcnt(0)" ::: "memory");
        }
    }
    __syncthreads();
}

DI void gemm_tile(const bf16_t* __restrict__ A, int lda, const bf16_t* __restrict__ B, int ldb, int K, char* lds, f32x16 (&acc)[2][2]) {
    const int tid = threadIdx.x, lane = tid & 63, wid = tid >> 6, wr = wid >> 1, wc = wid & 1, r = lane & 31, h = lane >> 5;
#pragma unroll
    for (int i = 0; i < 2; ++i)
#pragma unroll
        for (int j = 0; j < 2; ++j)
#pragma unroll
            for (int e = 0; e < 16; ++e) acc[i][j][e] = 0.f;
    const int lrow = tid >> 3, lkc = tid & 7;
    const bf16_t* ga = A + (size_t)lrow * lda + lkc * 8;
    const bf16_t* gb = B + (size_t)lrow * ldb + lkc * 8;
    const int wofs = lrow * 128 + ((lkc ^ ((lrow >> 1) & 7)) << 4);
    const int swz = (r >> 1) & 7;
    const int aofs = (wr * 64 + r) * 128, bofs = 16384 + (wc * 64 + r) * 128;
    u32x4 ra[4], rb[4];
#pragma unroll
    for (int i = 0; i < 4; ++i) { ra[i] = *(const u32x4*)(ga + (size_t)i * 32 * lda); rb[i] = *(const u32x4*)(gb + (size_t)i * 32 * ldb); }
#pragma unroll
    for (int i = 0; i < 4; ++i) { *(u32x4*)(lds + wofs + i * 4096) = ra[i]; *(u32x4*)(lds + 16384 + wofs + i * 4096) = rb[i]; }
    __syncthreads();
    const int nt = K >> 6;
    for (int t = 0; t < nt; ++t) {
        const int cur = (t & 1) * 32768, nxt = 32768 - cur;
        if (t + 1 < nt) {
            const int k0 = (t + 1) << 6;
#pragma unroll
            for (int i = 0; i < 4; ++i) { ra[i] = *(const u32x4*)(ga + (size_t)i * 32 * lda + k0); rb[i] = *(const u32x4*)(gb + (size_t)i * 32 * ldb + k0); }
        }
#pragma unroll
        for (int ks = 0; ks < 4; ++ks) {
            const int co = ((ks * 2 + h) ^ swz) << 4;
            bf16x8 a0 = *(const bf16x8*)(lds + cur + aofs + co);
            bf16x8 a1 = *(const bf16x8*)(lds + cur + aofs + 4096 + co);
            bf16x8 b0 = *(const bf16x8*)(lds + cur + bofs + co);
            bf16x8 b1 = *(const bf16x8*)(lds + cur + bofs + 4096 + co);
            acc[0][0] = MFMA(b0, a0, acc[0][0]);
            acc[0][1] = MFMA(b1, a0, acc[0][1]);
            acc[1][0] = MFMA(b0, a1, acc[1][0]);
            acc[1][1] = MFMA(b1, a1, acc[1][1]);
        }
        if (t + 1 < nt) {
#pragma unroll
            for (int i = 0; i < 4; ++i) { *(u32x4*)(lds + nxt + wofs + i * 4096) = ra[i]; *(u32x4*)(lds + nxt + 16384 + wofs + i * 4096) = rb[i]; }
        }
        __syncthreads();
    }
}

DI void st_bf16_tile(bf16_t* dst, const f32x16& v, int h) {
#pragma unroll
    for (int q = 0; q < 4; ++q) {
        u32x2 w; w.x = pk_bf16(v[4 * q], v[4 * q + 1]); w.y = pk_bf16(v[4 * q + 2], v[4 * q + 3]);
        *(u32x2*)(dst + 8 * q + 4 * h) = w;
    }
}
DI void st_f32_tile(float* dst, const f32x16& v, int h) {
#pragma unroll
    for (int q = 0; q < 4; ++q) { f32x4 w = {v[4 * q], v[4 * q + 1], v[4 * q + 2], v[4 * q + 3]}; *(f32x4*)(dst + 8 * q + 4 * h) = w; }
}
DI void st_bf16_tile_T(bf16_t* dst, size_t ld, const f32x16& v, int h) {
#pragma unroll
    for (int e = 0; e < 16; ++e) dst[(size_t)crow(e, h) * ld] = to_bf16(v[e]);
}
DI float sumsq16(const f32x16& v) { float s = 0.f;
#pragma unroll
    for (int e = 0; e < 16; ++e) s += v[e] * v[e];
    return s; }

DI const float* win_src(const float* w, int nd) {
    int sc;
    if (nd < 640) sc = nd; else if (nd < 1024) sc = 928 + (nd - 640); else if (nd < 1152) sc = 1312 + (nd - 1024); else if (nd < 1280) sc = 1440 + (nd - 1152);
    else if (nd < 1536) sc = 672 + (nd - 1280); else if (nd < 1568) sc = 640 + (nd - 1536); else return nullptr;
    return w + sc;
}
DI void tr_tile(const float* colp, int nsrc, bf16_t* dst, int K, int k0, int nd0, const float* kscale, float* tile) {
    const int tid = threadIdx.x, tn = tid & 63, tk = tid >> 6;
#pragma unroll 4
    for (int kk = tk; kk < 64; kk += 4) {
        float v = colp ? colp[(size_t)(k0 + kk) * nsrc] : 0.f;
        if (kscale) v *= kscale[k0 + kk];
        tile[kk * 65 + tn] = v;
    }
    __syncthreads();
    const int rr = tid >> 2, kq = tid & 3;
    u32x4 o0, o1;
    const float* tp = tile + (kq * 16) * 65 + rr;
    o0.x = pk_bf16(tp[0 * 65], tp[1 * 65]); o0.y = pk_bf16(tp[2 * 65], tp[3 * 65]); o0.z = pk_bf16(tp[4 * 65], tp[5 * 65]); o0.w = pk_bf16(tp[6 * 65], tp[7 * 65]);
    o1.x = pk_bf16(tp[8 * 65], tp[9 * 65]); o1.y = pk_bf16(tp[10 * 65], tp[11 * 65]); o1.z = pk_bf16(tp[12 * 65], tp[13 * 65]); o1.w = pk_bf16(tp[14 * 65], tp[15 * 65]);
    bf16_t* d = dst + (size_t)(nd0 + rr) * K + k0 + kq * 16;
    *(u32x4*)d = o0; *(u32x4*)(d + 8) = o1;
    __syncthreads();
}

DI void phase_prologue(KPR p, char* lds) {
    const int tid = threadIdx.x, bid = blockIdx.x, G = gridDim.x;
    float* tile = (float*)lds;
    for (int task = bid; task < 768; task += G) {
        const int l = task / 384, rem = task % 384, kc = rem / 24, cb = rem % 24;
        if (tid < 192) { const int j = tid >> 6, k = kc * 64 + (tid & 63); const float cv = (j == 0) ? p.c_ctx[k] : p.c[(j - 1) * 1024 + k]; tile[tid] = silu(cv); }
        __syncthreads();
        const int n = cb * 256 + tid;
        const float* w = p.w_ada + ((size_t)l * 1024 + kc * 64) * 6144 + n;
        float s0 = 0.f, s1 = 0.f, s2 = 0.f;
#pragma unroll 8
        for (int k = 0; k < 64; ++k) { const float wv = w[(size_t)k * 6144]; s0 += tile[k] * wv; s1 += tile[64 + k] * wv; s2 += tile[128 + k] * wv; }
        if (kc == 0) { const float bv = p.b_ada[l * 6144 + n]; s0 += bv; s1 += bv; s2 += bv; }
        float* m = p.mod + (size_t)l * 3 * 6144 + n;
        atomicAdd(m, s0); atomicAdd(m + 6144, s1); atomicAdd(m + 2 * 6144, s2);
        __syncthreads();
    }
    for (int tt = bid; tt < 2 * 2940; tt += G) {
        const int l = tt / 2940; int t = tt % 2940;
        const int tn = tid & 63;
        if (t < 416) { const int kt = t / 26, nt = t % 26; const float* w = p.w_in + (size_t)l * 1024 * 1568;
            tr_tile(win_src(w, nt * 64 + tn), 1568, p.wt_in + l * SZ_WIN, 1024, kt * 64, nt * 64, nullptr, tile); continue; }
        t -= 416;
        if (t < 60) { const int kt = t / 10, nt = t % 10; const float* w = p.w_q_up + (size_t)l * 384 * 576; const int nd = nt * 64 + tn;
            tr_tile(nd < 576 ? w + nd : nullptr, 576, p.wt_qup + l * SZ_QUP, 384, kt * 64, nt * 64, p.g_q_a + l * 384, tile); continue; }
        t -= 60;
        if (t < 96) { const int var = t / 48; t %= 48; const int kt = t / 12, nt = t % 12; const float* w = p.w_kv_up + (size_t)l * 256 * 768;
            tr_tile(w + nt * 64 + tn, 768, (var ? p.wt_kvp : p.wt_kvg) + l * SZ_KV, 256, kt * 64, nt * 64, var ? nullptr : p.g_kv_a + l * 256, tile); continue; }
        t -= 96;
        if (t < 256) { const int kt = t / 16, nt = t % 16; const float* w = p.w_out + (size_t)l * 1024 * 1024;
            tr_tile(w + nt * 64 + tn, 1024, p.wt_out + l * SZ_WOUT, 1024, kt * 64, nt * 64, nullptr, tile); continue; }
        t -= 256;
        if (t < 1408) { const int kt = t / 88, nt = t % 88; const float* w = (tn < 32 ? p.w_gate : p.w_up) + (size_t)l * 1024 * 2816 + nt * 32 + (tn & 31);
            tr_tile(w, 2816, p.wt_gu + l * SZ_GU, 1024, kt * 64, nt * 64, nullptr, tile); continue; }
        t -= 1408;
        { const int kt = t / 16, nt = t % 16; const float* w = p.w_down + (size_t)l * 2816 * 1024;
            tr_tile(w + nt * 64 + tn, 1024, p.wt_down + l * SZ_DOWN, 2816, kt * 64, nt * 64, nullptr, tile); }
    }
    const int gt = bid * 256 + tid, GT = G * 256;
    for (int i = gt; i < 2048 * 512; i += GT) {
        const int pp = i >> 9, k8 = (i & 511) * 8; u32x4 o; unsigned w[4];
#pragma unroll
        for (int e = 0; e < 4; ++e) { float v[2];
#pragma unroll
            for (int z = 0; z < 2; ++z) { const int kq = k8 + 2 * e + z; const int m = (pp * (kq & 2047)) & 2047; const float a = (float)m * (1.f / 1024.f);
                v[z] = (kq < 2048 ? cospif(a) : -sinpif(a)) * 0.022097086912079608f; }
            w[e] = pk_bf16(v[0], v[1]); }
        o.x = w[0]; o.y = w[1]; o.z = w[2]; o.w = w[3];
        *(u32x4*)(p.tab2048 + (size_t)pp * 4096 + k8) = o;
    }
    for (int i = gt; i < 256 * 512; i += GT) { const int pp = i >> 9, kq = i & 511; const int m = (pp * (kq & 255)) & 255; const float a = (float)m * (1.f / 128.f);
        p.tab256[i] = to_bf16((kq < 256 ? cospif(a) : -sinpif(a)) * 0.0625f); }
    for (int i = gt; i < 128 * 64; i += GT) { const int n = i >> 6, k = i & 63; const int m = ((n & 63) * k) & 63; const float a = (float)m * (1.f / 32.f);
        p.bt_ch[i] = to_bf16((n < 64 ? cospif(a) : sinpif(a)) * 0.125f); }
    for (int i = gt; i < 2048 * 32; i += GT) { const int t = i >> 5, pr = i & 31; const float inv = powf(10000.f, -(float)(pr & 15) * (1.f / 16.f));
        const float pos = (float)(pr < 16 ? (t >> 6) : (t & 63)); const float ang = pos * inv; f32x2 cs = {cosf(ang), sinf(ang)}; p.rope_g[i] = cs; }
    for (int i = gt; i < 2048 * 16; i += GT) { const int t = i >> 4, pr = i & 15; const float inv = powf(10000.f, -(float)(pr & 7) * (1.f / 8.f));
        const float pos = (float)(pr < 8 ? (t >> 6) : (t & 63)); const float ang = pos * inv; f32x2 cs = {cosf(ang), sinf(ang)}; p.rope_m[i] = cs; }
    for (int i = gt; i < 2 * 2 * 256 * 256; i += GT) p.ckv_cache[i] = to_bf16(p.c_ckv[i]);
    for (int i = gt; i < 2 * 2 * 256 * 32; i += GT) {
        const int d = i & 31, s = (i >> 5) & 255, l = (i >> 13) & 1, b = i >> 14; const bf16_t v = to_bf16(p.c_krope[i]);
        bf16_t* dst = p.kmla_den + ((size_t)((l * 2 + b) * 2304 + s) * 6) * 96 + 64 + d;
#pragma unroll
        for (int hh = 0; hh < 6; ++hh) dst[hh * 96] = v;
    }
    for (int i = gt; i < 2 * 2 * 256 * 128; i += GT) {
        const int d = i & 63, hk = (i >> 6) & 1, s = (i >> 7) & 255, l = (i >> 15) & 1, b = i >> 16;
        p.kgqa_den[((size_t)((l * 2 + b) * 2304 + s) * 2 + hk) * 64 + d] = to_bf16(p.c_gk[i]);
        p.vtgqa_den[((size_t)((l * 2 + b) * 2 + hk) * 64 + d) * 2304 + s] = to_bf16(p.c_gv[i]);
    }
}

DI void phase_norm(KPR p, const float* xc, const float* xd, const float* g, const float* modl, int shift_off, int scale_off) {
    const int lane = threadIdx.x & 63, gw = blockIdx.x * 4 + (threadIdx.x >> 6), nw = gridDim.x * 4;
    for (int T = gw; T < NTOK; T += nw) {
        const float* xr = T < NCTX ? xc + (size_t)T * D : xd + (size_t)(T - NCTX) * D;
        const float* mj = modl + (T < NCTX ? 0 : 1 + ((T - NCTX) >> 11)) * 6144;
        f32x4 v[4]; float ss = 0.f;
#pragma unroll
        for (int i = 0; i < 4; ++i) { v[i] = *(const f32x4*)(xr + lane * 4 + i * 256); ss += v[i].x * v[i].x + v[i].y * v[i].y + v[i].z * v[i].z + v[i].w * v[i].w; }
#pragma unroll
        for (int o = 32; o >= 1; o >>= 1) ss += __shfl_xor(ss, o);
        const float rs = rsqrtf(ss * (1.f / 1024.f) + EPS);
#pragma unroll
        for (int i = 0; i < 4; ++i) {
            const int c = lane * 4 + i * 256;
            const f32x4 gg = *(const f32x4*)(g + c), sc = *(const f32x4*)(mj + scale_off + c), sh = *(const f32x4*)(mj + shift_off + c);
            u32x2 w; w.x = pk_bf16(v[i].x * rs * gg.x * (1.f + sc.x) + sh.x, v[i].y * rs * gg.y * (1.f + sc.y) + sh.y);
            w.y = pk_bf16(v[i].z * rs * gg.z * (1.f + sc.z) + sh.z, v[i].w * rs * gg.w * (1.f + sc.w) + sh.w);
            *(u32x2*)(p.h + (size_t)T * D + c) = w;
        }
    }
}
DI void phase_final(KPR p, const float* x) {
    const int lane = threadIdx.x & 63, gw = blockIdx.x * 4 + (threadIdx.x >> 6), nw = gridDim.x * 4;
    for (int T = gw; T < NTOK; T += nw) {
        const float* xr = x + (size_t)T * D; f32x4 v[4]; float ss = 0.f;
#pragma unroll
        for (int i = 0; i < 4; ++i) { v[i] = *(const f32x4*)(xr + lane * 4 + i * 256); ss += v[i].x * v[i].x + v[i].y * v[i].y + v[i].z * v[i].z + v[i].w * v[i].w; }
#pragma unroll
        for (int o = 32; o >= 1; o >>= 1) ss += __shfl_xor(ss, o);
        const float rs = rsqrtf(ss * (1.f / 1024.f) + EPS);
#pragma unroll
        for (int i = 0; i < 4; ++i) { const int c = lane * 4 + i * 256; const f32x4 gg = *(const f32x4*)(p.g_final + c);
            f32x4 o = {v[i].x * rs * gg.x, v[i].y * rs * gg.y, v[i].z * rs * gg.z, v[i].w * rs * gg.w}; *(f32x4*)(p.out + (size_t)T * D + c) = o; }
    }
}

DI void rope_pair(float& x1, float& x2, const f32x2 cs) { const float a = x1 * cs.x - x2 * cs.y, b = x2 * cs.x + x1 * cs.y; x1 = a; x2 = b; }
DI void epi_win(KPR p, int l, f32x16 (&acc)[2][2], int tok0, int cb, int r, int h) {
#pragma unroll
    for (int i = 0; i < 2; ++i) {
        const int T = tok0 + i * 32 + r; const bool den = T >= NCTX;
        int b, s; if (!den) { b = T >> 8; s = T & 255; } else { b = (T - NCTX) >> 11; s = (T - NCTX) & 2047; }
        if (cb < 640) {
            float ss = sumsq16(acc[i][0]) + sumsq16(acc[i][1]); ss += __shfl_xor(ss, 32);
            if (cb < 384) {
                bf16_t* dst = p.cq + (size_t)T * 384 + cb; st_bf16_tile(dst, acc[i][0], h); st_bf16_tile(dst + 32, acc[i][1], h);
                if (h == 0) p.ssq_q[T * 6 + (cb >> 6)] = ss;
            } else {
                const int c0 = cb - 384; bf16_t* dst = p.ckv + (size_t)T * 256 + c0; st_bf16_tile(dst, acc[i][0], h); st_bf16_tile(dst + 32, acc[i][1], h);
                if (h == 0) p.ssq_kv[T * 4 + (c0 >> 6)] = ss;
                if (!den) { float* o = p.out + OFF_CKV + ((size_t)((b * 2 + l) * 256 + s)) * 256 + c0; st_f32_tile(o, acc[i][0], h); st_f32_tile(o + 32, acc[i][1], h); }
            }
        } else if (cb < 1152) {
            float ss = sumsq16(acc[i][0]) + sumsq16(acc[i][1]); ss += __shfl_xor(ss, 32);
            const float rs = rsqrtf(ss * (1.f / 64.f) + EPS);
            const bool isq = cb < 1024;
            const float* g = (isq ? p.g_q_head : p.g_k_head) + l * 64;
            f32x16 v0, v1;
#pragma unroll
            for (int e = 0; e < 16; ++e) { const int d = crow(e, h); v0[e] = acc[i][0][e] * rs * g[d]; v1[e] = acc[i][1][e] * rs * g[32 + d]; }
            if (!isq && !den) {
                const int hk = (cb - 1024) >> 6;
                float* o = p.out + OFF_GK + ((size_t)(((b * 2 + l) * 256 + s) * 2 + hk)) * 64; st_f32_tile(o, v0, h); st_f32_tile(o + 32, v1, h);
            }
            if (den) {
#pragma unroll
                for (int e = 0; e < 16; ++e) { const f32x2 cs = p.rope_g[s * 32 + crow(e, h)]; float x1 = v0[e], x2 = v1[e]; rope_pair(x1, x2, cs); v0[e] = x1; v1[e] = x2; }
            }
            if (isq) {
                const float qs = 0.125f * LOG2E;
#pragma unroll
                for (int e = 0; e < 16; ++e) { v0[e] *= qs; v1[e] *= qs; }
                bf16_t* dst = p.gq + (size_t)T * 384 + (cb - 640); st_bf16_tile(dst, v0, h); st_bf16_tile(dst + 32, v1, h);
            } else {
                const int hk = (cb - 1024) >> 6;
                bf16_t* dst = den ? p.kgqa_den + ((size_t)((l * 2 + b) * 2304 + 256 + s) * 2 + hk) * 64 : p.kgqa_ctx + ((size_t)(b * 256 + s) * 2 + hk) * 64;
                st_bf16_tile(dst, v0, h); st_bf16_tile(dst + 32, v1, h);
            }
        } else if (cb < 1280) {
            const int hk = (cb - 1152) >> 6;
            if (!den) {
                float* o = p.out + OFF_GV + ((size_t)(((b * 2 + l) * 256 + s) * 2 + hk)) * 64; st_f32_tile(o, acc[i][0], h); st_f32_tile(o + 32, acc[i][1], h);
                bf16_t* dst = p.vtgqa_ctx + ((size_t)(b * 2 + hk) * 64) * 256 + s; st_bf16_tile_T(dst, 256, acc[i][0], h); st_bf16_tile_T(dst + 32 * 256, 256, acc[i][1], h);
            } else {
                bf16_t* dst = p.vtgqa_den + ((size_t)((l * 2 + b) * 2 + hk) * 64) * 2304 + 256 + s; st_bf16_tile_T(dst, 2304, acc[i][0], h); st_bf16_tile_T(dst + 32 * 2304, 2304, acc[i][1], h);
            }
        } else if (cb < 1536) {
            bf16_t* dst = p.u + (size_t)T * 256 + (cb - 1280); st_bf16_tile(dst, acc[i][0], h); st_bf16_tile(dst + 32, acc[i][1], h);
        } else if (cb == 1536) {
            f32x16 v = acc[i][0];
            if (!den) {
                float* o = p.out + OFF_KROPE + ((size_t)((b * 2 + l) * 256 + s)) * 32; st_f32_tile(o, v, h);
                bf16_t* dst = p.kmla_ctx + ((size_t)(b * 256 + s) * 6) * 96 + 64;
#pragma unroll
                for (int hh = 0; hh < 6; ++hh) st_bf16_tile(dst + hh * 96, v, h);
            } else {
#pragma unroll
                for (int e = 0; e < 8; ++e) { const f32x2 cs = p.rope_m[s * 16 + crow(e, h)]; float x1 = v[e], x2 = v[e + 8]; rope_pair(x1, x2, cs); v[e] = x1; v[e + 8] = x2; }
                bf16_t* dst = p.kmla_den + ((size_t)((l * 2 + b) * 2304 + 256 + s) * 6) * 96 + 64;
#pragma unroll
                for (int hh = 0; hh < 6; ++hh) st_bf16_tile(dst + hh * 96, v, h);
            }
        }
    }
}

#define FOR_TILES_64M(NT, mvar, nvar)                                                             \
    for (int _lid = (int)(blockIdx.x >> 3), mvar = 8 * (int)(blockIdx.x & 7) + (_lid & 7), nvar = _lid >> 3; _lid < 8 * (NT);     \
         _lid += (int)(gridDim.x >> 3), mvar = 8 * (int)(blockIdx.x & 7) + (_lid & 7), nvar = _lid >> 3)

DI void phase_win(KPR p, int l, char* lds) {
    const int tid = threadIdx.x, lane = tid & 63, wid = tid >> 6, wr = wid >> 1, wc = wid & 1, r = lane & 31, h = lane >> 5;
    FOR_TILES_64M(13, m, n) {
        f32x16 acc[2][2];
        gemm_tile(p.h + (size_t)m * 128 * D, D, p.wt_in + l * SZ_WIN + (size_t)n * 128 * D, D, D, lds, acc);
        epi_win(p, l, acc, m * 128 + wr * 64, n * 128 + wc * 64, r, h);
    }
}

DI void phase_mid(KPR p, int l, char* lds) {
    const int tid = threadIdx.x, lane = tid & 63, wid = tid >> 6, wr = wid >> 1, wc = wid & 1, r = lane & 31, h = lane >> 5;
    for (int t = blockIdx.x; t < 984; t += gridDim.x) {
        f32x16 acc[2][2];
        if (t < 320) {
            const int m = t / 5, n = t % 5;
            gemm_tile(p.cq + (size_t)m * 128 * 384, 384, p.wt_qup + l * SZ_QUP + (size_t)n * 128 * 384, 384, 384, lds, acc);
            const int cb = n * 128 + wc * 64;
#pragma unroll
            for (int i = 0; i < 2; ++i) {
                const int T = m * 128 + wr * 64 + i * 32 + r; const bool den = T >= NCTX; const int s = (T - NCTX) & 2047;
                float ss = 0.f;
#pragma unroll
                for (int k = 0; k < 6; ++k) ss += p.ssq_q[T * 6 + k];
                const float rs = rsqrtf(ss * (1.f / 384.f) + EPS) * (0.10206207261596575f * LOG2E);
#pragma unroll
                for (int j = 0; j < 2; ++j) {
                    const int ct = (cb >> 5) + j; if (ct >= 18) continue;
                    f32x16 v;
#pragma unroll
                    for (int e = 0; e < 16; ++e) v[e] = acc[i][j][e] * rs;
                    if ((ct % 3) == 2 && den) {
#pragma unroll
                        for (int e = 0; e < 8; ++e) { const f32x2 cs = p.rope_m[s * 16 + crow(e, h)]; float x1 = v[e], x2 = v[e + 8]; rope_pair(x1, x2, cs); v[e] = x1; v[e + 8] = x2; }
                    }
                    st_bf16_tile(p.qmla + (size_t)T * 576 + ct * 32, v, h);
                }
            }
        } else if (t < 728) {
            const int tt = t - 320, mt = tt / 6, hd = tt % 6;
            const bf16_t* A; const bf16_t* W; int kind, b = 0, s0 = 0, T0 = 0;
            if (mt < 64) { T0 = mt * 128; A = p.ckv + (size_t)T0 * 256; W = p.wt_kvg; kind = mt < 32 ? 0 : 1; if (kind == 0) { b = T0 >> 8; s0 = T0 & 255; } else { b = (T0 - NCTX) >> 11; s0 = 256 + ((T0 - NCTX) & 2047); } }
            else { const int idx = mt - 64; b = idx >> 1; s0 = (idx & 1) * 128; A = p.ckv_cache + ((size_t)(b * 2 + l) * 256 + s0) * 256; W = p.wt_kvp; kind = 2; }
            gemm_tile(A, 256, W + l * SZ_KV + (size_t)hd * 128 * 256, 256, 256, lds, acc);
#pragma unroll
            for (int i = 0; i < 2; ++i) {
                const int ro = wr * 64 + i * 32 + r; float rs = 1.f;
                if (kind < 2) { const int T = T0 + ro; const float ss = p.ssq_kv[T * 4] + p.ssq_kv[T * 4 + 1] + p.ssq_kv[T * 4 + 2] + p.ssq_kv[T * 4 + 3]; rs = rsqrtf(ss * (1.f / 256.f) + EPS); }
                const int key = s0 + ro;
                f32x16 v0, v1;
#pragma unroll
                for (int e = 0; e < 16; ++e) { v0[e] = acc[i][0][e] * rs; v1[e] = acc[i][1][e] * rs; }
                if (wc == 0) {
                    bf16_t* dst = kind == 0 ? p.kmla_ctx + ((size_t)(b * 256 + key) * 6 + hd) * 96 : p.kmla_den + ((size_t)((l * 2 + b) * 2304 + key) * 6 + hd) * 96;
                    st_bf16_tile(dst, v0, h); st_bf16_tile(dst + 32, v1, h);
                } else {
                    if (kind == 0) { bf16_t* dst = p.vtmla_ctx + ((size_t)(b * 6 + hd) * 64) * 256 + key; st_bf16_tile_T(dst, 256, v0, h); st_bf16_tile_T(dst + 32 * 256, 256, v1, h); }
                    else { bf16_t* dst = p.vtmla_den + ((size_t)((l * 2 + b) * 6 + hd) * 64) * 2304 + key; st_bf16_tile_T(dst, 2304, v0, h); st_bf16_tile_T(dst + 32 * 2304, 2304, v1, h); }
                }
            }
        } else {
            const int tt = t - 728, m = tt >> 2, g = tt & 3;
            gemm_tile(p.u + (size_t)m * 128 * 256 + g * 64, 256, p.bt_ch, 64, 64, lds, acc);
#pragma unroll
            for (int i = 0; i < 2; ++i) {
                const int T = m * 128 + wr * 64 + i * 32 + r; const bool den = T >= NCTX;
#pragma unroll
                for (int j = 0; j < 2; ++j) {
                    const int c = g * 64 + j * 32;
                    if (!den) { const int b = T >> 8, s = T & 255; st_bf16_tile_T(p.zt_ctx + ((size_t)(b * 256 + c)) * 512 + wc * 256 + s, 512, acc[i][j], h); }
                    else { const int b = (T - NCTX) >> 11, s = (T - NCTX) & 2047; st_bf16_tile_T(p.zt_den + ((size_t)(b * 256 + c)) * 4096 + wc * 2048 + s, 4096, acc[i][j], h); }
                }
            }
        }
    }
    for (int i = blockIdx.x * 256 + tid; i < NCTX * 64; i += gridDim.x * 256) {
        const int T = i >> 6, c = (i & 63) * 4, b = T >> 8, s = T & 255;
        const float ss = p.ssq_kv[T * 4] + p.ssq_kv[T * 4 + 1] + p.ssq_kv[T * 4 + 2] + p.ssq_kv[T * 4 + 3]; const float rs = rsqrtf(ss * (1.f / 256.f) + EPS);
        float* o = p.out + OFF_CKV + ((size_t)((b * 2 + l) * 256 + s)) * 256 + c; f32x4 v = *(f32x4*)o; const f32x4 g = *(const f32x4*)(p.g_kv_a + l * 256 + c);
        v.x *= rs * g.x; v.y *= rs * g.y; v.z *= rs * g.z; v.w *= rs * g.w; *(f32x4*)o = v;
    }
}

template <int DQK>
DI void attn_item(const bf16_t* __restrict__ Q, int ldq, const bf16_t* __restrict__ Kp, int ldk, const bf16_t* __restrict__ Vt, int ldv, int Sk, bf16_t* O, int ldo, char* lds) {
    constexpr int KSTR = DQK * 2 + 16, VSTR = 136, KBYTES = 64 * KSTR, STAGE = KBYTES + 64 * VSTR, KCH = DQK / 8, NKL = (64 * KCH) / 256;
    const int tid = threadIdx.x, lane = tid & 63, w = tid >> 6, r = lane & 31, h = lane >> 5;
    bf16x8 qf[DQK / 16];
#pragma unroll
    for (int ks = 0; ks < DQK / 16; ++ks) qf[ks] = *(const bf16x8*)(Q + (size_t)(w * 32 + r) * ldq + ks * 16 + h * 8);
    f32x16 oacc[2];
#pragma unroll
    for (int e = 0; e < 16; ++e) { oacc[0][e] = 0.f; oacc[1][e] = 0.f; }
    float mrun = -INFINITY, lrun = 0.f;
    u32x4 rk[NKL], rv[2];
    int krow_[NKL], kch_[NKL];
#pragma unroll
    for (int i = 0; i < NKL; ++i) { const int c = tid + 256 * i; krow_[i] = c / KCH; kch_[i] = c % KCH; }
    const int vrow = tid >> 3, vch = tid & 7;
    auto gload = [&](int kt) {
#pragma unroll
        for (int i = 0; i < NKL; ++i) rk[i] = *(const u32x4*)(Kp + (size_t)(kt * 64 + krow_[i]) * ldk + kch_[i] * 8);
#pragma unroll
        for (int i = 0; i < 2; ++i) rv[i] = *(const u32x4*)(Vt + (size_t)(vrow + 32 * i) * ldv + kt * 64 + vch * 8);
    };
    auto lstore = [&](int buf) {
        char* base = lds + buf * STAGE;
#pragma unroll
        for (int i = 0; i < NKL; ++i) *(u32x4*)(base + krow_[i] * KSTR + kch_[i] * 16) = rk[i];
#pragma unroll
        for (int i = 0; i < 2; ++i) { char* d = base + KBYTES + (vrow + 32 * i) * VSTR + vch * 16; u32x2 lo = {rv[i].x, rv[i].y}, hi = {rv[i].z, rv[i].w}; *(u32x2*)d = lo; *(u32x2*)(d + 8) = hi; }
    };
    gload(0); lstore(0); __syncthreads();
    const int nkt = Sk >> 6;
    for (int kt = 0; kt < nkt; ++kt) {
        const char* kb = lds + (kt & 1) * STAGE; const char* vb = kb + KBYTES;
        if (kt + 1 < nkt) gload(kt + 1);
        f32x16 sacc[2];
#pragma unroll
        for (int sub = 0; sub < 2; ++sub) {
#pragma unroll
            for (int e = 0; e < 16; ++e) sacc[sub][e] = 0.f;
#pragma unroll
            for (int ks = 0; ks < DQK / 16; ++ks) {
                const bf16x8 kf = *(const bf16x8*)(kb + (sub * 32 + r) * KSTR + (ks * 2 + h) * 16);
                sacc[sub] = MFMA(kf, qf[ks], sacc[sub]);
            }
        }
        float mx = sacc[0][0];
#pragma unroll
        for (int e = 1; e < 16; ++e) mx = fmaxf(mx, sacc[0][e]);
#pragma unroll
        for (int e = 0; e < 16; ++e) mx = fmaxf(mx, sacc[1][e]);
        mx = fmaxf(mx, __shfl_xor(mx, 32));
        const float mnew = fmaxf(mrun, mx);
        const float alpha = __builtin_amdgcn_exp2f(mrun - mnew);
        mrun = mnew;
        float psum = 0.f;
#pragma unroll
        for (int sub = 0; sub < 2; ++sub)
#pragma unroll
            for (int e = 0; e < 16; ++e) { const float pv = __builtin_amdgcn_exp2f(sacc[sub][e] - mnew); sacc[sub][e] = pv; psum += pv; }
        lrun = lrun * alpha + psum;
#pragma unroll
        for (int e = 0; e < 16; ++e) { oacc[0][e] *= alpha; oacc[1][e] *= alpha; }
#pragma unroll
        for (int sub = 0; sub < 2; ++sub)
#pragma unroll
            for (int s2 = 0; s2 < 2; ++s2) {
                u32x4 pw; pw.x = pk_bf16(sacc[sub][8 * s2 + 0], sacc[sub][8 * s2 + 1]); pw.y = pk_bf16(sacc[sub][8 * s2 + 2], sacc[sub][8 * s2 + 3]);
                pw.z = pk_bf16(sacc[sub][8 * s2 + 4], sacc[sub][8 * s2 + 5]); pw.w = pk_bf16(sacc[sub][8 * s2 + 6], sacc[sub][8 * s2 + 7]);
                const bf16x8 pf = __builtin_bit_cast(bf16x8, pw);
#pragma unroll
                for (int dvt = 0; dvt < 2; ++dvt) {
                    const char* va = vb + (dvt * 32 + r) * VSTR + (sub * 32 + s2 * 16 + 4 * h) * 2;
                    const s16x4 lo = *(const s16x4*)va, hi = *(const s16x4*)(va + 16);
                    const bf16x8 vf = __builtin_shufflevector(lo, hi, 0, 1, 2, 3, 4, 5, 6, 7);
                    oacc[dvt] = MFMA(vf, pf, oacc[dvt]);
                }
            }
        if (kt + 1 < nkt) lstore((kt + 1) & 1);
        __syncthreads();
    }
    lrun += __shfl_xor(lrun, 32);
    const float inv = 1.f / lrun;
#pragma unroll
    for (int dvt = 0; dvt < 2; ++dvt) {
        f32x16 v;
#pragma unroll
        for (int e = 0; e < 16; ++e) v[e] = oacc[dvt][e] * inv;
        st_bf16_tile(O + (size_t)(w * 32 + r) * ldo + dvt * 32, v, h);
    }
}

DI void phase_mix(KPR p, int l, char* lds, unsigned* ctr) {
    const int tid = threadIdx.x, lane = tid & 63, wid = tid >> 6, wr = wid >> 1, wc = wid & 1, r = lane & 31, h = lane >> 5;
    __shared__ unsigned sitem_s; volatile unsigned* sitem = &sitem_s;
    for (;;) {
        __syncthreads();
        if (tid == 0) *sitem = atomicAdd(ctr, 1u);
        __syncthreads();
        const int it = (int)*sitem;
        if (it >= 896) break;
        if (it < 64 || (it >= 448 && it < 512)) {
            f32x16 acc[2][2]; int tokbase, m, n;
            if (it < 64) { const int b = it >> 5; m = (it >> 1) & 15; n = it & 1; tokbase = NCTX + b * 2048;
                gemm_tile(p.tab2048 + (size_t)m * 128 * 4096, 4096, p.zt_den + ((size_t)(b * 256 + n * 128)) * 4096, 4096, 4096, lds, acc); }
            else { const int q = it - 448, b = q >> 2; m = (q >> 1) & 1; n = q & 1; tokbase = b * 256;
                gemm_tile(p.tab256 + (size_t)m * 128 * 512, 512, p.zt_ctx + ((size_t)(b * 256 + n * 128)) * 512, 512, 512, lds, acc); }
#pragma unroll
            for (int i = 0; i < 2; ++i) {
                const int T = tokbase + m * 128 + wr * 64 + i * 32 + r;
                bf16_t* dst = p.mix + (size_t)T * D + 384 + n * 128 + wc * 64;
                st_bf16_tile(dst, acc[i][0], h); st_bf16_tile(dst + 32, acc[i][1], h);
            }
        } else {
            int q, den;
            if (it < 448) { q = it - 64; den = 1; } else { q = it - 512; den = 0; }
            int b, hd, qb;
            if (den) { qb = q & 15; hd = (q >> 4) % 12; b = q / 192; } else { qb = q & 1; hd = (q >> 1) % 12; b = q / 24; }
            const int T0 = den ? NCTX + b * 2048 + qb * 128 : b * 256 + qb * 128;
            const int Sk = den ? 2304 : 256;
            if (hd < 6) {
                const bf16_t* K = den ? p.kmla_den + ((size_t)(l * 2 + b) * 2304 * 6 + hd) * 96 : p.kmla_ctx + ((size_t)b * 256 * 6 + hd) * 96;
                const bf16_t* V = den ? p.vtmla_den + ((size_t)((l * 2 + b) * 6 + hd) * 64) * 2304 : p.vtmla_ctx + ((size_t)(b * 6 + hd) * 64) * 256;
                attn_item<96>(p.qmla + (size_t)T0 * 576 + hd * 96, 576, K, 576, V, Sk, Sk, p.mix + (size_t)T0 * D + hd * 64, D, lds);
            } else {
                const int hq = hd - 6, hk = hq / 3;
                const bf16_t* K = den ? p.kgqa_den + ((size_t)(l * 2 + b) * 2304 * 2 + hk) * 64 : p.kgqa_ctx + ((size_t)b * 256 * 2 + hk) * 64;
                const bf16_t* V = den ? p.vtgqa_den + ((size_t)((l * 2 + b) * 2 + hk) * 64) * 2304 : p.vtgqa_ctx + ((size_t)(b * 2 + hk) * 64) * 256;
                attn_item<64>(p.gq + (size_t)T0 * 384 + hq * 64, 384, K, 128, V, Sk, Sk, p.mix + (size_t)T0 * D + 640 + hq * 64, D, lds);
            }
        }
    }
}

DI void phase_resid(KPR p, const bf16_t* A, int K, const bf16_t* W, const float* xc, const float* xd, float* xout, const float* gate, char* lds) {
    const int tid = threadIdx.x, lane = tid & 63, wid = tid >> 6, wr = wid >> 1, wc = wid & 1, r = lane & 31, h = lane >> 5;
    FOR_TILES_64M(8, m, n) {
        f32x16 acc[2][2];
        gemm_tile(A + (size_t)m * 128 * K, K, W + (size_t)n * 128 * K, K, K, lds, acc);
#pragma unroll
        for (int i = 0; i < 2; ++i) {
            const int T = m * 128 + wr * 64 + i * 32 + r;
            const float* xr = T < NCTX ? xc + (size_t)T * D : xd + (size_t)(T - NCTX) * D;
            const float* gj = gate + (T < NCTX ? 0 : 1 + ((T - NCTX) >> 11)) * 6144;
#pragma unroll
            for (int j = 0; j < 2; ++j)
#pragma unroll
                for (int q = 0; q < 4; ++q) {
                    const int c = n * 128 + wc * 64 + j * 32 + 8 * q + 4 * h;
                    const f32x4 xv = *(const f32x4*)(xr + c), gv = *(const f32x4*)(gj + c);
                    f32x4 o = {xv.x + gv.x * acc[i][j][4 * q], xv.y + gv.y * acc[i][j][4 * q + 1], xv.z + gv.z * acc[i][j][4 * q + 2], xv.w + gv.w * acc[i][j][4 * q + 3]};
                    *(f32x4*)(xout + (size_t)T * D + c) = o;
                }
        }
    }
}
DI void phase_gu(KPR p, int l, char* lds) {
    const int tid = threadIdx.x, lane = tid & 63, wid = tid >> 6, wr = wid >> 1, wc = wid & 1, r = lane & 31, h = lane >> 5;
    FOR_TILES_64M(44, m, n) {
        f32x16 acc[2][2];
        gemm_tile(p.h + (size_t)m * 128 * D, D, p.wt_gu + l * SZ_GU + (size_t)n * 128 * D, D, D, lds, acc);
#pragma unroll
        for (int i = 0; i < 2; ++i) {
            const int T = m * 128 + wr * 64 + i * 32 + r;
            f32x16 v;
#pragma unroll
            for (int e = 0; e < 16; ++e) v[e] = silu(acc[i][0][e]) * acc[i][1][e];
            st_bf16_tile(p.hid + (size_t)T * DFF + (n * 2 + wc) * 32, v, h);
        }
    }
}

constexpr int NPHASE = 18;
template <int PM>
__global__ void __launch_bounds__(256, 2) fwd_megakernel(P p_arg) {
    KP kp0 = (KP)__builtin_amdgcn_kernarg_segment_ptr();
    KPR p = *kp0;
    __shared__ __attribute__((aligned(16))) char lds[65536];
    __shared__ uint4 xbw;
    if (p.never) cg::this_grid().sync();
    if (threadIdx.x == 0) xbw = make_uint4(0u, 0u, 0u, 0u);
    __syncthreads();
    XcdBarrier xb;
    if (!MULTI_LAUNCH) xb = xcd_barrier_post(p.bar, (volatile LAS unsigned*)&xbw);
    const int ph0 = p.ph0, ph1 = p.ph1;
    for (int ph = ph0; ph < ph1; ++ph) {
        KP kp = kp0; asm volatile("" : "+s"(kp));
        KPR p = *kp;
        if (ph == 0) { if (PM & 1) phase_prologue(p, lds); }
        else if (ph == 17) { if (PM & 2) phase_final(p, p.xa); }
        else {
            const int l = (ph - 1) >> 3, s = (ph - 1) & 7;
            const float* modl = p.mod + (size_t)l * 3 * 6144;
            const float* xc = l == 0 ? p.x_prompt : p.xa;
            const float* xd = l == 0 ? p.x_sample : p.xa + (size_t)NCTX * D;
            switch (s) {
                case 0: if (PM & 4) phase_norm(p, xc, xd, p.g_norm1 + l * D, modl, 0, 1024); break;
                case 1: if (PM & 8) phase_win(p, l, lds); break;
                case 2: if (PM & 16) phase_mid(p, l, lds); break;
                case 3: if (PM & 32) phase_mix(p, l, lds, p.ctr + 64 * l); break;
                case 4: if (PM & 64) phase_resid(p, p.mix, D, p.wt_out + l * SZ_WOUT, xc, xd, p.xb, modl + 2048, lds); break;
                case 5: if (PM & 4) phase_norm(p, p.xb, p.xb + (size_t)NCTX * D, p.g_norm2 + l * D, modl, 3072, 4096); break;
                case 6: if (PM & 128) phase_gu(p, l, lds); break;
                case 7: if (PM & 64) phase_resid(p, p.hid, DFF, p.wt_down + l * SZ_DOWN, p.xb, p.xb + (size_t)NCTX * D, p.xa, modl + 5120, lds); break;
            }
        }
        if (!MULTI_LAUNCH && ph + 1 < ph1) xcd_barrier(xb);
    }
}

extern "C" void kernel_launch(void* const* d_in, const int* in_sizes, int n_in, void* d_out, int out_size, void* d_ws, size_t ws_size, hipStream_t stream) {
    static int grid_blocks = 0;
    if (!grid_blocks) {
        int dev = 0, cus = 0, per_cu = 0;
        hipGetDevice(&dev);
        hipDeviceGetAttribute(&cus, hipDeviceAttributeMultiprocessorCount, dev);
        hipOccupancyMaxActiveBlocksPerMultiprocessor(&per_cu, fwd_megakernel<(MULTI_LAUNCH ? 32 : 0xffff)>, 256, 0);
        if (per_cu > 2) per_cu = 2;
        if (per_cu < 1) per_cu = 1;
        grid_blocks = cus * per_cu;
        grid_blocks &= ~7;
    }
    P p{};
    const float* const* in = (const float* const*)d_in;
    p.x_prompt = in[0]; p.x_sample = in[1]; p.c_ckv = in[2]; p.c_krope = in[3]; p.c_gk = in[4]; p.c_gv = in[5]; p.c = in[6]; p.c_ctx = in[7]; p.w_ada = in[8]; p.b_ada = in[9];
    p.g_norm1 = in[10]; p.g_norm2 = in[11]; p.w_in = in[12]; p.g_q_a = in[13]; p.w_q_up = in[14]; p.g_kv_a = in[15]; p.w_kv_up = in[16]; p.g_q_head = in[17]; p.g_k_head = in[18];
    p.w_out = in[19]; p.w_gate = in[20]; p.w_up = in[21]; p.w_down = in[22]; p.g_final = in[23];
    p.out = (float*)d_out;
    char* ws = (char*)d_ws; size_t off = 0;
    auto alloc = [&](size_t bytes) { char* r = ws + off; off += (bytes + 255) & ~(size_t)255; return r; };
    p.bar = (unsigned*)alloc(XCD_BAR_WORDS * 4); p.ctr = (unsigned*)alloc(1024); p.mod = (float*)alloc(2 * 3 * 6144 * 4);
    const size_t zero_bytes = off;
    p.wt_in = (bf16_t*)alloc(2 * SZ_WIN * 2); p.wt_qup = (bf16_t*)alloc(2 * SZ_QUP * 2); p.wt_kvg = (bf16_t*)alloc(2 * SZ_KV * 2); p.wt_kvp = (bf16_t*)alloc(2 * SZ_KV * 2);
    p.wt_out = (bf16_t*)alloc(2 * SZ_WOUT * 2); p.wt_gu = (bf16_t*)alloc(2 * SZ_GU * 2); p.wt_down = (bf16_t*)alloc(2 * SZ_DOWN * 2);
    p.tab2048 = (bf16_t*)alloc((size_t)2048 * 4096 * 2); p.tab256 = (bf16_t*)alloc(256 * 512 * 2); p.bt_ch = (bf16_t*)alloc(128 * 64 * 2);
    p.rope_g = (f32x2*)alloc(2048 * 32 * 8); p.rope_m = (f32x2*)alloc(2048 * 16 * 8);
    p.ckv_cache = (bf16_t*)alloc(2 * 2 * 256 * 256 * 2);
    p.h = (bf16_t*)alloc((size_t)NTOK * D * 2);
    p.ssq_q = (float*)alloc(NTOK * 6 * 4); p.ssq_kv = (float*)alloc(NTOK * 4 * 4);
    p.xa = (float*)alloc((size_t)NTOK * D * 4); p.xb = (float*)alloc((size_t)NTOK * D * 4);
    p.kmla_ctx = (bf16_t*)alloc((size_t)16 * 256 * 576 * 2); p.vtmla_ctx = (bf16_t*)alloc((size_t)16 * 6 * 64 * 256 * 2);
    p.kgqa_ctx = (bf16_t*)alloc((size_t)16 * 256 * 128 * 2); p.vtgqa_ctx = (bf16_t*)alloc((size_t)16 * 2 * 64 * 256 * 2);
    p.kmla_den = (bf16_t*)alloc((size_t)4 * 2304 * 576 * 2); p.vtmla_den = (bf16_t*)alloc((size_t)4 * 6 * 64 * 2304 * 2);
    p.kgqa_den = (bf16_t*)alloc((size_t)4 * 2304 * 128 * 2); p.vtgqa_den = (bf16_t*)alloc((size_t)4 * 2 * 64 * 2304 * 2);
    p.zt_ctx = (bf16_t*)alloc((size_t)16 * 256 * 512 * 2); p.zt_den = (bf16_t*)alloc((size_t)2 * 256 * 4096 * 2);
    const size_t ov = off;
    p.cq = (bf16_t*)alloc((size_t)NTOK * 384 * 2); p.ckv = (bf16_t*)alloc((size_t)NTOK * 256 * 2); p.u = (bf16_t*)alloc((size_t)NTOK * 256 * 2);
    p.gq = (bf16_t*)alloc((size_t)NTOK * 384 * 2); p.qmla = (bf16_t*)alloc((size_t)NTOK * 576 * 2); p.mix = (bf16_t*)alloc((size_t)NTOK * D * 2);
    p.hid = (bf16_t*)(ws + ov);
    if (off - ov < (size_t)NTOK * DFF * 2) off = ov + (size_t)NTOK * DFF * 2;
    if (off > ws_size) { fprintf(stderr, "workspace too small: need %zu have %zu\n", off, ws_size); return; }
    hipMemsetAsync(ws, 0, zero_bytes, stream);
#if MULTI_LAUNCH
    for (int ph = 0; ph < NPHASE; ++ph) {
        P q = p; q.ph0 = ph; q.ph1 = ph + 1;
        const int s = (ph - 1) & 7;
        if (ph == 0) hipLaunchKernelGGL(fwd_megakernel<1>, dim3(grid_blocks), dim3(256), 0, stream, q);
        else if (ph == 17) hipLaunchKernelGGL(fwd_megakernel<2>, dim3(grid_blocks), dim3(256), 0, stream, q);
        else if (s == 0 || s == 5) hipLaunchKernelGGL(fwd_megakernel<4>, dim3(grid_blocks), dim3(256), 0, stream, q);
        else if (s == 1) hipLaunchKernelGGL(fwd_megakernel<8>, dim3(grid_blocks), dim3(256), 0, stream, q);
        else if (s == 2) hipLaunchKernelGGL(fwd_megakernel<16>, dim3(grid_blocks), dim3(256), 0, stream, q);
        else if (s == 3) hipLaunchKernelGGL(fwd_megakernel<32>, dim3(grid_blocks), dim3(256), 0, stream, q);
        else if (s == 4 || s == 7) hipLaunchKernelGGL(fwd_megakernel<64>, dim3(grid_blocks), dim3(256), 0, stream, q);
        else hipLaunchKernelGGL(fwd_megakernel<128>, dim3(grid_blocks), dim3(256), 0, stream, q);
    }
#else
    p.ph0 = 0; p.ph1 = NPHASE;
    void* args[] = {&p};
    hipError_t e = hipLaunchCooperativeKernel((void*)fwd_megakernel<0xffff>, dim3(grid_blocks), dim3(256), args, 0, stream);
    if (e != hipSuccess) fprintf(stderr, "cooperative launch failed: %s (grid %d)\n", hipGetErrorString(e), grid_blocks);
#endif
}
```

```cpp
#include <hip/hip_runtime.h>
#include <hip/hip_cooperative_groups.h>
#include <stdint.h>
#include <stdio.h>
namespace cg = cooperative_groups;

#ifndef FUSEMASK
#define FUSEMASK 0xffff
#endif
#ifndef MULTI_LAUNCH
#define MULTI_LAUNCH 0
#endif

typedef unsigned short bf16_t;
typedef short bf16x8 __attribute__((ext_vector_type(8)));
typedef short s16x4 __attribute__((ext_vector_type(4)));
typedef float f32x16 __attribute__((ext_vector_type(16)));
typedef float f32x4 __attribute__((ext_vector_type(4)));
typedef float f32x2 __attribute__((ext_vector_type(2)));
typedef unsigned u32x4 __attribute__((ext_vector_type(4)));
typedef unsigned u32x2 __attribute__((ext_vector_type(2)));
#define DI __device__ __forceinline__
#define LAS __attribute__((address_space(3)))

constexpr int D = 1024, NTOK = 8192, NCTX = 4096, DFF = 2816;
constexpr int NINP = 1664;
constexpr float EPS = 1e-6f;
constexpr float LOG2E = 1.4426950408889634f;
constexpr size_t OFF_YP = 0, OFF_YS = 4194304, OFF_CKV = 8388608, OFF_KROPE = 10485760, OFF_GK = 10747904, OFF_GV = 11796480;
constexpr size_t SZ_WIN = (size_t)NINP * 1024, SZ_QUP = 640 * 384, SZ_KV = 768 * 256, SZ_WOUT = 1024 * 1024, SZ_GU = (size_t)5632 * 1024, SZ_DOWN = (size_t)1024 * 2816;

struct P {
    const float *x_prompt, *x_sample, *c_ckv, *c_krope, *c_gk, *c_gv, *c, *c_ctx, *w_ada, *b_ada, *g_norm1, *g_norm2, *w_in, *g_q_a, *w_q_up, *g_kv_a,
        *w_kv_up, *g_q_head, *g_k_head, *w_out, *w_gate, *w_up, *w_down, *g_final;
    float* out;
    unsigned* bar;
    unsigned* ctr;
    float* mod;
    bf16_t *wt_in, *wt_qup, *wt_kvg, *wt_kvp, *wt_out, *wt_gu, *wt_down;
    bf16_t *tab2048, *tab256, *bt_ch;
    f32x2 *rope_g, *rope_m;
    bf16_t* ckv_cache;
    bf16_t *h, *cq, *ckv, *u, *gq, *qmla, *mix, *hid;
    float *ssq_q, *ssq_kv;
    float *xa, *xb;
    bf16_t *kmla_ctx, *vtmla_ctx, *kgqa_ctx, *vtgqa_ctx;
    bf16_t *kmla_den, *vtmla_den, *kgqa_den, *vtgqa_den;
    bf16_t *zt_ctx, *zt_den;
    int never, ph0, ph1, pad;
};

typedef const volatile __attribute__((address_space(4))) P& KPR;
typedef const volatile __attribute__((address_space(4))) P* KP;
typedef __bf16 nbf16x2 __attribute__((ext_vector_type(2)));
DI unsigned pk_bf16(float lo, float hi) { f32x2 v = {lo, hi}; nbf16x2 b = __builtin_convertvector(v, nbf16x2); return __builtin_bit_cast(unsigned, b); }
DI bf16_t to_bf16(float x) { return (bf16_t)(pk_bf16(x, 0.f) & 0xffffu); }
DI int crow(int e, int h) { return (e & 3) + 8 * (e >> 2) + 4 * h; }
DI float silu(float x) { return x / (1.f + __expf(-x)); }
#define MFMA(a, b, c) __builtin_amdgcn_mfma_f32_32x32x16_bf16((a), (b), (c), 0, 0, 0)

#define XB_TMO 128
#define XB_XCNT(j) (256 + 64 * (j))
#define XB_XSUB(j) (1280 + 64 * (j))
#define XB_XGEN(j) (2304 + 64 * (j))
#define XB_TOP 3328
#define XB_TOPGEN 3392
#define XCD_BAR_WORDS 3456
#define XB_SPIN_CAP (1u << 20)
DI unsigned xb_ld(unsigned* p) { return __hip_atomic_load(p, __ATOMIC_RELAXED, __HIP_MEMORY_SCOPE_AGENT); }
DI unsigned xb_add(unsigned* p, unsigned v) { return __hip_atomic_fetch_add(p, v, __ATOMIC_RELAXED, __HIP_MEMORY_SCOPE_AGENT); }
DI unsigned xb_xcc_id() { return (unsigned)__builtin_amdgcn_s_getreg((3 << 11) | 20) & 0xFu; }
#define XB_SPIN(cond, bar)                                                                         \
    do {                                                                                           \
        unsigned _sp = 0;                                                                          \
        while (cond) {                                                                             \
            __builtin_amdgcn_s_sleep(1);                                                           \
            if ((++_sp & 255u) == 0u) {                                                            \
                if (xb_ld(&(bar)[XB_TMO])) break;                                                  \
                if (_sp > XB_SPIN_CAP) { atomicAdd(&(bar)[XB_TMO], 1u); break; }                   \
            }                                                                                      \
        }                                                                                          \
    } while (0)
struct XcdBarrier { unsigned* bar; unsigned x; volatile LAS unsigned* st; };
DI XcdBarrier xcd_barrier_post(unsigned* bar, volatile LAS unsigned* st) {
    XcdBarrier b; b.bar = bar; b.x = xb_xcc_id(); b.st = st;
    if (threadIdx.x == 0) (void)xb_add(&bar[XB_XCNT(b.x)], 1u);
    return b;
}
DI void xcd_barrier_complete(unsigned* bar, unsigned x, unsigned& nloc, unsigned& nx) {
    const unsigned G = gridDim.x * gridDim.y * gridDim.z;
    unsigned sum, cnt, mine, sp = 0u;
    for (;;) {
        sum = 0u; cnt = 0u; mine = 0u;
#pragma unroll
        for (unsigned j = 0; j < 16; ++j) { const unsigned c = xb_ld(&bar[XB_XCNT(j)]); sum += c; cnt += (c > 0u) ? 1u : 0u; mine = (j == x) ? c : mine; }
        if (sum == G) break;
        __builtin_amdgcn_s_sleep(1);
        if ((++sp & 255u) == 0u) { if (xb_ld(&bar[XB_TMO])) break; if (sp > XB_SPIN_CAP) { atomicAdd(&bar[XB_TMO], 1u); break; } }
    }
    nloc = mine > 0u ? mine : 1u; nx = cnt > 0u ? cnt : 1u;
}
DI void xcd_barrier(const XcdBarrier& b) {
    asm volatile("s_waitcnt vmcnt(0)" ::: "memory");
    __syncthreads();
    if (threadIdx.x == 0) {
        unsigned* bar = b.bar;
        __builtin_amdgcn_s_waitcnt(0);
        unsigned nloc = b.st[0], nx = b.st[1];
        if (nloc == 0u) { xcd_barrier_complete(bar, b.x, nloc, nx); b.st[0] = nloc; b.st[1] = nx; }
        const unsigned old = xb_add(&bar[XB_XSUB(b.x)], 1u);
        const unsigned gen = old / nloc;
        if (old + 1u == (gen + 1u) * nloc) {
            __builtin_amdgcn_fence(__ATOMIC_RELEASE, "agent");
            asm volatile("s_waitcnt vmcnt(0)" ::: "memory");
            const unsigned og = xb_add(&bar[XB_TOP], 1u);
            const unsigned tg = og / nx;
            if (og + 1u == (tg + 1u) * nx) xb_add(&bar[XB_TOPGEN], 1u);
            else XB_SPIN(xb_ld(&bar[XB_TOPGEN]) == tg, bar);
            __builtin_amdgcn_fence(__ATOMIC_ACQUIRE, "agent");
            xb_add(&bar[XB_XGEN(b.x)], 1u);
            asm volatile("s_waitcnt vmcnt(0)" ::: "memory");
        } else {
            XB_SPIN(xb_ld(&bar[XB_XGEN(b.x)]) == gen, bar);
            __builtin_amdgcn_fence(__ATOMIC_ACQUIRE, "agent");
            asm volatile("s_waitcnt vmcnt(0)" ::: "memory");
        }
    }
    __syncthreads();
}

DI void gemm_tile(const bf16_t* __restrict__ A, int lda, const bf16_t* __restrict__ B, int ldb, int K, char* lds, f32x16 (&acc)[2][2]) {
    int tid = threadIdx.x; asm volatile("" : "+v"(tid));
    const int lane = tid & 63, wid = tid >> 6, wr = wid >> 1, wc = wid & 1, r = lane & 31, h = lane >> 5;
#pragma unroll
    for (int i = 0; i < 2; ++i)
#pragma unroll
        for (int j = 0; j < 2; ++j)
#pragma unroll
            for (int e = 0; e < 16; ++e) acc[i][j][e] = 0.f;
    const int lrow = tid >> 3, lkc = tid & 7;
    const bf16_t* ga = A + (size_t)lrow * lda + lkc * 8;
    const bf16_t* gb = B + (size_t)lrow * ldb + lkc * 8;
    const int wofs = lrow * 128 + ((lkc ^ ((lrow >> 1) & 7)) << 4);
    const int swz = (r >> 1) & 7;
    const int aofs = (wr * 64 + r) * 128, bofs = 16384 + (wc * 64 + r) * 128;
    u32x4 ra[4], rb[4];
#pragma unroll
    for (int i = 0; i < 4; ++i) { ra[i] = *(const u32x4*)(ga + (size_t)i * 32 * lda); rb[i] = *(const u32x4*)(gb + (size_t)i * 32 * ldb); }
#pragma unroll
    for (int i = 0; i < 4; ++i) { *(u32x4*)(lds + wofs + i * 4096) = ra[i]; *(u32x4*)(lds + 16384 + wofs + i * 4096) = rb[i]; }
    __syncthreads();
    const int nt = K >> 6;
    for (int t = 0; t < nt; ++t) {
        const int cur = (t & 1) * 32768, nxt = 32768 - cur;
        if (t + 1 < nt) {
            const int k0 = (t + 1) << 6;
#pragma unroll
            for (int i = 0; i < 4; ++i) { ra[i] = *(const u32x4*)(ga + (size_t)i * 32 * lda + k0); rb[i] = *(const u32x4*)(gb + (size_t)i * 32 * ldb + k0); }
        }
#pragma unroll
        for (int ks = 0; ks < 4; ++ks) {
            const int co = ((ks * 2 + h) ^ swz) << 4;
            bf16x8 a0 = *(const bf16x8*)(lds + cur + aofs + co);
            bf16x8 a1 = *(const bf16x8*)(lds + cur + aofs + 4096 + co);
            bf16x8 b0 = *(const bf16x8*)(lds + cur + bofs + co);
            bf16x8 b1 = *(const bf16x8*)(lds + cur + bofs + 4096 + co);
            acc[0][0] = MFMA(b0, a0, acc[0][0]);
            acc[0][1] = MFMA(b1, a0, acc[0][1]);
            acc[1][0] = MFMA(b0, a1, acc[1][0]);
            acc[1][1] = MFMA(b1, a1, acc[1][1]);
        }
        if (t + 1 < nt) {
#pragma unroll
            for (int i = 0; i < 4; ++i) { *(u32x4*)(lds + nxt + wofs + i * 4096) = ra[i]; *(u32x4*)(lds + nxt + 16384 + wofs + i * 4096) = rb[i]; }
        }
        __syncthreads();
    }
}

DI void st_bf16_tile(bf16_t* dst, const f32x16& v, int h) {
#pragma unroll
    for (int q = 0; q < 4; ++q) {
        u32x2 w; w.x = pk_bf16(v[4 * q], v[4 * q + 1]); w.y = pk_bf16(v[4 * q + 2], v[4 * q + 3]);
        *(u32x2*)(dst + 8 * q + 4 * h) = w;
    }
}
DI void st_f32_tile(float* dst, const f32x16& v, int h) {
#pragma unroll
    for (int q = 0; q < 4; ++q) { f32x4 w = {v[4 * q], v[4 * q + 1], v[4 * q + 2], v[4 * q + 3]}; *(f32x4*)(dst + 8 * q + 4 * h) = w; }
}
DI void st_bf16_tile_T(bf16_t* dst, size_t ld, const f32x16& v, int h) {
#pragma unroll
    for (int e = 0; e < 16; ++e) dst[(size_t)crow(e, h) * ld] = to_bf16(v[e]);
}
DI float sumsq16(const f32x16& v) { float s = 0.f;
#pragma unroll
    for (int e = 0; e < 16; ++e) s += v[e] * v[e];
    return s; }

DI const float* win_src(const float* w, int nd) {
    int sc;
    if (nd < 640) sc = nd; else if (nd < 1024) sc = 928 + (nd - 640); else if (nd < 1152) sc = 1312 + (nd - 1024); else if (nd < 1280) sc = 1440 + (nd - 1152);
    else if (nd < 1536) sc = 672 + (nd - 1280); else if (nd < 1568) sc = 640 + (nd - 1536); else return nullptr;
    return w + sc;
}
DI void tr_tile(const float* colp, int nsrc, bf16_t* dst, int K, int k0, int nd0, const float* kscale, float* tile) {
    const int tid = threadIdx.x, tn = tid & 63, tk = tid >> 6;
#pragma unroll 4
    for (int kk = tk; kk < 64; kk += 4) {
        float v = colp ? colp[(size_t)(k0 + kk) * nsrc] : 0.f;
        if (kscale) v *= kscale[k0 + kk];
        tile[kk * 65 + tn] = v;
    }
    __syncthreads();
    const int rr = tid >> 2, kq = tid & 3;
    u32x4 o0, o1;
    const float* tp = tile + (kq * 16) * 65 + rr;
    o0.x = pk_bf16(tp[0 * 65], tp[1 * 65]); o0.y = pk_bf16(tp[2 * 65], tp[3 * 65]); o0.z = pk_bf16(tp[4 * 65], tp[5 * 65]); o0.w = pk_bf16(tp[6 * 65], tp[7 * 65]);
    o1.x = pk_bf16(tp[8 * 65], tp[9 * 65]); o1.y = pk_bf16(tp[10 * 65], tp[11 * 65]); o1.z = pk_bf16(tp[12 * 65], tp[13 * 65]); o1.w = pk_bf16(tp[14 * 65], tp[15 * 65]);
    bf16_t* d = dst + (size_t)(nd0 + rr) * K + k0 + kq * 16;
    *(u32x4*)d = o0; *(u32x4*)(d + 8) = o1;
    __syncthreads();
}

DI void phase_prologue(KPR p, char* lds) {
    const int tid = threadIdx.x, bid = blockIdx.x, G = gridDim.x;
    float* tile = (float*)lds;
    for (int task = bid; task < 768; task += G) {
        const int l = task / 384, rem = task % 384, kc = rem / 24, cb = rem % 24;
        if (tid < 192) { const int j = tid >> 6, k = kc * 64 + (tid & 63); const float cv = (j == 0) ? p.c_ctx[k] : p.c[(j - 1) * 1024 + k]; tile[tid] = silu(cv); }
        __syncthreads();
        const int n = cb * 256 + tid;
        const float* w = p.w_ada + ((size_t)l * 1024 + kc * 64) * 6144 + n;
        float s0 = 0.f, s1 = 0.f, s2 = 0.f;
#pragma unroll 8
        for (int k = 0; k < 64; ++k) { const float wv = w[(size_t)k * 6144]; s0 += tile[k] * wv; s1 += tile[64 + k] * wv; s2 += tile[128 + k] * wv; }
        if (kc == 0) { const float bv = p.b_ada[l * 6144 + n]; s0 += bv; s1 += bv; s2 += bv; }
        float* m = p.mod + (size_t)l * 3 * 6144 + n;
        atomicAdd(m, s0); atomicAdd(m + 6144, s1); atomicAdd(m + 2 * 6144, s2);
        __syncthreads();
    }
    for (int tt = bid; tt < 2 * 2940; tt += G) {
        const int l = tt / 2940; int t = tt % 2940;
        const int tn = tid & 63;
        if (t < 416) { const int kt = t / 26, nt = t % 26; const float* w = p.w_in + (size_t)l * 1024 * 1568;
            tr_tile(win_src(w, nt * 64 + tn), 1568, p.wt_in + l * SZ_WIN, 1024, kt * 64, nt * 64, nullptr, tile); continue; }
        t -= 416;
        if (t < 60) { const int kt = t / 10, nt = t % 10; const float* w = p.w_q_up + (size_t)l * 384 * 576; const int nd = nt * 64 + tn;
            tr_tile(nd < 576 ? w + nd : nullptr, 576, p.wt_qup + l * SZ_QUP, 384, kt * 64, nt * 64, p.g_q_a + l * 384, tile); continue; }
        t -= 60;
        if (t < 96) { const int var = t / 48; t %= 48; const int kt = t / 12, nt = t % 12; const float* w = p.w_kv_up + (size_t)l * 256 * 768;
            tr_tile(w + nt * 64 + tn, 768, (var ? p.wt_kvp : p.wt_kvg) + l * SZ_KV, 256, kt * 64, nt * 64, var ? nullptr : p.g_kv_a + l * 256, tile); continue; }
        t -= 96;
        if (t < 256) { const int kt = t / 16, nt = t % 16; const float* w = p.w_out + (size_t)l * 1024 * 1024;
            tr_tile(w + nt * 64 + tn, 1024, p.wt_out + l * SZ_WOUT, 1024, kt * 64, nt * 64, nullptr, tile); continue; }
        t -= 256;
        if (t < 1408) { const int kt = t / 88, nt = t % 88; const float* w = (tn < 32 ? p.w_gate : p.w_up) + (size_t)l * 1024 * 2816 + nt * 32 + (tn & 31);
            tr_tile(w, 2816, p.wt_gu + l * SZ_GU, 1024, kt * 64, nt * 64, nullptr, tile); continue; }
        t -= 1408;
        { const int kt = t / 16, nt = t % 16; const float* w = p.w_down + (size_t)l * 2816 * 1024;
            tr_tile(w + nt * 64 + tn, 1024, p.wt_down + l * SZ_DOWN, 2816, kt * 64, nt * 64, nullptr, tile); }
    }
    const int gt = bid * 256 + tid, GT = G * 256;
    for (int i = gt; i < 2048 * 512; i += GT) {
        const int pp = i >> 9, k8 = (i & 511) * 8; u32x4 o; unsigned w[4];
#pragma unroll
        for (int e = 0; e < 4; ++e) { float v[2];
#pragma unroll
            for (int z = 0; z < 2; ++z) { const int kq = k8 + 2 * e + z; const int m = (pp * (kq & 2047)) & 2047; const float a = (float)m * (1.f / 1024.f);
                v[z] = (kq < 2048 ? cospif(a) : -sinpif(a)) * 0.022097086912079608f; }
            w[e] = pk_bf16(v[0], v[1]); }
        o.x = w[0]; o.y = w[1]; o.z = w[2]; o.w = w[3];
        *(u32x4*)(p.tab2048 + (size_t)pp * 4096 + k8) = o;
    }
    for (int i = gt; i < 256 * 512; i += GT) { const int pp = i >> 9, kq = i & 511; const int m = (pp * (kq & 255)) & 255; const float a = (float)m * (1.f / 128.f);
        p.tab256[i] = to_bf16((kq < 256 ? cospif(a) : -sinpif(a)) * 0.0625f); }
    for (int i = gt; i < 128 * 64; i += GT) { const int n = i >> 6, k = i & 63; const int m = ((n & 63) * k) & 63; const float a = (float)m * (1.f / 32.f);
        p.bt_ch[i] = to_bf16((n < 64 ? cospif(a) : sinpif(a)) * 0.125f); }
    for (int i = gt; i < 2048 * 32; i += GT) { const int t = i >> 5, pr = i & 31; const float inv = powf(10000.f, -(float)(pr & 15) * (1.f / 16.f));
        const float pos = (float)(pr < 16 ? (t >> 6) : (t & 63)); const float ang = pos * inv; f32x2 cs = {cosf(ang), sinf(ang)}; p.rope_g[i] = cs; }
    for (int i = gt; i < 2048 * 16; i += GT) { const int t = i >> 4, pr = i & 15; const float inv = powf(10000.f, -(float)(pr & 7) * (1.f / 8.f));
        const float pos = (float)(pr < 8 ? (t >> 6) : (t & 63)); const float ang = pos * inv; f32x2 cs = {cosf(ang), sinf(ang)}; p.rope_m[i] = cs; }
    for (int i = gt; i < 2 * 2 * 256 * 256; i += GT) p.ckv_cache[i] = to_bf16(p.c_ckv[i]);
    for (int i = gt; i < 2 * 2 * 256 * 32; i += GT) {
        const int d = i & 31, s = (i >> 5) & 255, l = (i >> 13) & 1, b = i >> 14; const bf16_t v = to_bf16(p.c_krope[i]);
        bf16_t* dst = p.kmla_den + ((size_t)((l * 2 + b) * 2304 + s) * 6) * 96 + 64 + d;
#pragma unroll
        for (int hh = 0; hh < 6; ++hh) dst[hh * 96] = v;
    }
    for (int i = gt; i < 2 * 2 * 256 * 128; i += GT) {
        const int d = i & 63, hk = (i >> 6) & 1, s = (i >> 7) & 255, l = (i >> 15) & 1, b = i >> 16;
        p.kgqa_den[((size_t)((l * 2 + b) * 2304 + s) * 2 + hk) * 64 + d] = to_bf16(p.c_gk[i]);
        p.vtgqa_den[((size_t)((l * 2 + b) * 2 + hk) * 64 + d) * 2304 + s] = to_bf16(p.c_gv[i]);
    }
}

DI void phase_norm(KPR p, const float* xc, const float* xd, const float* g, const float* modl, int shift_off, int scale_off) {
    const int lane = threadIdx.x & 63, gw = blockIdx.x * 4 + (threadIdx.x >> 6), nw = gridDim.x * 4;
    for (int T = gw; T < NTOK; T += nw) {
        const float* xr = T < NCTX ? xc + (size_t)T * D : xd + (size_t)(T - NCTX) * D;
        const float* mj = modl + (T < NCTX ? 0 : 1 + ((T - NCTX) >> 11)) * 6144;
        f32x4 v[4]; float ss = 0.f;
#pragma unroll
        for (int i = 0; i < 4; ++i) { v[i] = *(const f32x4*)(xr + lane * 4 + i * 256); ss += v[i].x * v[i].x + v[i].y * v[i].y + v[i].z * v[i].z + v[i].w * v[i].w; }
#pragma unroll
        for (int o = 32; o >= 1; o >>= 1) ss += __shfl_xor(ss, o);
        const float rs = rsqrtf(ss * (1.f / 1024.f) + EPS);
#pragma unroll
        for (int i = 0; i < 4; ++i) {
            const int c = lane * 4 + i * 256;
            const f32x4 gg = *(const f32x4*)(g + c), sc = *(const f32x4*)(mj + scale_off + c), sh = *(const f32x4*)(mj + shift_off + c);
            u32x2 w; w.x = pk_bf16(v[i].x * rs * gg.x * (1.f + sc.x) + sh.x, v[i].y * rs * gg.y * (1.f + sc.y) + sh.y);
            w.y = pk_bf16(v[i].z * rs * gg.z * (1.f + sc.z) + sh.z, v[i].w * rs * gg.w * (1.f + sc.w) + sh.w);
            *(u32x2*)(p.h + (size_t)T * D + c) = w;
        }
    }
}
DI void phase_final(KPR p, const float* x) {
    const int lane = threadIdx.x & 63, gw = blockIdx.x * 4 + (threadIdx.x >> 6), nw = gridDim.x * 4;
    for (int T = gw; T < NTOK; T += nw) {
        const float* xr = x + (size_t)T * D; f32x4 v[4]; float ss = 0.f;
#pragma unroll
        for (int i = 0; i < 4; ++i) { v[i] = *(const f32x4*)(xr + lane * 4 + i * 256); ss += v[i].x * v[i].x + v[i].y * v[i].y + v[i].z * v[i].z + v[i].w * v[i].w; }
#pragma unroll
        for (int o = 32; o >= 1; o >>= 1) ss += __shfl_xor(ss, o);
        const float rs = rsqrtf(ss * (1.f / 1024.f) + EPS);
#pragma unroll
        for (int i = 0; i < 4; ++i) { const int c = lane * 4 + i * 256; const f32x4 gg = *(const f32x4*)(p.g_final + c);
            f32x4 o = {v[i].x * rs * gg.x, v[i].y * rs * gg.y, v[i].z * rs * gg.z, v[i].w * rs * gg.w}; *(f32x4*)(p.out + (size_t)T * D + c) = o; }
    }
}

DI void rope_pair(float& x1, float& x2, const f32x2 cs) { const float a = x1 * cs.x - x2 * cs.y, b = x2 * cs.x + x1 * cs.y; x1 = a; x2 = b; }
DI void epi_win(KPR p, int l, f32x16 (&acc)[2][2], int tok0, int cb, int r, int h) {
#pragma unroll
    for (int i = 0; i < 2; ++i) {
        const int T = tok0 + i * 32 + r; const bool den = T >= NCTX;
        int b, s; if (!den) { b = T >> 8; s = T & 255; } else { b = (T - NCTX) >> 11; s = (T - NCTX) & 2047; }
        if (cb < 640) {
            float ss = sumsq16(acc[i][0]) + sumsq16(acc[i][1]); ss += __shfl_xor(ss, 32);
            if (cb < 384) {
                bf16_t* dst = p.cq + (size_t)T * 384 + cb; st_bf16_tile(dst, acc[i][0], h); st_bf16_tile(dst + 32, acc[i][1], h);
                if (h == 0) p.ssq_q[T * 6 + (cb >> 6)] = ss;
            } else {
                const int c0 = cb - 384; bf16_t* dst = p.ckv + (size_t)T * 256 + c0; st_bf16_tile(dst, acc[i][0], h); st_bf16_tile(dst + 32, acc[i][1], h);
                if (h == 0) p.ssq_kv[T * 4 + (c0 >> 6)] = ss;
                if (!den) { float* o = p.out + OFF_CKV + ((size_t)((b * 2 + l) * 256 + s)) * 256 + c0; st_f32_tile(o, acc[i][0], h); st_f32_tile(o + 32, acc[i][1], h); }
            }
        } else if (cb < 1152) {
            float ss = sumsq16(acc[i][0]) + sumsq16(acc[i][1]); ss += __shfl_xor(ss, 32);
            const float rs = rsqrtf(ss * (1.f / 64.f) + EPS);
            const bool isq = cb < 1024;
            const float* g = (isq ? p.g_q_head : p.g_k_head) + l * 64;
            f32x16 v0, v1;
#pragma unroll
            for (int e = 0; e < 16; ++e) { const int d = crow(e, h); v0[e] = acc[i][0][e] * rs * g[d]; v1[e] = acc[i][1][e] * rs * g[32 + d]; }
            if (!isq && !den) {
                const int hk = (cb - 1024) >> 6;
                float* o = p.out + OFF_GK + ((size_t)(((b * 2 + l) * 256 + s) * 2 + hk)) * 64; st_f32_tile(o, v0, h); st_f32_tile(o + 32, v1, h);
            }
            if (den) {
#pragma unroll
                for (int e = 0; e < 16; ++e) { const f32x2 cs = p.rope_g[s * 32 + crow(e, h)]; float x1 = v0[e], x2 = v1[e]; rope_pair(x1, x2, cs); v0[e] = x1; v1[e] = x2; }
            }
            if (isq) {
                const float qs = 0.125f * LOG2E;
#pragma unroll
                for (int e = 0; e < 16; ++e) { v0[e] *= qs; v1[e] *= qs; }
                bf16_t* dst = p.gq + (size_t)T * 384 + (cb - 640); st_bf16_tile(dst, v0, h); st_bf16_tile(dst + 32, v1, h);
            } else {
                const int hk = (cb - 1024) >> 6;
                bf16_t* dst = den ? p.kgqa_den + ((size_t)((l * 2 + b) * 2304 + 256 + s) * 2 + hk) * 64 : p.kgqa_ctx + ((size_t)(b * 256 + s) * 2 + hk) * 64;
                st_bf16_tile(dst, v0, h); st_bf16_tile(dst + 32, v1, h);
            }
        } else if (cb < 1280) {
            const int hk = (cb - 1152) >> 6;
            if (!den) {
                float* o = p.out + OFF_GV + ((size_t)(((b * 2 + l) * 256 + s) * 2 + hk)) * 64; st_f32_tile(o, acc[i][0], h); st_f32_tile(o + 32, acc[i][1], h);
                bf16_t* dst = p.vtgqa_ctx + ((size_t)(b * 2 + hk) * 64) * 256 + s; st_bf16_tile_T(dst, 256, acc[i][0], h); st_bf16_tile_T(dst + 32 * 256, 256, acc[i][1], h);
            } else {
                bf16_t* dst = p.vtgqa_den + ((size_t)((l * 2 + b) * 2 + hk) * 64) * 2304 + 256 + s; st_bf16_tile_T(dst, 2304, acc[i][0], h); st_bf16_tile_T(dst + 32 * 2304, 2304, acc[i][1], h);
            }
        } else if (cb < 1536) {
            bf16_t* dst = p.u + (size_t)T * 256 + (cb - 1280); st_bf16_tile(dst, acc[i][0], h); st_bf16_tile(dst + 32, acc[i][1], h);
        } else if (cb == 1536) {
            f32x16 v = acc[i][0];
            if (!den) {
                float* o = p.out + OFF_KROPE + ((size_t)((b * 2 + l) * 256 + s)) * 32; st_f32_tile(o, v, h);
                bf16_t* dst = p.kmla_ctx + ((size_t)(b * 256 + s) * 6) * 96 + 64;
#pragma unroll
                for (int hh = 0; hh < 6; ++hh) st_bf16_tile(dst + hh * 96, v, h);
            } else {
#pragma unroll
                for (int e = 0; e < 8; ++e) { const f32x2 cs = p.rope_m[s * 16 + crow(e, h)]; float x1 = v[e], x2 = v[e + 8]; rope_pair(x1, x2, cs); v[e] = x1; v[e + 8] = x2; }
                bf16_t* dst = p.kmla_den + ((size_t)((l * 2 + b) * 2304 + 256 + s) * 6) * 96 + 64;
#pragma unroll
                for (int hh = 0; hh < 6; ++hh) st_bf16_tile(dst + hh * 96, v, h);
            }
        }
    }
}

#define FOR_TILES_64M(NT, mvar, nvar)                                                             \
    for (int _lid = (int)(blockIdx.x >> 3), mvar = 8 * (int)(blockIdx.x & 7) + (_lid & 7), nvar = _lid >> 3; _lid < 8 * (NT);     \
         _lid += (int)(gridDim.x >> 3), mvar = 8 * (int)(blockIdx.x & 7) + (_lid & 7), nvar = _lid >> 3)

DI void phase_win(KPR p, int l, char* lds) {
    const int tid = threadIdx.x, lane = tid & 63, wid = tid >> 6, wr = wid >> 1, wc = wid & 1, r = lane & 31, h = lane >> 5;
    FOR_TILES_64M(13, m, n) {
        f32x16 acc[2][2];
        gemm_tile(p.h + (size_t)m * 128 * D, D, p.wt_in + l * SZ_WIN + (size_t)n * 128 * D, D, D, lds, acc);
        epi_win(p, l, acc, m * 128 + wr * 64, n * 128 + wc * 64, r, h);
    }
}

DI void phase_mid(KPR p, int l, char* lds) {
    const int tid = threadIdx.x, lane = tid & 63, wid = tid >> 6, wr = wid >> 1, wc = wid & 1, r = lane & 31, h = lane >> 5;
    for (int t = blockIdx.x; t < 984; t += gridDim.x) {
        f32x16 acc[2][2];
        if (t < 320) {
            const int m = t / 5, n = t % 5;
            gemm_tile(p.cq + (size_t)m * 128 * 384, 384, p.wt_qup + l * SZ_QUP + (size_t)n * 128 * 384, 384, 384, lds, acc);
            const int cb = n * 128 + wc * 64;
#pragma unroll
            for (int i = 0; i < 2; ++i) {
                const int T = m * 128 + wr * 64 + i * 32 + r; const bool den = T >= NCTX; const int s = (T - NCTX) & 2047;
                float ss = 0.f;
#pragma unroll
                for (int k = 0; k < 6; ++k) ss += p.ssq_q[T * 6 + k];
                const float rs = rsqrtf(ss * (1.f / 384.f) + EPS) * (0.10206207261596575f * LOG2E);
#pragma unroll
                for (int j = 0; j < 2; ++j) {
                    const int ct = (cb >> 5) + j; if (ct >= 18) continue;
                    f32x16 v;
#pragma unroll
                    for (int e = 0; e < 16; ++e) v[e] = acc[i][j][e] * rs;
                    if ((ct % 3) == 2 && den) {
#pragma unroll
                        for (int e = 0; e < 8; ++e) { const f32x2 cs = p.rope_m[s * 16 + crow(e, h)]; float x1 = v[e], x2 = v[e + 8]; rope_pair(x1, x2, cs); v[e] = x1; v[e + 8] = x2; }
                    }
                    st_bf16_tile(p.qmla + (size_t)T * 576 + ct * 32, v, h);
                }
            }
        } else if (t < 728) {
            const int tt = t - 320, mt = tt / 6, hd = tt % 6;
            const bf16_t* A; const bf16_t* W; int kind, b = 0, s0 = 0, T0 = 0;
            if (mt < 64) { T0 = mt * 128; A = p.ckv + (size_t)T0 * 256; W = p.wt_kvg; kind = mt < 32 ? 0 : 1; if (kind == 0) { b = T0 >> 8; s0 = T0 & 255; } else { b = (T0 - NCTX) >> 11; s0 = 256 + ((T0 - NCTX) & 2047); } }
            else { const int idx = mt - 64; b = idx >> 1; s0 = (idx & 1) * 128; A = p.ckv_cache + ((size_t)(b * 2 + l) * 256 + s0) * 256; W = p.wt_kvp; kind = 2; }
            gemm_tile(A, 256, W + l * SZ_KV + (size_t)hd * 128 * 256, 256, 256, lds, acc);
#pragma unroll
            for (int i = 0; i < 2; ++i) {
                const int ro = wr * 64 + i * 32 + r; float rs = 1.f;
                if (kind < 2) { const int T = T0 + ro; const float ss = p.ssq_kv[T * 4] + p.ssq_kv[T * 4 + 1] + p.ssq_kv[T * 4 + 2] + p.ssq_kv[T * 4 + 3]; rs = rsqrtf(ss * (1.f / 256.f) + EPS); }
                const int key = s0 + ro;
                f32x16 v0, v1;
#pragma unroll
                for (int e = 0; e < 16; ++e) { v0[e] = acc[i][0][e] * rs; v1[e] = acc[i][1][e] * rs; }
                if (wc == 0) {
                    bf16_t* dst = kind == 0 ? p.kmla_ctx + ((size_t)(b * 256 + key) * 6 + hd) * 96 : p.kmla_den + ((size_t)((l * 2 + b) * 2304 + key) * 6 + hd) * 96;
                    st_bf16_tile(dst, v0, h); st_bf16_tile(dst + 32, v1, h);
                } else {
                    if (kind == 0) { bf16_t* dst = p.vtmla_ctx + ((size_t)(b * 6 + hd) * 64) * 256 + key; st_bf16_tile_T(dst, 256, v0, h); st_bf16_tile_T(dst + 32 * 256, 256, v1, h); }
                    else { bf16_t* dst = p.vtmla_den + ((size_t)((l * 2 + b) * 6 + hd) * 64) * 2304 + key; st_bf16_tile_T(dst, 2304, v0, h); st_bf16_tile_T(dst + 32 * 2304, 2304, v1, h); }
                }
            }
        } else {
            const int tt = t - 728, m = tt >> 2, g = tt & 3;
            gemm_tile(p.u + (size_t)m * 128 * 256 + g * 64, 256, p.bt_ch, 64, 64, lds, acc);
#pragma unroll
            for (int i = 0; i < 2; ++i) {
                const int T = m * 128 + wr * 64 + i * 32 + r; const bool den = T >= NCTX;
#pragma unroll
                for (int j = 0; j < 2; ++j) {
                    const int c = g * 64 + j * 32;
                    if (!den) { const int b = T >> 8, s = T & 255; st_bf16_tile_T(p.zt_ctx + ((size_t)(b * 256 + c)) * 512 + wc * 256 + s, 512, acc[i][j], h); }
                    else { const int b = (T - NCTX) >> 11, s = (T - NCTX) & 2047; st_bf16_tile_T(p.zt_den + ((size_t)(b * 256 + c)) * 4096 + wc * 2048 + s, 4096, acc[i][j], h); }
                }
            }
        }
    }
    for (int i = blockIdx.x * 256 + tid; i < NCTX * 64; i += gridDim.x * 256) {
        const int T = i >> 6, c = (i & 63) * 4, b = T >> 8, s = T & 255;
        const float ss = p.ssq_kv[T * 4] + p.ssq_kv[T * 4 + 1] + p.ssq_kv[T * 4 + 2] + p.ssq_kv[T * 4 + 3]; const float rs = rsqrtf(ss * (1.f / 256.f) + EPS);
        float* o = p.out + OFF_CKV + ((size_t)((b * 2 + l) * 256 + s)) * 256 + c; f32x4 v = *(f32x4*)o; const f32x4 g = *(const f32x4*)(p.g_kv_a + l * 256 + c);
        v.x *= rs * g.x; v.y *= rs * g.y; v.z *= rs * g.z; v.w *= rs * g.w; *(f32x4*)o = v;
    }
}

template <int DQK>
DI void attn_item(const bf16_t* __restrict__ Q, int ldq, const bf16_t* __restrict__ Kp, int ldk, const bf16_t* __restrict__ Vt, int ldv, int Sk, bf16_t* O, int ldo, char* lds) {
    constexpr int KSTR = DQK * 2 + 16, VSTR = 136, KBYTES = 64 * KSTR, STAGE = KBYTES + 64 * VSTR, KCH = DQK / 8, NKL = (64 * KCH) / 256;
    int tid = threadIdx.x; asm volatile("" : "+v"(tid));
    const int lane = tid & 63, w = tid >> 6, r = lane & 31, h = lane >> 5;
    bf16x8 qf[DQK / 16];
#pragma unroll
    for (int ks = 0; ks < DQK / 16; ++ks) qf[ks] = *(const bf16x8*)(Q + (size_t)(w * 32 + r) * ldq + ks * 16 + h * 8);
    f32x16 oacc[2];
#pragma unroll
    for (int e = 0; e < 16; ++e) { oacc[0][e] = 0.f; oacc[1][e] = 0.f; }
    float mrun = -INFINITY, lrun = 0.f;
    u32x4 rk[NKL], rv[2];
    int krow_[NKL], kch_[NKL];
#pragma unroll
    for (int i = 0; i < NKL; ++i) { const int c = tid + 256 * i; krow_[i] = c / KCH; kch_[i] = c % KCH; }
    const int vrow = tid >> 3, vch = tid & 7;
    auto gload = [&](int kt) {
#pragma unroll
        for (int i = 0; i < NKL; ++i) rk[i] = *(const u32x4*)(Kp + (size_t)(kt * 64 + krow_[i]) * ldk + kch_[i] * 8);
#pragma unroll
        for (int i = 0; i < 2; ++i) rv[i] = *(const u32x4*)(Vt + (size_t)(vrow + 32 * i) * ldv + kt * 64 + vch * 8);
    };
    auto lstore = [&](int buf) {
        char* base = lds + buf * STAGE;
#pragma unroll
        for (int i = 0; i < NKL; ++i) *(u32x4*)(base + krow_[i] * KSTR + kch_[i] * 16) = rk[i];
#pragma unroll
        for (int i = 0; i < 2; ++i) { char* d = base + KBYTES + (vrow + 32 * i) * VSTR + vch * 16; u32x2 lo = {rv[i].x, rv[i].y}, hi = {rv[i].z, rv[i].w}; *(u32x2*)d = lo; *(u32x2*)(d + 8) = hi; }
    };
    gload(0); lstore(0); __syncthreads();
    const int nkt = Sk >> 6;
    for (int kt = 0; kt < nkt; ++kt) {
        const char* kb = lds + (kt & 1) * STAGE; const char* vb = kb + KBYTES;
        if (kt + 1 < nkt) gload(kt + 1);
        f32x16 sacc[2];
#pragma unroll
        for (int sub = 0; sub < 2; ++sub) {
#pragma unroll
            for (int e = 0; e < 16; ++e) sacc[sub][e] = 0.f;
#pragma unroll
            for (int ks = 0; ks < DQK / 16; ++ks) {
                const bf16x8 kf = *(const bf16x8*)(kb + (sub * 32 + r) * KSTR + (ks * 2 + h) * 16);
                sacc[sub] = MFMA(kf, qf[ks], sacc[sub]);
            }
            __builtin_amdgcn_sched_barrier(0);
        }
        float mx = sacc[0][0];
#pragma unroll
        for (int e = 1; e < 16; ++e) mx = fmaxf(mx, sacc[0][e]);
#pragma unroll
        for (int e = 0; e < 16; ++e) mx = fmaxf(mx, sacc[1][e]);
        mx = fmaxf(mx, __shfl_xor(mx, 32));
        const float mnew = fmaxf(mrun, mx);
        const float alpha = __builtin_amdgcn_exp2f(mrun - mnew);
        mrun = mnew;
        float psum = 0.f;
#pragma unroll
        for (int sub = 0; sub < 2; ++sub)
#pragma unroll
            for (int e = 0; e < 16; ++e) { const float pv = __builtin_amdgcn_exp2f(sacc[sub][e] - mnew); sacc[sub][e] = pv; psum += pv; }
        lrun = lrun * alpha + psum;
#pragma unroll
        for (int e = 0; e < 16; ++e) { oacc[0][e] *= alpha; oacc[1][e] *= alpha; }
#pragma unroll
        for (int sub = 0; sub < 2; ++sub)
#pragma unroll
            for (int s2 = 0; s2 < 2; ++s2) {
                u32x4 pw; pw.x = pk_bf16(sacc[sub][8 * s2 + 0], sacc[sub][8 * s2 + 1]); pw.y = pk_bf16(sacc[sub][8 * s2 + 2], sacc[sub][8 * s2 + 3]);
                pw.z = pk_bf16(sacc[sub][8 * s2 + 4], sacc[sub][8 * s2 + 5]); pw.w = pk_bf16(sacc[sub][8 * s2 + 6], sacc[sub][8 * s2 + 7]);
                const bf16x8 pf = __builtin_bit_cast(bf16x8, pw);
#pragma unroll
                for (int dvt = 0; dvt < 2; ++dvt) {
                    const char* va = vb + (dvt * 32 + r) * VSTR + (sub * 32 + s2 * 16 + 4 * h) * 2;
                    const s16x4 lo = *(const s16x4*)va, hi = *(const s16x4*)(va + 16);
                    const bf16x8 vf = __builtin_shufflevector(lo, hi, 0, 1, 2, 3, 4, 5, 6, 7);
                    oacc[dvt] = MFMA(vf, pf, oacc[dvt]);
                }
                __builtin_amdgcn_sched_barrier(0);
            }
        if (kt + 1 < nkt) lstore((kt + 1) & 1);
        __syncthreads();
    }
    lrun += __shfl_xor(lrun, 32);
    const float inv = 1.f / lrun;
#pragma unroll
    for (int dvt = 0; dvt < 2; ++dvt) {
        f32x16 v;
#pragma unroll
        for (int e = 0; e < 16; ++e) v[e] = oacc[dvt][e] * inv;
        st_bf16_tile(O + (size_t)(w * 32 + r) * ldo + dvt * 32, v, h);
    }
}

DI void phase_mix(KPR p, int l, char* lds, unsigned* ctr) {
    const int tid = threadIdx.x, lane = tid & 63, wid = tid >> 6, wr = wid >> 1, wc = wid & 1, r = lane & 31, h = lane >> 5;
    __shared__ unsigned sitem_s; volatile unsigned* sitem = &sitem_s;
    for (;;) {
        __syncthreads();
        if (tid == 0) *sitem = atomicAdd(ctr, 1u);
        __syncthreads();
        const int it = (int)*sitem;
        if (it >= 896) break;
#ifndef MIXMASK
#define MIXMASK 7
#endif
        if (it < 64 || (it >= 448 && it < 512)) {
            if (!(MIXMASK & 1)) continue;
            f32x16 acc[2][2]; int tokbase, m, n;
            if (it < 64) { const int b = it >> 5; m = (it >> 1) & 15; n = it & 1; tokbase = NCTX + b * 2048;
                gemm_tile(p.tab2048 + (size_t)m * 128 * 4096, 4096, p.zt_den + ((size_t)(b * 256 + n * 128)) * 4096, 4096, 4096, lds, acc); }
            else { const int q = it - 448, b = q >> 2; m = (q >> 1) & 1; n = q & 1; tokbase = b * 256;
                gemm_tile(p.tab256 + (size_t)m * 128 * 512, 512, p.zt_ctx + ((size_t)(b * 256 + n * 128)) * 512, 512, 512, lds, acc); }
#pragma unroll
            for (int i = 0; i < 2; ++i) {
                const int T = tokbase + m * 128 + wr * 64 + i * 32 + r;
                bf16_t* dst = p.mix + (size_t)T * D + 384 + n * 128 + wc * 64;
                st_bf16_tile(dst, acc[i][0], h); st_bf16_tile(dst + 32, acc[i][1], h);
            }
        } else {
            int q, den;
            if (it < 448) { q = it - 64; den = 1; } else { q = it - 512; den = 0; }
            int b, hd, qb;
            if (den) { qb = q & 15; hd = (q >> 4) % 12; b = q / 192; } else { qb = q & 1; hd = (q >> 1) % 12; b = q / 24; }
            const int T0 = den ? NCTX + b * 2048 + qb * 128 : b * 256 + qb * 128;
            const int Sk = den ? 2304 : 256;
            if (hd < 6) {
                if (!(MIXMASK & 2)) continue;
                const bf16_t* K = den ? p.kmla_den + ((size_t)(l * 2 + b) * 2304 * 6 + hd) * 96 : p.kmla_ctx + ((size_t)b * 256 * 6 + hd) * 96;
                const bf16_t* V = den ? p.vtmla_den + ((size_t)((l * 2 + b) * 6 + hd) * 64) * 2304 : p.vtmla_ctx + ((size_t)(b * 6 + hd) * 64) * 256;
                attn_item<96>(p.qmla + (size_t)T0 * 576 + hd * 96, 576, K, 576, V, Sk, Sk, p.mix + (size_t)T0 * D + hd * 64, D, lds);
            } else {
                if (!(MIXMASK & 4)) continue;
                const int hq = hd - 6, hk = hq / 3;
                const bf16_t* K = den ? p.kgqa_den + ((size_t)(l * 2 + b) * 2304 * 2 + hk) * 64 : p.kgqa_ctx + ((size_t)b * 256 * 2 + hk) * 64;
                const bf16_t* V = den ? p.vtgqa_den + ((size_t)((l * 2 + b) * 2 + hk) * 64) * 2304 : p.vtgqa_ctx + ((size_t)(b * 2 + hk) * 64) * 256;
                attn_item<64>(p.gq + (size_t)T0 * 384 + hq * 64, 384, K, 128, V, Sk, Sk, p.mix + (size_t)T0 * D + 640 + hq * 64, D, lds);
            }
        }
    }
}

DI void phase_resid(KPR p, const bf16_t* A, int K, const bf16_t* W, const float* xc, const float* xd, float* xout, const float* gate, char* lds) {
    const int tid = threadIdx.x, lane = tid & 63, wid = tid >> 6, wr = wid >> 1, wc = wid & 1, r = lane & 31, h = lane >> 5;
    FOR_TILES_64M(8, m, n) {
        f32x16 acc[2][2];
        gemm_tile(A + (size_t)m * 128 * K, K, W + (size_t)n * 128 * K, K, K, lds, acc);
#pragma unroll
        for (int i = 0; i < 2; ++i) {
            const int T = m * 128 + wr * 64 + i * 32 + r;
            const float* xr = T < NCTX ? xc + (size_t)T * D : xd + (size_t)(T - NCTX) * D;
            const float* gj = gate + (T < NCTX ? 0 : 1 + ((T - NCTX) >> 11)) * 6144;
#pragma unroll
            for (int j = 0; j < 2; ++j)
#pragma unroll
                for (int q = 0; q < 4; ++q) {
                    const int c = n * 128 + wc * 64 + j * 32 + 8 * q + 4 * h;
                    const f32x4 xv = *(const f32x4*)(xr + c), gv = *(const f32x4*)(gj + c);
                    f32x4 o = {xv.x + gv.x * acc[i][j][4 * q], xv.y + gv.y * acc[i][j][4 * q + 1], xv.z + gv.z * acc[i][j][4 * q + 2], xv.w + gv.w * acc[i][j][4 * q + 3]};
                    *(f32x4*)(xout + (size_t)T * D + c) = o;
                }
        }
    }
}
DI void phase_gu(KPR p, int l, char* lds) {
    const int tid = threadIdx.x, lane = tid & 63, wid = tid >> 6, wr = wid >> 1, wc = wid & 1, r = lane & 31, h = lane >> 5;
    FOR_TILES_64M(44, m, n) {
        f32x16 acc[2][2];
        gemm_tile(p.h + (size_t)m * 128 * D, D, p.wt_gu + l * SZ_GU + (size_t)n * 128 * D, D, D, lds, acc);
#pragma unroll
        for (int i = 0; i < 2; ++i) {
            const int T = m * 128 + wr * 64 + i * 32 + r;
            f32x16 v;
#pragma unroll
            for (int e = 0; e < 16; ++e) v[e] = silu(acc[i][0][e]) * acc[i][1][e];
            st_bf16_tile(p.hid + (size_t)T * DFF + (n * 2 + wc) * 32, v, h);
        }
    }
}

constexpr int NPHASE = 18;
template <int PM>
__global__ void __launch_bounds__(256, 2) fwd_megakernel(P p_arg) {
    KP kp0 = (KP)__builtin_amdgcn_kernarg_segment_ptr();
    KPR p = *kp0;
    __shared__ __attribute__((aligned(16))) char lds[65536];
    __shared__ uint4 xbw;
    if (p.never) cg::this_grid().sync();
    if (threadIdx.x == 0) xbw = make_uint4(0u, 0u, 0u, 0u);
    __syncthreads();
    XcdBarrier xb;
    if (!MULTI_LAUNCH) xb = xcd_barrier_post(p.bar, (volatile LAS unsigned*)&xbw);
    const int ph0 = p.ph0, ph1 = p.ph1;
    for (int ph = ph0; ph < ph1; ++ph) {
        KP kp = kp0; asm volatile("" : "+s"(kp));
        KPR p = *kp;
        if (ph == 0) { if (PM & 1) phase_prologue(p, lds); }
        else if (ph == 17) { if (PM & 2) phase_final(p, p.xa); }
        else {
            const int l = (ph - 1) >> 3, s = (ph - 1) & 7;
            const float* modl = p.mod + (size_t)l * 3 * 6144;
            const float* xc = l == 0 ? p.x_prompt : p.xa;
            const float* xd = l == 0 ? p.x_sample : p.xa + (size_t)NCTX * D;
            switch (s) {
                case 0: if (PM & 4) phase_norm(p, xc, xd, p.g_norm1 + l * D, modl, 0, 1024); break;
                case 1: if (PM & 8) phase_win(p, l, lds); break;
                case 2: if (PM & 16) phase_mid(p, l, lds); break;
                case 3: if (PM & 32) phase_mix(p, l, lds, p.ctr + 64 * l); break;
                case 4: if (PM & 64) phase_resid(p, p.mix, D, p.wt_out + l * SZ_WOUT, xc, xd, p.xb, modl + 2048, lds); break;
                case 5: if (PM & 4) phase_norm(p, p.xb, p.xb + (size_t)NCTX * D, p.g_norm2 + l * D, modl, 3072, 4096); break;
                case 6: if (PM & 128) phase_gu(p, l, lds); break;
                case 7: if (PM & 64) phase_resid(p, p.hid, DFF, p.wt_down + l * SZ_DOWN, p.xb, p.xb + (size_t)NCTX * D, p.xa, modl + 5120, lds); break;
            }
        }
        if (!MULTI_LAUNCH && ph + 1 < ph1) xcd_barrier(xb);
    }
}

extern "C" void kernel_launch(void* const* d_in, const int* in_sizes, int n_in, void* d_out, int out_size, void* d_ws, size_t ws_size, hipStream_t stream) {
    static int grid_blocks = 0;
    if (!grid_blocks) {
        int dev = 0, cus = 0, per_cu = 0;
        hipGetDevice(&dev);
        hipDeviceGetAttribute(&cus, hipDeviceAttributeMultiprocessorCount, dev);
        hipOccupancyMaxActiveBlocksPerMultiprocessor(&per_cu, fwd_megakernel<(MULTI_LAUNCH ? 32 : FUSEMASK)>, 256, 0);
        if (per_cu > 2) per_cu = 2;
        if (per_cu < 1) per_cu = 1;
        grid_blocks = cus * per_cu;
        grid_blocks &= ~7;
    }
    P p{};
    const float* const* in = (const float* const*)d_in;
    p.x_prompt = in[0]; p.x_sample = in[1]; p.c_ckv = in[2]; p.c_krope = in[3]; p.c_gk = in[4]; p.c_gv = in[5]; p.c = in[6]; p.c_ctx = in[7]; p.w_ada = in[8]; p.b_ada = in[9];
    p.g_norm1 = in[10]; p.g_norm2 = in[11]; p.w_in = in[12]; p.g_q_a = in[13]; p.w_q_up = in[14]; p.g_kv_a = in[15]; p.w_kv_up = in[16]; p.g_q_head = in[17]; p.g_k_head = in[18];
    p.w_out = in[19]; p.w_gate = in[20]; p.w_up = in[21]; p.w_down = in[22]; p.g_final = in[23];
    p.out = (float*)d_out;
    char* ws = (char*)d_ws; size_t off = 0;
    auto alloc = [&](size_t bytes) { char* r = ws + off; off += (bytes + 255) & ~(size_t)255; return r; };
    p.bar = (unsigned*)alloc(XCD_BAR_WORDS * 4); p.ctr = (unsigned*)alloc(1024); p.mod = (float*)alloc(2 * 3 * 6144 * 4);
    const size_t zero_bytes = off;
    p.wt_in = (bf16_t*)alloc(2 * SZ_WIN * 2); p.wt_qup = (bf16_t*)alloc(2 * SZ_QUP * 2); p.wt_kvg = (bf16_t*)alloc(2 * SZ_KV * 2); p.wt_kvp = (bf16_t*)alloc(2 * SZ_KV * 2);
    p.wt_out = (bf16_t*)alloc(2 * SZ_WOUT * 2); p.wt_gu = (bf16_t*)alloc(2 * SZ_GU * 2); p.wt_down = (bf16_t*)alloc(2 * SZ_DOWN * 2);
    p.tab2048 = (bf16_t*)alloc((size_t)2048 * 4096 * 2); p.tab256 = (bf16_t*)alloc(256 * 512 * 2); p.bt_ch = (bf16_t*)alloc(128 * 64 * 2);
    p.rope_g = (f32x2*)alloc(2048 * 32 * 8); p.rope_m = (f32x2*)alloc(2048 * 16 * 8);
    p.ckv_cache = (bf16_t*)alloc(2 * 2 * 256 * 256 * 2);
    p.h = (bf16_t*)alloc((size_t)NTOK * D * 2);
    p.ssq_q = (float*)alloc(NTOK * 6 * 4); p.ssq_kv = (float*)alloc(NTOK * 4 * 4);
    p.xa = (float*)alloc((size_t)NTOK * D * 4); p.xb = (float*)alloc((size_t)NTOK * D * 4);
    p.kmla_ctx = (bf16_t*)alloc((size_t)16 * 256 * 576 * 2); p.vtmla_ctx = (bf16_t*)alloc((size_t)16 * 6 * 64 * 256 * 2);
    p.kgqa_ctx = (bf16_t*)alloc((size_t)16 * 256 * 128 * 2); p.vtgqa_ctx = (bf16_t*)alloc((size_t)16 * 2 * 64 * 256 * 2);
    p.kmla_den = (bf16_t*)alloc((size_t)4 * 2304 * 576 * 2); p.vtmla_den = (bf16_t*)alloc((size_t)4 * 6 * 64 * 2304 * 2);
    p.kgqa_den = (bf16_t*)alloc((size_t)4 * 2304 * 128 * 2); p.vtgqa_den = (bf16_t*)alloc((size_t)4 * 2 * 64 * 2304 * 2);
    p.zt_ctx = (bf16_t*)alloc((size_t)16 * 256 * 512 * 2); p.zt_den = (bf16_t*)alloc((size_t)2 * 256 * 4096 * 2);
    const size_t ov = off;
    p.cq = (bf16_t*)alloc((size_t)NTOK * 384 * 2); p.ckv = (bf16_t*)alloc((size_t)NTOK * 256 * 2); p.u = (bf16_t*)alloc((size_t)NTOK * 256 * 2);
    p.gq = (bf16_t*)alloc((size_t)NTOK * 384 * 2); p.qmla = (bf16_t*)alloc((size_t)NTOK * 576 * 2); p.mix = (bf16_t*)alloc((size_t)NTOK * D * 2);
    p.hid = (bf16_t*)(ws + ov);
    if (off - ov < (size_t)NTOK * DFF * 2) off = ov + (size_t)NTOK * DFF * 2;
    if (off > ws_size) { fprintf(stderr, "workspace too small: need %zu have %zu\n", off, ws_size); return; }
    hipMemsetAsync(ws, 0, zero_bytes, stream);
#if MULTI_LAUNCH
    for (int ph = 0; ph < NPHASE; ++ph) {
        P q = p; q.ph0 = ph; q.ph1 = ph + 1;
        const int s = (ph - 1) & 7;
        if (ph == 0) hipLaunchKernelGGL(fwd_megakernel<1>, dim3(grid_blocks), dim3(256), 0, stream, q);
        else if (ph == 17) hipLaunchKernelGGL(fwd_megakernel<2>, dim3(grid_blocks), dim3(256), 0, stream, q);
        else if (s == 0 || s == 5) hipLaunchKernelGGL(fwd_megakernel<4>, dim3(grid_blocks), dim3(256), 0, stream, q);
        else if (s == 1) hipLaunchKernelGGL(fwd_megakernel<8>, dim3(grid_blocks), dim3(256), 0, stream, q);
        else if (s == 2) hipLaunchKernelGGL(fwd_megakernel<16>, dim3(grid_blocks), dim3(256), 0, stream, q);
        else if (s == 3) hipLaunchKernelGGL(fwd_megakernel<32>, dim3(grid_blocks), dim3(256), 0, stream, q);
        else if (s == 4 || s == 7) hipLaunchKernelGGL(fwd_megakernel<64>, dim3(grid_blocks), dim3(256), 0, stream, q);
        else hipLaunchKernelGGL(fwd_megakernel<128>, dim3(grid_blocks), dim3(256), 0, stream, q);
    }
#else
    p.ph0 = 0; p.ph1 = NPHASE;
    void* args[] = {&p};
    hipError_t e = hipLaunchCooperativeKernel((void*)fwd_megakernel<FUSEMASK>, dim3(grid_blocks), dim3(256), args, 0, stream);
    if (e != hipSuccess) fprintf(stderr, "cooperative launch failed: %s (grid %d)\n", hipGetErrorString(e), grid_blocks);
#endif
}
```

```cpp
#include <hip/hip_runtime.h>
#include <hip/hip_cooperative_groups.h>
#include <stdint.h>
#include <stdio.h>
namespace cg = cooperative_groups;

#ifndef FUSEMASK
#define FUSEMASK 0xffff
#endif
#ifndef MULTI_LAUNCH
#define MULTI_LAUNCH 0
#endif

typedef unsigned short bf16_t;
typedef short bf16x8 __attribute__((ext_vector_type(8)));
typedef short s16x4 __attribute__((ext_vector_type(4)));
typedef float f32x16 __attribute__((ext_vector_type(16)));
typedef float f32x4 __attribute__((ext_vector_type(4)));
typedef float f32x2 __attribute__((ext_vector_type(2)));
typedef unsigned u32x4 __attribute__((ext_vector_type(4)));
typedef unsigned u32x2 __attribute__((ext_vector_type(2)));
#define DI __device__ __forceinline__
#define LAS __attribute__((address_space(3)))

constexpr int D = 1024, NTOK = 8192, NCTX = 4096, DFF = 2816;
constexpr int NINP = 1792;
constexpr float EPS = 1e-6f;
constexpr float LOG2E = 1.4426950408889634f;
constexpr size_t OFF_YP = 0, OFF_YS = 4194304, OFF_CKV = 8388608, OFF_KROPE = 10485760, OFF_GK = 10747904, OFF_GV = 11796480;
constexpr size_t SZ_WIN = (size_t)NINP * 1024, SZ_QUP = 640 * 384, SZ_KV = 768 * 256, SZ_WOUT = 1024 * 1024, SZ_GU = (size_t)5632 * 1024, SZ_DOWN = (size_t)1024 * 2816;

struct P {
    const float *x_prompt, *x_sample, *c_ckv, *c_krope, *c_gk, *c_gv, *c, *c_ctx, *w_ada, *b_ada, *g_norm1, *g_norm2, *w_in, *g_q_a, *w_q_up, *g_kv_a,
        *w_kv_up, *g_q_head, *g_k_head, *w_out, *w_gate, *w_up, *w_down, *g_final;
    float* out;
    unsigned* bar;
    unsigned* ctr;
    float* mod;
    bf16_t *wt_in, *wt_qup, *wt_kvg, *wt_kvp, *wt_out, *wt_gu, *wt_down;
    bf16_t *tab2048, *tab256, *bt_ch;
    f32x2 *rope_g, *rope_m;
    bf16_t* ckv_cache;
    bf16_t *h, *cq, *ckv, *u, *gq, *qmla, *mix, *hid;
    float *ssq_q, *ssq_kv;
    float *xa, *xb;
    bf16_t *kmla_ctx, *vtmla_ctx, *kgqa_ctx, *vtgqa_ctx;
    bf16_t *kmla_den, *vtmla_den, *kgqa_den, *vtgqa_den;
    bf16_t *zt_ctx, *zt_den;
    int never, ph0, ph1, pad;
};

typedef const volatile __attribute__((address_space(4))) P& KPR;
typedef const volatile __attribute__((address_space(4))) P* KP;
typedef __bf16 nbf16x2 __attribute__((ext_vector_type(2)));
DI unsigned pk_bf16(float lo, float hi) { f32x2 v = {lo, hi}; nbf16x2 b = __builtin_convertvector(v, nbf16x2); return __builtin_bit_cast(unsigned, b); }
DI bf16_t to_bf16(float x) { return (bf16_t)(pk_bf16(x, 0.f) & 0xffffu); }
DI int crow(int e, int h) { return (e & 3) + 8 * (e >> 2) + 4 * h; }
DI int ltid() { int t = threadIdx.x; asm volatile("" : "+v"(t)); return t; }
DI int lbid() { int b = blockIdx.x; asm volatile("" : "+s"(b)); return b; }
DI float silu(float x) { return x / (1.f + __expf(-x)); }
#define MFMA(a, b, c) __builtin_amdgcn_mfma_f32_32x32x16_bf16((a), (b), (c), 0, 0, 0)

#define XB_TMO 128
#define XB_XCNT(j) (256 + 64 * (j))
#define XB_XSUB(j) (1280 + 64 * (j))
#define XB_XGEN(j) (2304 + 64 * (j))
#define XB_TOP 3328
#define XB_TOPGEN 3392
#define XCD_BAR_WORDS 3456
#define XB_SPIN_CAP (1u << 20)
DI unsigned xb_ld(unsigned* p) { return __hip_atomic_load(p, __ATOMIC_RELAXED, __HIP_MEMORY_SCOPE_AGENT); }
DI unsigned xb_add(unsigned* p, unsigned v) { return __hip_atomic_fetch_add(p, v, __ATOMIC_RELAXED, __HIP_MEMORY_SCOPE_AGENT); }
DI unsigned xb_xcc_id() { return (unsigned)__builtin_amdgcn_s_getreg((3 << 11) | 20) & 0xFu; }
#define XB_SPIN(cond, bar)                                                                         \
    do {                                                                                           \
        unsigned _sp = 0;                                                                          \
        while (cond) {                                                                             \
            __builtin_amdgcn_s_sleep(1);                                                           \
            if ((++_sp & 255u) == 0u) {                                                            \
                if (xb_ld(&(bar)[XB_TMO])) break;                                                  \
                if (_sp > XB_SPIN_CAP) { atomicAdd(&(bar)[XB_TMO], 1u); break; }                   \
            }                                                                                      \
        }                                                                                          \
    } while (0)
struct XcdBarrier { unsigned* bar; unsigned x; volatile LAS unsigned* st; };
DI XcdBarrier xcd_barrier_post(unsigned* bar, volatile LAS unsigned* st) {
    XcdBarrier b; b.bar = bar; b.x = xb_xcc_id(); b.st = st;
    if (threadIdx.x == 0) (void)xb_add(&bar[XB_XCNT(b.x)], 1u);
    return b;
}
DI void xcd_barrier_complete(unsigned* bar, unsigned x, unsigned& nloc, unsigned& nx) {
    const unsigned G = gridDim.x * gridDim.y * gridDim.z;
    unsigned sum, cnt, mine, sp = 0u;
    for (;;) {
        sum = 0u; cnt = 0u; mine = 0u;
#pragma unroll
        for (unsigned j = 0; j < 16; ++j) { const unsigned c = xb_ld(&bar[XB_XCNT(j)]); sum += c; cnt += (c > 0u) ? 1u : 0u; mine = (j == x) ? c : mine; }
        if (sum == G) break;
        __builtin_amdgcn_s_sleep(1);
        if ((++sp & 255u) == 0u) { if (xb_ld(&bar[XB_TMO])) break; if (sp > XB_SPIN_CAP) { atomicAdd(&bar[XB_TMO], 1u); break; } }
    }
    nloc = mine > 0u ? mine : 1u; nx = cnt > 0u ? cnt : 1u;
}
DI void xcd_barrier(const XcdBarrier& b) {
    asm volatile("s_waitcnt vmcnt(0)" ::: "memory");
    __syncthreads();
    if (threadIdx.x == 0) {
        unsigned* bar = b.bar;
        __builtin_amdgcn_s_waitcnt(0);
        unsigned nloc = b.st[0], nx = b.st[1];
        if (nloc == 0u) { xcd_barrier_complete(bar, b.x, nloc, nx); b.st[0] = nloc; b.st[1] = nx; }
        const unsigned old = xb_add(&bar[XB_XSUB(b.x)], 1u);
        const unsigned gen = old / nloc;
        if (old + 1u == (gen + 1u) * nloc) {
            __builtin_amdgcn_fence(__ATOMIC_RELEASE, "agent");
            asm volatile("s_waitcnt vmcnt(0)" ::: "memory");
            const unsigned og = xb_add(&bar[XB_TOP], 1u);
            const unsigned tg = og / nx;
            if (og + 1u == (tg + 1u) * nx) xb_add(&bar[XB_TOPGEN], 1u);
            else XB_SPIN(xb_ld(&bar[XB_TOPGEN]) == tg, bar);
            __builtin_amdgcn_fence(__ATOMIC_ACQUIRE, "agent");
            xb_add(&bar[XB_XGEN(b.x)], 1u);
            asm volatile("s_waitcnt vmcnt(0)" ::: "memory");
        } else {
            XB_SPIN(xb_ld(&bar[XB_XGEN(b.x)]) == gen, bar);
            __builtin_amdgcn_fence(__ATOMIC_ACQUIRE, "agent");
            asm volatile("s_waitcnt vmcnt(0)" ::: "memory");
        }
    }
    __syncthreads();
}

DI void glds16(const void* g, unsigned lds_addr) {
    unsigned keep;
    asm volatile("s_mov_b32 %0, m0\n\ts_mov_b32 m0, %2\n\ts_nop 0\n\tglobal_load_lds_dwordx4 %1, off\n\ts_mov_b32 m0, %0" : "=&s"(keep) : "v"(g), "s"(lds_addr) : "memory");
}
template <int WM>
DI void gemm_tile(const bf16_t* __restrict__ A, int lda, const bf16_t* __restrict__ B, int ldb, int K, char* lds, f32x16 (&acc)[WM][2]) {
    constexpr int NB = WM == 4 ? 4 : 2;
    int tid = threadIdx.x; asm volatile("" : "+v"(tid));
    const int lane = tid & 63, wid = tid >> 6, r = lane & 31, h = lane >> 5;
    const int wr = WM == 4 ? (wid >> 2) : (wid >> 1), wc = WM == 4 ? (wid & 3) : (wid & 1);
#pragma unroll
    for (int i = 0; i < WM; ++i)
#pragma unroll
        for (int j = 0; j < 2; ++j)
#pragma unroll
            for (int e = 0; e < 16; ++e) acc[i][j][e] = 0.f;
    const int lrow = wid * 8 + (lane >> 3);
    const int lkc = (lane & 7) ^ ((lrow >> 1) & 7);
    const bf16_t* ga = A + (size_t)lrow * lda + lkc * 8;
    const bf16_t* gb = B + (size_t)lrow * ldb + lkc * 8;
    LAS char* l3 = (LAS char*)lds;
    const unsigned lbase = (unsigned)(size_t)l3 + (unsigned)__builtin_amdgcn_readfirstlane(wid) * 1024u;
    const int swz = (r >> 1) & 7;
    const int aofs = (wr * (WM * 32) + r) * 128, bofs = 32768 + (wc * 64 + r) * 128;
#define GLDS_TILE(buf, k0)                                                                            \
    _Pragma("unroll") for (int i = 0; i < 4; ++i) glds16(ga + (size_t)i * 64 * lda + (k0), lbase + (buf) + i * 8192);          \
    _Pragma("unroll") for (int i = 0; i < NB; ++i) glds16(gb + (size_t)i * 64 * ldb + (k0), lbase + (buf) + 32768 + i * 8192);
    GLDS_TILE(0, 0)
    asm volatile("s_waitcnt vmcnt(0)" ::: "memory");
    __syncthreads();
    const int nt = K >> 6;
    for (int t = 0; t < nt; ++t) {
        const int cur = (t & 1) * 65536, nxt = 65536 - cur;
        if (t + 1 < nt) { const int k0 = (t + 1) << 6; GLDS_TILE(nxt, k0) }
        bf16x8 af[2][WM], bfr[2][2];
#define LOAD_FRAGS(slot, ks)                                                                                         \
        { const int co = (((ks) * 2 + h) ^ swz) << 4;                                                                \
          _Pragma("unroll") for (int i = 0; i < WM; ++i) af[slot][i] = *(const LAS bf16x8*)(l3 + cur + aofs + i * 4096 + co);   \
          _Pragma("unroll") for (int j = 0; j < 2; ++j) bfr[slot][j] = *(const LAS bf16x8*)(l3 + cur + bofs + j * 4096 + co); }
        LOAD_FRAGS(0, 0)
#pragma unroll
        for (int ks = 0; ks < 4; ++ks) {
            if (ks < 3) LOAD_FRAGS((ks + 1) & 1, ks + 1)
#pragma unroll
            for (int i = 0; i < WM; ++i)
#pragma unroll
                for (int j = 0; j < 2; ++j) acc[i][j] = MFMA(bfr[ks & 1][j], af[ks & 1][i], acc[i][j]);
            __builtin_amdgcn_sched_barrier(0);
        }
#undef LOAD_FRAGS
        asm volatile("s_waitcnt vmcnt(0)" ::: "memory");
        __syncthreads();
    }
#undef GLDS_TILE
}

DI void st_bf16_tile(bf16_t* dst, const f32x16& v, int h) {
#pragma unroll
    for (int q = 0; q < 4; ++q) {
        u32x2 w; w.x = pk_bf16(v[4 * q], v[4 * q + 1]); w.y = pk_bf16(v[4 * q + 2], v[4 * q + 3]);
        *(u32x2*)(dst + 8 * q + 4 * h) = w;
    }
}
DI void st_f32_tile(float* dst, const f32x16& v, int h) {
#pragma unroll
    for (int q = 0; q < 4; ++q) { f32x4 w = {v[4 * q], v[4 * q + 1], v[4 * q + 2], v[4 * q + 3]}; *(f32x4*)(dst + 8 * q + 4 * h) = w; }
}
DI void st_bf16_tile_T(bf16_t* dst, size_t ld, const f32x16& v, int h) {
#pragma unroll
    for (int e = 0; e < 16; ++e) dst[(size_t)crow(e, h) * ld] = to_bf16(v[e]);
}
DI float sumsq16(const f32x16& v) { float s = 0.f;
#pragma unroll
    for (int e = 0; e < 16; ++e) s += v[e] * v[e];
    return s; }

DI const float* win_src(const float* w, int nd) {
    int sc;
    if (nd < 640) sc = nd; else if (nd < 1024) sc = 928 + (nd - 640); else if (nd < 1152) sc = 1312 + (nd - 1024); else if (nd < 1280) sc = 1440 + (nd - 1152);
    else if (nd < 1536) sc = 672 + (nd - 1280); else if (nd < 1568) sc = 640 + (nd - 1536); else return nullptr;
    return w + sc;
}
DI void tr_tile(const float* colp, int nsrc, bf16_t* dst, int K, int k0, int nd0, const float* kscale, float* tile) {
    const int tid = ltid() & 255, tn = tid & 63, tk = tid >> 6;
    float tv[16];
#pragma unroll
    for (int i = 0; i < 16; ++i) tv[i] = colp ? colp[(size_t)(k0 + tk + 4 * i) * nsrc] : 0.f;
    if (kscale) {
#pragma unroll
        for (int i = 0; i < 16; ++i) tv[i] *= kscale[k0 + tk + 4 * i];
    }
#pragma unroll
    for (int i = 0; i < 16; ++i) tile[(tk + 4 * i) * 65 + tn] = tv[i];
    __syncthreads();
    const int rr = tid >> 2, kq = tid & 3;
    u32x4 o0, o1;
    const float* tp = tile + (kq * 16) * 65 + rr;
    o0.x = pk_bf16(tp[0 * 65], tp[1 * 65]); o0.y = pk_bf16(tp[2 * 65], tp[3 * 65]); o0.z = pk_bf16(tp[4 * 65], tp[5 * 65]); o0.w = pk_bf16(tp[6 * 65], tp[7 * 65]);
    o1.x = pk_bf16(tp[8 * 65], tp[9 * 65]); o1.y = pk_bf16(tp[10 * 65], tp[11 * 65]); o1.z = pk_bf16(tp[12 * 65], tp[13 * 65]); o1.w = pk_bf16(tp[14 * 65], tp[15 * 65]);
    bf16_t* d = dst + (size_t)(nd0 + rr) * K + k0 + kq * 16;
    *(u32x4*)d = o0; *(u32x4*)(d + 8) = o1;
    __syncthreads();
}

DI void phase_prologue(KPR p, char* lds) {
    const int tid = ltid(), bid = lbid(), G = gridDim.x;
    float* tile = (float*)lds;
    for (int task = bid; task < 768; task += G) {
        const int l = task / 384, rem = task % 384, kc = rem / 12, cb = rem % 12;
        if (tid < 96) { const int j = tid >> 5, k = kc * 32 + (tid & 31); const float cv = (j == 0) ? p.c_ctx[k] : p.c[(j - 1) * 1024 + k]; tile[tid] = silu(cv); }
        __syncthreads();
        const int n = cb * 512 + tid;
        const float* w = p.w_ada + ((size_t)l * 1024 + kc * 32) * 6144 + n;
        float s0 = 0.f, s1 = 0.f, s2 = 0.f;
        float wv[32];
#pragma unroll
        for (int k = 0; k < 32; ++k) wv[k] = w[(size_t)k * 6144];
#pragma unroll
        for (int k = 0; k < 32; ++k) { s0 += tile[k] * wv[k]; s1 += tile[32 + k] * wv[k]; s2 += tile[64 + k] * wv[k]; }
        if (kc == 0) { const float bv = p.b_ada[l * 6144 + n]; s0 += bv; s1 += bv; s2 += bv; }
        float* m = p.mod + (size_t)l * 3 * 6144 + n;
        atomicAdd(m, s0); atomicAdd(m + 6144, s1); atomicAdd(m + 2 * 6144, s2);
        __syncthreads();
    }
    tile = (float*)(lds + (tid >> 8) * 16640);
    for (int pp = bid; pp < 2972; pp += G) {
        const int tt = pp * 2 + (tid >> 8);
        const int l = tt / 2972; int t = tt % 2972;
        const int tn = tid & 63;
        if (t < 448) { const int kt = t / 28, nt = t % 28; const float* w = p.w_in + (size_t)l * 1024 * 1568;
            tr_tile(win_src(w, nt * 64 + tn), 1568, p.wt_in + l * SZ_WIN, 1024, kt * 64, nt * 64, nullptr, tile); continue; }
        t -= 448;
        if (t < 60) { const int kt = t / 10, nt = t % 10; const float* w = p.w_q_up + (size_t)l * 384 * 576; const int nd = nt * 64 + tn;
            tr_tile(nd < 576 ? w + nd : nullptr, 576, p.wt_qup + l * SZ_QUP, 384, kt * 64, nt * 64, p.g_q_a + l * 384, tile); continue; }
        t -= 60;
        if (t < 96) { const int var = t / 48; t %= 48; const int kt = t / 12, nt = t % 12; const float* w = p.w_kv_up + (size_t)l * 256 * 768;
            tr_tile(w + nt * 64 + tn, 768, (var ? p.wt_kvp : p.wt_kvg) + l * SZ_KV, 256, kt * 64, nt * 64, var ? nullptr : p.g_kv_a + l * 256, tile); continue; }
        t -= 96;
        if (t < 256) { const int kt = t / 16, nt = t % 16; const float* w = p.w_out + (size_t)l * 1024 * 1024;
            tr_tile(w + nt * 64 + tn, 1024, p.wt_out + l * SZ_WOUT, 1024, kt * 64, nt * 64, nullptr, tile); continue; }
        t -= 256;
        if (t < 1408) { const int kt = t / 88, nt = t % 88; const float* w = (tn < 32 ? p.w_gate : p.w_up) + (size_t)l * 1024 * 2816 + nt * 32 + (tn & 31);
            tr_tile(w, 2816, p.wt_gu + l * SZ_GU, 1024, kt * 64, nt * 64, nullptr, tile); continue; }
        t -= 1408;
        { const int kt = t / 16, nt = t % 16; const float* w = p.w_down + (size_t)l * 2816 * 1024;
            tr_tile(w + nt * 64 + tn, 1024, p.wt_down + l * SZ_DOWN, 2816, kt * 64, nt * 64, nullptr, tile); }
    }
    const int gt = bid * 512 + tid, GT = G * 512;
    for (int i = gt; i < 2048 * 512; i += GT) {
        const int pp = i >> 9, k8 = (i & 511) * 8; u32x4 o; unsigned w[4];
#pragma unroll
        for (int e = 0; e < 4; ++e) { float v[2];
#pragma unroll
            for (int z = 0; z < 2; ++z) { const int kq = k8 + 2 * e + z; const int m = (pp * (kq & 2047)) & 2047; const float a = (float)m * (1.f / 1024.f);
                v[z] = (kq < 2048 ? cospif(a) : -sinpif(a)) * 0.022097086912079608f; }
            w[e] = pk_bf16(v[0], v[1]); }
        o.x = w[0]; o.y = w[1]; o.z = w[2]; o.w = w[3];
        *(u32x4*)(p.tab2048 + (size_t)pp * 4096 + k8) = o;
    }
    for (int i = gt; i < 256 * 512; i += GT) { const int pp = i >> 9, kq = i & 511; const int m = (pp * (kq & 255)) & 255; const float a = (float)m * (1.f / 128.f);
        p.tab256[i] = to_bf16((kq < 256 ? cospif(a) : -sinpif(a)) * 0.0625f); }
    for (int i = gt; i < 128 * 64; i += GT) { const int n = i >> 6, k = i & 63; const int m = ((n & 63) * k) & 63; const float a = (float)m * (1.f / 32.f);
        p.bt_ch[i] = to_bf16((n < 64 ? cospif(a) : sinpif(a)) * 0.125f); }
    for (int i = gt; i < 2048 * 32; i += GT) { const int t = i >> 5, pr = i & 31; const float inv = powf(10000.f, -(float)(pr & 15) * (1.f / 16.f));
        const float pos = (float)(pr < 16 ? (t >> 6) : (t & 63)); const float ang = pos * inv; f32x2 cs = {cosf(ang), sinf(ang)}; p.rope_g[i] = cs; }
    for (int i = gt; i < 2048 * 16; i += GT) { const int t = i >> 4, pr = i & 15; const float inv = powf(10000.f, -(float)(pr & 7) * (1.f / 8.f));
        const float pos = (float)(pr < 8 ? (t >> 6) : (t & 63)); const float ang = pos * inv; f32x2 cs = {cosf(ang), sinf(ang)}; p.rope_m[i] = cs; }
    for (int i = gt; i < 2 * 2 * 256 * 256; i += GT) p.ckv_cache[i] = to_bf16(p.c_ckv[i]);
    for (int i = gt; i < 2 * 2 * 256 * 32; i += GT) {
        const int d = i & 31, s = (i >> 5) & 255, l = (i >> 13) & 1, b = i >> 14; const bf16_t v = to_bf16(p.c_krope[i]);
        bf16_t* dst = p.kmla_den + ((size_t)((l * 2 + b) * 2304 + s) * 6) * 96 + 64 + d;
#pragma unroll
        for (int hh = 0; hh < 6; ++hh) dst[hh * 96] = v;
    }
    for (int i = gt; i < 2 * 2 * 256 * 128; i += GT) {
        const int d = i & 63, hk = (i >> 6) & 1, s = (i >> 7) & 255, l = (i >> 15) & 1, b = i >> 16;
        p.kgqa_den[((size_t)((l * 2 + b) * 2304 + s) * 2 + hk) * 64 + d] = to_bf16(p.c_gk[i]);
        p.vtgqa_den[((size_t)((l * 2 + b) * 2 + hk) * 64 + d) * 2304 + s] = to_bf16(p.c_gv[i]);
    }
}

DI void phase_norm(KPR p, const float* xc, const float* xd, const float* g, const float* modl, int shift_off, int scale_off) {
    const int lane = ltid() & 63, gw = lbid() * 8 + (ltid() >> 6), nw = gridDim.x * 8;
    for (int T0 = gw; T0 < NTOK; T0 += 4 * nw) {
        f32x4 v[4][4];
#pragma unroll
        for (int rr = 0; rr < 4; ++rr) {
            const int T = T0 + rr * nw;
            if (T < NTOK) {
                const float* xr = T < NCTX ? xc + (size_t)T * D : xd + (size_t)(T - NCTX) * D;
#pragma unroll
                for (int i = 0; i < 4; ++i) v[rr][i] = *(const f32x4*)(xr + lane * 4 + i * 256);
            }
        }
#pragma unroll
        for (int rr = 0; rr < 4; ++rr) {
            const int T = T0 + rr * nw;
            if (T < NTOK) {
                const float* mj = modl + (T < NCTX ? 0 : 1 + ((T - NCTX) >> 11)) * 6144;
                float ss = 0.f;
#pragma unroll
                for (int i = 0; i < 4; ++i) ss += v[rr][i].x * v[rr][i].x + v[rr][i].y * v[rr][i].y + v[rr][i].z * v[rr][i].z + v[rr][i].w * v[rr][i].w;
#pragma unroll
                for (int o = 32; o >= 1; o >>= 1) ss += __shfl_xor(ss, o);
                const float rs = rsqrtf(ss * (1.f / 1024.f) + EPS);
#pragma unroll
                for (int i = 0; i < 4; ++i) {
                    const int c = lane * 4 + i * 256;
                    const f32x4 gg = *(const f32x4*)(g + c), sc = *(const f32x4*)(mj + scale_off + c), sh = *(const f32x4*)(mj + shift_off + c);
                    const f32x4 x = v[rr][i];
                    u32x2 w; w.x = pk_bf16(x.x * rs * gg.x * (1.f + sc.x) + sh.x, x.y * rs * gg.y * (1.f + sc.y) + sh.y);
                    w.y = pk_bf16(x.z * rs * gg.z * (1.f + sc.z) + sh.z, x.w * rs * gg.w * (1.f + sc.w) + sh.w);
                    *(u32x2*)(p.h + (size_t)T * D + c) = w;
                }
            }
        }
    }
}
DI void phase_final(KPR p, const float* x) {
    const int lane = ltid() & 63, gw = lbid() * 8 + (ltid() >> 6), nw = gridDim.x * 8;
    for (int T0 = gw; T0 < NTOK; T0 += 4 * nw) {
        f32x4 v[4][4];
#pragma unroll
        for (int rr = 0; rr < 4; ++rr) {
            const int T = T0 + rr * nw;
            if (T < NTOK) {
#pragma unroll
                for (int i = 0; i < 4; ++i) v[rr][i] = *(const f32x4*)(x + (size_t)T * D + lane * 4 + i * 256);
            }
        }
#pragma unroll
        for (int rr = 0; rr < 4; ++rr) {
            const int T = T0 + rr * nw;
            if (T < NTOK) {
                float ss = 0.f;
#pragma unroll
                for (int i = 0; i < 4; ++i) ss += v[rr][i].x * v[rr][i].x + v[rr][i].y * v[rr][i].y + v[rr][i].z * v[rr][i].z + v[rr][i].w * v[rr][i].w;
#pragma unroll
                for (int o = 32; o >= 1; o >>= 1) ss += __shfl_xor(ss, o);
                const float rs = rsqrtf(ss * (1.f / 1024.f) + EPS);
#pragma unroll
                for (int i = 0; i < 4; ++i) { const int c = lane * 4 + i * 256; const f32x4 gg = *(const f32x4*)(p.g_final + c); const f32x4 xx = v[rr][i];
                    f32x4 o = {xx.x * rs * gg.x, xx.y * rs * gg.y, xx.z * rs * gg.z, xx.w * rs * gg.w}; *(f32x4*)(p.out + (size_t)T * D + c) = o; }
            }
        }
    }
}

DI void rope_pair(float& x1, float& x2, const f32x2 cs) { const float a = x1 * cs.x - x2 * cs.y, b = x2 * cs.x + x1 * cs.y; x1 = a; x2 = b; }
template <int WM>
DI void epi_win(KPR p, int l, f32x16 (&acc)[WM][2], int tok0, int cb, int r, int h) {
#pragma unroll
    for (int i = 0; i < WM; ++i) {
        __builtin_amdgcn_sched_barrier(0);
        const int T = tok0 + i * 32 + r; const bool den = T >= NCTX;
        int b, s; if (!den) { b = T >> 8; s = T & 255; } else { b = (T - NCTX) >> 11; s = (T - NCTX) & 2047; }
        if (cb < 640) {
            float ss = sumsq16(acc[i][0]) + sumsq16(acc[i][1]); ss += __shfl_xor(ss, 32);
            if (cb < 384) {
                bf16_t* dst = p.cq + (size_t)T * 384 + cb; st_bf16_tile(dst, acc[i][0], h); st_bf16_tile(dst + 32, acc[i][1], h);
                if (h == 0) p.ssq_q[T * 6 + (cb >> 6)] = ss;
            } else {
                const int c0 = cb - 384; bf16_t* dst = p.ckv + (size_t)T * 256 + c0; st_bf16_tile(dst, acc[i][0], h); st_bf16_tile(dst + 32, acc[i][1], h);
                if (h == 0) p.ssq_kv[T * 4 + (c0 >> 6)] = ss;
                if (!den) { float* o = p.out + OFF_CKV + ((size_t)((b * 2 + l) * 256 + s)) * 256 + c0; st_f32_tile(o, acc[i][0], h); st_f32_tile(o + 32, acc[i][1], h); }
            }
        } else if (cb < 1152) {
            float ss = sumsq16(acc[i][0]) + sumsq16(acc[i][1]); ss += __shfl_xor(ss, 32);
            const float rs = rsqrtf(ss * (1.f / 64.f) + EPS);
            const bool isq = cb < 1024;
            const float* g = (isq ? p.g_q_head : p.g_k_head) + l * 64;
            const int hk = (cb - 1024) >> 6;
            float* o32 = p.out + OFF_GK + ((size_t)(((b * 2 + l) * 256 + s) * 2 + hk)) * 64;
            bf16_t* dst = isq ? p.gq + (size_t)T * 384 + (cb - 640)
                              : (den ? p.kgqa_den + ((size_t)((l * 2 + b) * 2304 + 256 + s) * 2 + hk) * 64 : p.kgqa_ctx + ((size_t)(b * 256 + s) * 2 + hk) * 64);
            const float qs = isq ? 0.125f * LOG2E : 1.f;
#pragma unroll
            for (int q = 0; q < 4; ++q) {
                const int d0 = 8 * q + 4 * h;
                const f32x4 g0 = *(const f32x4*)(g + d0), g1 = *(const f32x4*)(g + 32 + d0);
                float x1[4], x2[4];
#pragma unroll
                for (int z = 0; z < 4; ++z) { x1[z] = acc[i][0][4 * q + z] * rs * g0[z]; x2[z] = acc[i][1][4 * q + z] * rs * g1[z]; }
                if (!isq && !den) { f32x4 w0 = {x1[0], x1[1], x1[2], x1[3]}, w1 = {x2[0], x2[1], x2[2], x2[3]}; *(f32x4*)(o32 + d0) = w0; *(f32x4*)(o32 + 32 + d0) = w1; }
                if (den) {
                    const f32x4 ca = *(const f32x4*)(p.rope_g + s * 32 + d0), cb2 = *(const f32x4*)(p.rope_g + s * 32 + d0 + 2);
                    { f32x2 cs = {ca[0], ca[1]}; rope_pair(x1[0], x2[0], cs); } { f32x2 cs = {ca[2], ca[3]}; rope_pair(x1[1], x2[1], cs); }
                    { f32x2 cs = {cb2[0], cb2[1]}; rope_pair(x1[2], x2[2], cs); } { f32x2 cs = {cb2[2], cb2[3]}; rope_pair(x1[3], x2[3], cs); }
                }
                u32x2 w0, w1; w0.x = pk_bf16(x1[0] * qs, x1[1] * qs); w0.y = pk_bf16(x1[2] * qs, x1[3] * qs); w1.x = pk_bf16(x2[0] * qs, x2[1] * qs); w1.y = pk_bf16(x2[2] * qs, x2[3] * qs);
                *(u32x2*)(dst + d0) = w0; *(u32x2*)(dst + 32 + d0) = w1;
                __builtin_amdgcn_sched_barrier(0);
            }
        } else if (cb < 1280) {
            const int hk = (cb - 1152) >> 6;
            if (!den) {
                float* o = p.out + OFF_GV + ((size_t)(((b * 2 + l) * 256 + s) * 2 + hk)) * 64; st_f32_tile(o, acc[i][0], h); st_f32_tile(o + 32, acc[i][1], h);
                bf16_t* dst = p.vtgqa_ctx + ((size_t)(b * 2 + hk) * 64) * 256 + s; st_bf16_tile_T(dst, 256, acc[i][0], h); st_bf16_tile_T(dst + 32 * 256, 256, acc[i][1], h);
            } else {
                bf16_t* dst = p.vtgqa_den + ((size_t)((l * 2 + b) * 2 + hk) * 64) * 2304 + 256 + s; st_bf16_tile_T(dst, 2304, acc[i][0], h); st_bf16_tile_T(dst + 32 * 2304, 2304, acc[i][1], h);
            }
        } else if (cb < 1536) {
            bf16_t* dst = p.u + (size_t)T * 256 + (cb - 1280); st_bf16_tile(dst, acc[i][0], h); st_bf16_tile(dst + 32, acc[i][1], h);
        } else if (cb == 1536) {
            f32x16 v = acc[i][0];
            if (!den) {
                float* o = p.out + OFF_KROPE + ((size_t)((b * 2 + l) * 256 + s)) * 32; st_f32_tile(o, v, h);
                bf16_t* dst = p.kmla_ctx + ((size_t)(b * 256 + s) * 6) * 96 + 64;
#pragma unroll
                for (int hh = 0; hh < 6; ++hh) st_bf16_tile(dst + hh * 96, v, h);
            } else {
#pragma unroll
                for (int e = 0; e < 8; ++e) { const f32x2 cs = p.rope_m[s * 16 + crow(e, h)]; float x1 = v[e], x2 = v[e + 8]; rope_pair(x1, x2, cs); v[e] = x1; v[e + 8] = x2; }
                bf16_t* dst = p.kmla_den + ((size_t)((l * 2 + b) * 2304 + 256 + s) * 6) * 96 + 64;
#pragma unroll
                for (int hh = 0; hh < 6; ++hh) st_bf16_tile(dst + hh * 96, v, h);
            }
        }
    }
}

#define FOR_TILES_32M(NT, mvar, nvar)                                                             \
    for (int _lid = (lbid() >> 3), mvar = 4 * (lbid() & 7) + (_lid & 3), nvar = _lid >> 2; _lid < 4 * (NT);     \
         _lid += (int)(gridDim.x >> 3), mvar = 4 * (lbid() & 7) + (_lid & 3), nvar = _lid >> 2)

DI void phase_win(KPR p, int l, char* lds) {
    const int tid = ltid(), lane = tid & 63, wid = tid >> 6, wr = wid >> 2, wc = wid & 3, r = lane & 31, h = lane >> 5;
    FOR_TILES_32M(7, m, n) {
        f32x16 acc[4][2];
        gemm_tile<4>(p.h + (size_t)m * 256 * D, D, p.wt_in + l * SZ_WIN + (size_t)n * 256 * D, D, D, lds, acc);
        epi_win<4>(p, l, acc, m * 256 + wr * 128, n * 256 + wc * 64, r, h);
    }
}

DI void phase_mid(KPR p, int l, char* lds, bool rep = false) {
    const int tid = ltid(), lane = tid & 63, wid = tid >> 6, wr = wid >> 1, wc = wid & 1, r = lane & 31, h = lane >> 5;
    for (int t = lbid(); t < 492; t += gridDim.x) {
        f32x16 acc[2][2];
        if (t < 160) {
            const int m = t / 5, n = t % 5;
            gemm_tile<2>(p.cq + (size_t)m * 256 * 384, 384, p.wt_qup + l * SZ_QUP + (size_t)n * 128 * 384, 384, 384, lds, acc);
            const int cb = n * 128 + wc * 64;
#pragma unroll
            for (int i = 0; i < 2; ++i) {
                const int T = m * 256 + wr * 64 + i * 32 + r; const bool den = T >= NCTX; const int s = (T - NCTX) & 2047;
                float ss = 0.f;
#pragma unroll
                for (int k = 0; k < 6; ++k) ss += p.ssq_q[T * 6 + k];
                const float rs = rsqrtf(ss * (1.f / 384.f) + EPS) * (0.10206207261596575f * LOG2E);
#pragma unroll
                for (int j = 0; j < 2; ++j) {
                    const int ct = (cb >> 5) + j; if (ct >= 18) continue;
                    f32x16 v;
#pragma unroll
                    for (int e = 0; e < 16; ++e) v[e] = acc[i][j][e] * rs;
                    if ((ct % 3) == 2 && den) {
#pragma unroll
                        for (int e = 0; e < 8; ++e) { const f32x2 cs = p.rope_m[s * 16 + crow(e, h)]; float x1 = v[e], x2 = v[e + 8]; rope_pair(x1, x2, cs); v[e] = x1; v[e + 8] = x2; }
                    }
                    st_bf16_tile(p.qmla + (size_t)T * 576 + ct * 32, v, h);
                }
            }
        } else if (t < 364) {
            const int tt = t - 160, mt = tt / 6, hd = tt % 6;
            const bf16_t* A; const bf16_t* W; int kind, b = 0, s0 = 0, T0 = 0;
            if (mt < 32) { T0 = mt * 256; A = p.ckv + (size_t)T0 * 256; W = p.wt_kvg; kind = mt < 16 ? 0 : 1; if (kind == 0) { b = T0 >> 8; s0 = 0; } else { b = (T0 - NCTX) >> 11; s0 = 256 + ((T0 - NCTX) & 2047); } }
            else { b = mt - 32; s0 = 0; A = p.ckv_cache + ((size_t)(b * 2 + l) * 256) * 256; W = p.wt_kvp; kind = 2; }
            gemm_tile<2>(A, 256, W + l * SZ_KV + (size_t)hd * 128 * 256, 256, 256, lds, acc);
#pragma unroll
            for (int i = 0; i < 2; ++i) {
                const int ro = wr * 64 + i * 32 + r; float rs = 1.f;
                if (kind < 2) { const int T = T0 + ro; const float ss = p.ssq_kv[T * 4] + p.ssq_kv[T * 4 + 1] + p.ssq_kv[T * 4 + 2] + p.ssq_kv[T * 4 + 3]; rs = rsqrtf(ss * (1.f / 256.f) + EPS); }
                const int key = s0 + ro;
                f32x16 v0, v1;
#pragma unroll
                for (int e = 0; e < 16; ++e) { v0[e] = acc[i][0][e] * rs; v1[e] = acc[i][1][e] * rs; }
                if (wc == 0) {
                    bf16_t* dst = kind == 0 ? p.kmla_ctx + ((size_t)(b * 256 + key) * 6 + hd) * 96 : p.kmla_den + ((size_t)((l * 2 + b) * 2304 + key) * 6 + hd) * 96;
                    st_bf16_tile(dst, v0, h); st_bf16_tile(dst + 32, v1, h);
                } else {
                    if (kind == 0) { bf16_t* dst = p.vtmla_ctx + ((size_t)(b * 6 + hd) * 64) * 256 + key; st_bf16_tile_T(dst, 256, v0, h); st_bf16_tile_T(dst + 32 * 256, 256, v1, h); }
                    else { bf16_t* dst = p.vtmla_den + ((size_t)((l * 2 + b) * 6 + hd) * 64) * 2304 + key; st_bf16_tile_T(dst, 2304, v0, h); st_bf16_tile_T(dst + 32 * 2304, 2304, v1, h); }
                }
            }
        } else {
            const int tt = t - 364, m = tt >> 2, g = tt & 3;
            gemm_tile<2>(p.u + (size_t)m * 256 * 256 + g * 64, 256, p.bt_ch, 64, 64, lds, acc);
#pragma unroll
            for (int i = 0; i < 2; ++i) {
                const int T = m * 256 + wr * 64 + i * 32 + r; const bool den = T >= NCTX;
#pragma unroll
                for (int j = 0; j < 2; ++j) {
                    const int c = g * 64 + j * 32;
                    if (!den) { const int b = T >> 8, s = T & 255; st_bf16_tile_T(p.zt_ctx + ((size_t)(b * 256 + c)) * 512 + wc * 256 + s, 512, acc[i][j], h); }
                    else { const int b = (T - NCTX) >> 11, s = (T - NCTX) & 2047; st_bf16_tile_T(p.zt_den + ((size_t)(b * 256 + c)) * 4096 + wc * 2048 + s, 4096, acc[i][j], h); }
                }
            }
        }
    }
    if (!rep)
    for (int i = lbid() * 512 + tid; i < NCTX * 64; i += gridDim.x * 512) {
        const int T = i >> 6, c = (i & 63) * 4, b = T >> 8, s = T & 255;
        const float ss = p.ssq_kv[T * 4] + p.ssq_kv[T * 4 + 1] + p.ssq_kv[T * 4 + 2] + p.ssq_kv[T * 4 + 3]; const float rs = rsqrtf(ss * (1.f / 256.f) + EPS);
        float* o = p.out + OFF_CKV + ((size_t)((b * 2 + l) * 256 + s)) * 256 + c; f32x4 v = *(f32x4*)o; const f32x4 g = *(const f32x4*)(p.g_kv_a + l * 256 + c);
        v.x *= rs * g.x; v.y *= rs * g.y; v.z *= rs * g.z; v.w *= rs * g.w; *(f32x4*)o = v;
    }
}

template <int DQK>
DI void attn_item(const bf16_t* __restrict__ Q, int ldq, const bf16_t* __restrict__ Kp, int ldk, const bf16_t* __restrict__ Vt, int ldv, int Sk, bf16_t* O, int ldo, char* lds) {
    constexpr int KSTR = DQK * 2 + 16, VSTR = 136, KBYTES = 64 * KSTR, STAGE = KBYTES + 64 * VSTR, KCH = DQK / 8;
    int tid = ltid();
    const int lane = tid & 63, w = tid >> 6, r = lane & 31, h = lane >> 5;
    bf16x8 qf[DQK / 16];
#pragma unroll
    for (int ks = 0; ks < DQK / 16; ++ks) qf[ks] = *(const bf16x8*)(Q + (size_t)(w * 32 + r) * ldq + ks * 16 + h * 8);
    f32x16 oacc[2];
#pragma unroll
    for (int e = 0; e < 16; ++e) { oacc[0][e] = 0.f; oacc[1][e] = 0.f; }
    float mrun = -INFINITY, lrun = 0.f;
    u32x4 rk[2], rv;
    const bool k2 = (DQK == 96) && tid < 256;
    const int kr0 = tid / KCH, kc0 = tid % KCH, kr1 = (tid + 512) / KCH, kc1 = (tid + 512) % KCH;
    const int vrow = tid >> 3, vch = tid & 7;
    auto gload = [&](int kt) {
        rk[0] = *(const u32x4*)(Kp + (size_t)(kt * 64 + kr0) * ldk + kc0 * 8);
        if (k2) rk[1] = *(const u32x4*)(Kp + (size_t)(kt * 64 + kr1) * ldk + kc1 * 8);
        rv = *(const u32x4*)(Vt + (size_t)vrow * ldv + kt * 64 + vch * 8);
    };
    auto lstore = [&](int buf) {
        char* base = lds + buf * STAGE;
        *(u32x4*)(base + kr0 * KSTR + kc0 * 16) = rk[0];
        if (k2) *(u32x4*)(base + kr1 * KSTR + kc1 * 16) = rk[1];
        char* d = base + KBYTES + vrow * VSTR + vch * 16; u32x2 lo = {rv.x, rv.y}, hi = {rv.z, rv.w}; *(u32x2*)d = lo; *(u32x2*)(d + 8) = hi;
    };
    gload(0); lstore(0); __syncthreads();
    const int nkt = Sk >> 6;
    for (int kt = 0; kt < nkt; ++kt) {
        const char* kb = lds + (kt & 1) * STAGE; const char* vb = kb + KBYTES;
        if (kt + 1 < nkt) gload(kt + 1);
        f32x16 sacc[2];
#pragma unroll
        for (int sub = 0; sub < 2; ++sub) {
#pragma unroll
            for (int e = 0; e < 16; ++e) sacc[sub][e] = 0.f;
#pragma unroll
            for (int ks = 0; ks < DQK / 16; ++ks) {
                const bf16x8 kf = *(const bf16x8*)(kb + (sub * 32 + r) * KSTR + (ks * 2 + h) * 16);
                sacc[sub] = MFMA(kf, qf[ks], sacc[sub]);
            }
            __builtin_amdgcn_sched_barrier(0);
        }
        float mx = sacc[0][0];
#pragma unroll
        for (int e = 1; e < 16; ++e) mx = fmaxf(mx, sacc[0][e]);
#pragma unroll
        for (int e = 0; e < 16; ++e) mx = fmaxf(mx, sacc[1][e]);
        mx = fmaxf(mx, __shfl_xor(mx, 32));
        const float mnew = fmaxf(mrun, mx);
        const float alpha = __builtin_amdgcn_exp2f(mrun - mnew);
        mrun = mnew;
        float psum = 0.f;
#pragma unroll
        for (int sub = 0; sub < 2; ++sub)
#pragma unroll
            for (int e = 0; e < 16; ++e) { const float pv = __builtin_amdgcn_exp2f(sacc[sub][e] - mnew); sacc[sub][e] = pv; psum += pv; }
        lrun = lrun * alpha + psum;
#pragma unroll
        for (int e = 0; e < 16; ++e) { oacc[0][e] *= alpha; oacc[1][e] *= alpha; }
#pragma unroll
        for (int sub = 0; sub < 2; ++sub)
#pragma unroll
            for (int s2 = 0; s2 < 2; ++s2) {
                u32x4 pw; pw.x = pk_bf16(sacc[sub][8 * s2 + 0], sacc[sub][8 * s2 + 1]); pw.y = pk_bf16(sacc[sub][8 * s2 + 2], sacc[sub][8 * s2 + 3]);
                pw.z = pk_bf16(sacc[sub][8 * s2 + 4], sacc[sub][8 * s2 + 5]); pw.w = pk_bf16(sacc[sub][8 * s2 + 6], sacc[sub][8 * s2 + 7]);
                const bf16x8 pf = __builtin_bit_cast(bf16x8, pw);
#pragma unroll
                for (int dvt = 0; dvt < 2; ++dvt) {
                    const char* va = vb + (dvt * 32 + r) * VSTR + (sub * 32 + s2 * 16 + 4 * h) * 2;
                    const s16x4 lo = *(const s16x4*)va, hi = *(const s16x4*)(va + 16);
                    const bf16x8 vf = __builtin_shufflevector(lo, hi, 0, 1, 2, 3, 4, 5, 6, 7);
                    oacc[dvt] = MFMA(vf, pf, oacc[dvt]);
                }
                __builtin_amdgcn_sched_barrier(0);
            }
        if (kt + 1 < nkt) lstore((kt + 1) & 1);
        __syncthreads();
    }
    lrun += __shfl_xor(lrun, 32);
    const float inv = 1.f / lrun;
#pragma unroll
    for (int dvt = 0; dvt < 2; ++dvt) {
        f32x16 v;
#pragma unroll
        for (int e = 0; e < 16; ++e) v[e] = oacc[dvt][e] * inv;
        st_bf16_tile(O + (size_t)(w * 32 + r) * ldo + dvt * 32, v, h);
    }
}

DI void phase_mix(KPR p, int l, char* lds, unsigned* ctr) {
    const int tid = ltid(), lane = tid & 63, wid = tid >> 6, wr = wid >> 1, wc = wid & 1, r = lane & 31, h = lane >> 5;
    __shared__ unsigned sitem_s; volatile unsigned* sitem = &sitem_s;
    for (;;) {
        __syncthreads();
        if (tid == 0) *sitem = atomicAdd(ctr, 1u);
        __syncthreads();
        const int it = (int)*sitem;
        if (it >= 448) break;
        if (it < 32 || (it >= 224 && it < 256)) {
            f32x16 acc[2][2]; int tokbase, m, n;
            if (it < 32) { const int b = it >> 4; m = (it >> 1) & 7; n = it & 1; tokbase = NCTX + b * 2048;
                gemm_tile<2>(p.tab2048 + (size_t)m * 256 * 4096, 4096, p.zt_den + ((size_t)(b * 256 + n * 128)) * 4096, 4096, 4096, lds, acc); }
            else { const int q = it - 224, b = q >> 1; m = 0; n = q & 1; tokbase = b * 256;
                gemm_tile<2>(p.tab256, 512, p.zt_ctx + ((size_t)(b * 256 + n * 128)) * 512, 512, 512, lds, acc); }
#pragma unroll
            for (int i = 0; i < 2; ++i) {
                const int T = tokbase + m * 256 + wr * 64 + i * 32 + r;
                bf16_t* dst = p.mix + (size_t)T * D + 384 + n * 128 + wc * 64;
                st_bf16_tile(dst, acc[i][0], h); st_bf16_tile(dst + 32, acc[i][1], h);
            }
        } else {
            int b, hd, qb, den;
            if (it < 224) { const int q = it - 32; den = 1; qb = q & 7; hd = (q >> 3) % 12; b = q / 96; } else { const int q = it - 256; den = 0; qb = 0; hd = q % 12; b = q / 12; }
            const int T0 = den ? NCTX + b * 2048 + qb * 256 : b * 256;
            const int Sk = den ? 2304 : 256;
            if (hd < 6) {
                const bf16_t* K = den ? p.kmla_den + ((size_t)(l * 2 + b) * 2304 * 6 + hd) * 96 : p.kmla_ctx + ((size_t)b * 256 * 6 + hd) * 96;
                const bf16_t* V = den ? p.vtmla_den + ((size_t)((l * 2 + b) * 6 + hd) * 64) * 2304 : p.vtmla_ctx + ((size_t)(b * 6 + hd) * 64) * 256;
                attn_item<96>(p.qmla + (size_t)T0 * 576 + hd * 96, 576, K, 576, V, Sk, Sk, p.mix + (size_t)T0 * D + hd * 64, D, lds);
            } else {
                const int hq = hd - 6, hk = hq / 3;
                const bf16_t* K = den ? p.kgqa_den + ((size_t)(l * 2 + b) * 2304 * 2 + hk) * 64 : p.kgqa_ctx + ((size_t)b * 256 * 2 + hk) * 64;
                const bf16_t* V = den ? p.vtgqa_den + ((size_t)((l * 2 + b) * 2 + hk) * 64) * 2304 : p.vtgqa_ctx + ((size_t)(b * 2 + hk) * 64) * 256;
                attn_item<64>(p.gq + (size_t)T0 * 384 + hq * 64, 384, K, 128, V, Sk, Sk, p.mix + (size_t)T0 * D + 640 + hq * 64, D, lds);
            }
        }
    }
}

DI void phase_resid(KPR p, const bf16_t* A, int K, const bf16_t* W, const float* xc, const float* xd, float* xout, const float* gate, char* lds) {
    const int tid = ltid(), lane = tid & 63, wid = tid >> 6, wr = wid >> 1, wc = wid & 1, r = lane & 31, h = lane >> 5;
    FOR_TILES_32M(8, m, n) {
        f32x16 acc[2][2];
        gemm_tile<2>(A + (size_t)m * 256 * K, K, W + (size_t)n * 128 * K, K, K, lds, acc);
#pragma unroll
        for (int i = 0; i < 2; ++i) {
            const int T = m * 256 + wr * 64 + i * 32 + r;
            const float* xr = T < NCTX ? xc + (size_t)T * D : xd + (size_t)(T - NCTX) * D;
            const float* gj = gate + (T < NCTX ? 0 : 1 + ((T - NCTX) >> 11)) * 6144;
#pragma unroll
            for (int j = 0; j < 2; ++j)
#pragma unroll
                for (int q = 0; q < 4; ++q) {
                    const int c = n * 128 + wc * 64 + j * 32 + 8 * q + 4 * h;
                    const f32x4 xv = *(const f32x4*)(xr + c), gv = *(const f32x4*)(gj + c);
                    f32x4 o = {xv.x + gv.x * acc[i][j][4 * q], xv.y + gv.y * acc[i][j][4 * q + 1], xv.z + gv.z * acc[i][j][4 * q + 2], xv.w + gv.w * acc[i][j][4 * q + 3]};
                    *(f32x4*)(xout + (size_t)T * D + c) = o;
                }
        }
    }
}
DI void phase_gu(KPR p, int l, char* lds) {
    const int tid = ltid(), lane = tid & 63, wid = tid >> 6, wr = wid >> 2, wc = wid & 3, r = lane & 31, h = lane >> 5;
    FOR_TILES_32M(22, m, n) {
        f32x16 acc[4][2];
        gemm_tile<4>(p.h + (size_t)m * 256 * D, D, p.wt_gu + l * SZ_GU + (size_t)n * 256 * D, D, D, lds, acc);
#pragma unroll
        for (int i = 0; i < 4; ++i) {
            const int T = m * 256 + wr * 128 + i * 32 + r;
            f32x16 v;
#pragma unroll
            for (int e = 0; e < 16; ++e) v[e] = silu(acc[i][0][e]) * acc[i][1][e];
            st_bf16_tile(p.hid + (size_t)T * DFF + (n * 4 + wc) * 32, v, h);
        }
    }
}

constexpr int NPHASE = 18;
template <int PM>
__global__ void __launch_bounds__(512, 2) fwd_megakernel(P p_arg) {
    KP kp0 = (KP)__builtin_amdgcn_kernarg_segment_ptr();
    KPR p = *kp0;
    __shared__ __attribute__((aligned(16))) char lds[131072];
    __shared__ uint4 xbw;
    if (p.never) cg::this_grid().sync();
    if (threadIdx.x == 0) xbw = make_uint4(0u, 0u, 0u, 0u);
    __syncthreads();
    XcdBarrier xb;
    if (!MULTI_LAUNCH) xb = xcd_barrier_post(p.bar, (volatile LAS unsigned*)&xbw);
    const int ph0 = p.ph0, ph1 = p.ph1;
    for (int ph = ph0; ph < ph1; ++ph) {
        KP kp = kp0; asm volatile("" : "+s"(kp));
        KPR p = *kp;
        if (ph == 0) { if (PM & 1) phase_prologue(p, lds); }
        else if (ph == 17) { if (PM & 2) phase_final(p, p.xa); }
        else {
            const int l = (ph - 1) >> 3, s = (ph - 1) & 7;
            const float* modl = p.mod + (size_t)l * 3 * 6144;
            const float* xc = l == 0 ? p.x_prompt : p.xa;
            const float* xd = l == 0 ? p.x_sample : p.xa + (size_t)NCTX * D;
            switch (s) {
                case 0: if (PM & 4) phase_norm(p, xc, xd, p.g_norm1 + l * D, modl, 0, 1024); break;
                case 1: if (PM & 8) phase_win(p, l, lds); break;
                case 2: if (PM & 16) phase_mid(p, l, lds); break;
                case 3: if (PM & 32) phase_mix(p, l, lds, p.ctr + 64 * l); break;
                case 4: if (PM & 64) phase_resid(p, p.mix, D, p.wt_out + l * SZ_WOUT, xc, xd, p.xb, modl + 2048, lds); break;
                case 5: if (PM & 4) phase_norm(p, p.xb, p.xb + (size_t)NCTX * D, p.g_norm2 + l * D, modl, 3072, 4096); break;
                case 6: if (PM & 128) phase_gu(p, l, lds); break;
                case 7: if (PM & 64) phase_resid(p, p.hid, DFF, p.wt_down + l * SZ_DOWN, p.xb, p.xb + (size_t)NCTX * D, p.xa, modl + 5120, lds); break;
            }
        }
#ifdef DBL
        if (ph >= 1 && ph < 17) {
            const int l = (ph - 1) >> 3, s = (ph - 1) & 7;
            const float* modl = p.mod + (size_t)l * 3 * 6144;
            const float* xc = l == 0 ? p.x_prompt : p.xa;
            const float* xd = l == 0 ? p.x_sample : p.xa + (size_t)NCTX * D;
            for (int rep = 0; rep < DBLN; ++rep) {
            if (s == 0 && (DBL & 4)) phase_norm(p, xc, xd, p.g_norm1 + l * D, modl, 0, 1024);
            if (s == 1 && (DBL & 8)) phase_win(p, l, lds);
            if (s == 2 && (DBL & 16)) phase_mid(p, l, lds, true);
            if (s == 3 && (DBL & 32)) phase_mix(p, l, lds, p.ctr + 64 * l + 16 + rep);
            if (s == 4 && (DBL & 64)) phase_resid(p, p.mix, D, p.wt_out + l * SZ_WOUT, xc, xd, p.xb, modl + 2048, lds);
            if (s == 6 && (DBL & 128)) phase_gu(p, l, lds);
            if (s == 7 && (DBL & 256)) phase_resid(p, p.hid, DFF, p.wt_down + l * SZ_DOWN, p.xb, p.xb + (size_t)NCTX * D, p.xa, modl + 5120, lds);
            }
        }
#endif
        if (!MULTI_LAUNCH && ph + 1 < ph1) xcd_barrier(xb);
    }
}

extern "C" void kernel_launch(void* const* d_in, const int* in_sizes, int n_in, void* d_out, int out_size, void* d_ws, size_t ws_size, hipStream_t stream) {
    static int grid_blocks = 0;
    if (!grid_blocks) {
        int dev = 0, cus = 0, per_cu = 0;
        hipGetDevice(&dev);
        hipDeviceGetAttribute(&cus, hipDeviceAttributeMultiprocessorCount, dev);
        hipOccupancyMaxActiveBlocksPerMultiprocessor(&per_cu, fwd_megakernel<(MULTI_LAUNCH ? 32 : FUSEMASK)>, 512, 0);
        if (per_cu > 1) per_cu = 1;
        if (per_cu < 1) per_cu = 1;
        grid_blocks = cus * per_cu;
        grid_blocks &= ~7;
    }
    P p{};
    const float* const* in = (const float* const*)d_in;
    p.x_prompt = in[0]; p.x_sample = in[1]; p.c_ckv = in[2]; p.c_krope = in[3]; p.c_gk = in[4]; p.c_gv = in[5]; p.c = in[6]; p.c_ctx = in[7]; p.w_ada = in[8]; p.b_ada = in[9];
    p.g_norm1 = in[10]; p.g_norm2 = in[11]; p.w_in = in[12]; p.g_q_a = in[13]; p.w_q_up = in[14]; p.g_kv_a = in[15]; p.w_kv_up = in[16]; p.g_q_head = in[17]; p.g_k_head = in[18];
    p.w_out = in[19]; p.w_gate = in[20]; p.w_up = in[21]; p.w_down = in[22]; p.g_final = in[23];
    p.out = (float*)d_out;
    char* ws = (char*)d_ws; size_t off = 0;
    auto alloc = [&](size_t bytes) { char* r = ws + off; off += (bytes + 255) & ~(size_t)255; return r; };
    p.bar = (unsigned*)alloc(XCD_BAR_WORDS * 4); p.ctr = (unsigned*)alloc(1024); p.mod = (float*)alloc(2 * 3 * 6144 * 4);
    const size_t zero_bytes = off;
    p.wt_in = (bf16_t*)alloc(2 * SZ_WIN * 2); p.wt_qup = (bf16_t*)alloc(2 * SZ_QUP * 2); p.wt_kvg = (bf16_t*)alloc(2 * SZ_KV * 2); p.wt_kvp = (bf16_t*)alloc(2 * SZ_KV * 2);
    p.wt_out = (bf16_t*)alloc(2 * SZ_WOUT * 2); p.wt_gu = (bf16_t*)alloc(2 * SZ_GU * 2); p.wt_down = (bf16_t*)alloc(2 * SZ_DOWN * 2);
    p.tab2048 = (bf16_t*)alloc((size_t)2048 * 4096 * 2); p.tab256 = (bf16_t*)alloc(256 * 512 * 2); p.bt_ch = (bf16_t*)alloc(128 * 64 * 2);
    p.rope_g = (f32x2*)alloc(2048 * 32 * 8); p.rope_m = (f32x2*)alloc(2048 * 16 * 8);
    p.ckv_cache = (bf16_t*)alloc(2 * 2 * 256 * 256 * 2);
    p.h = (bf16_t*)alloc((size_t)NTOK * D * 2);
    p.ssq_q = (float*)alloc(NTOK * 6 * 4); p.ssq_kv = (float*)alloc(NTOK * 4 * 4);
    p.xa = (float*)alloc((size_t)NTOK * D * 4); p.xb = (float*)alloc((size_t)NTOK * D * 4);
    p.kmla_ctx = (bf16_t*)alloc((size_t)16 * 256 * 576 * 2); p.vtmla_ctx = (bf16_t*)alloc((size_t)16 * 6 * 64 * 256 * 2);
    p.kgqa_ctx = (bf16_t*)alloc((size_t)16 * 256 * 128 * 2); p.vtgqa_ctx = (bf16_t*)alloc((size_t)16 * 2 * 64 * 256 * 2);
    p.kmla_den = (bf16_t*)alloc((size_t)4 * 2304 * 576 * 2); p.vtmla_den = (bf16_t*)alloc((size_t)4 * 6 * 64 * 2304 * 2);
    p.kgqa_den = (bf16_t*)alloc((size_t)4 * 2304 * 128 * 2); p.vtgqa_den = (bf16_t*)alloc((size_t)4 * 2 * 64 * 2304 * 2);
    p.zt_ctx = (bf16_t*)alloc((size_t)16 * 256 * 512 * 2); p.zt_den = (bf16_t*)alloc((size_t)2 * 256 * 4096 * 2);
    const size_t ov = off;
    p.cq = (bf16_t*)alloc((size_t)NTOK * 384 * 2); p.ckv = (bf16_t*)alloc((size_t)NTOK * 256 * 2); p.u = (bf16_t*)alloc((size_t)NTOK * 256 * 2);
    p.gq = (bf16_t*)alloc((size_t)NTOK * 384 * 2); p.qmla = (bf16_t*)alloc((size_t)NTOK * 576 * 2); p.mix = (bf16_t*)alloc((size_t)NTOK * D * 2);
    p.hid = (bf16_t*)(ws + ov);
    if (off - ov < (size_t)NTOK * DFF * 2) off = ov + (size_t)NTOK * DFF * 2;
    if (off > ws_size) { fprintf(stderr, "workspace too small: need %zu have %zu\n", off, ws_size); return; }
    hipMemsetAsync(ws, 0, zero_bytes, stream);
#if MULTI_LAUNCH
    for (int ph = 0; ph < NPHASE; ++ph) {
        P q = p; q.ph0 = ph; q.ph1 = ph + 1;
        const int s = (ph - 1) & 7;
        if (ph == 0) hipLaunchKernelGGL(fwd_megakernel<1>, dim3(grid_blocks), dim3(512), 0, stream, q);
        else if (ph == 17) hipLaunchKernelGGL(fwd_megakernel<2>, dim3(grid_blocks), dim3(512), 0, stream, q);
        else if (s == 0 || s == 5) hipLaunchKernelGGL(fwd_megakernel<4>, dim3(grid_blocks), dim3(512), 0, stream, q);
        else if (s == 1) hipLaunchKernelGGL(fwd_megakernel<8>, dim3(grid_blocks), dim3(512), 0, stream, q);
        else if (s == 2) hipLaunchKernelGGL(fwd_megakernel<16>, dim3(grid_blocks), dim3(512), 0, stream, q);
        else if (s == 3) hipLaunchKernelGGL(fwd_megakernel<32>, dim3(grid_blocks), dim3(512), 0, stream, q);
        else if (s == 4 || s == 7) hipLaunchKernelGGL(fwd_megakernel<64>, dim3(grid_blocks), dim3(512), 0, stream, q);
        else hipLaunchKernelGGL(fwd_megakernel<128>, dim3(grid_blocks), dim3(512), 0, stream, q);
    }
#else
    p.ph0 = 0; p.ph1 = NPHASE;
    void* args[] = {&p};
    hipError_t e = hipLaunchCooperativeKernel((void*)fwd_megakernel<FUSEMASK>, dim3(grid_blocks), dim3(512), args, 0, stream);
    if (e != hipSuccess) fprintf(stderr, "cooperative launch failed: %s (grid %d)\n", hipGetErrorString(e), grid_blocks);
#endif
}
```

```cpp
#include <hip/hip_runtime.h>
#include <hip/hip_cooperative_groups.h>
#include <stdint.h>
#include <stdio.h>
namespace cg = cooperative_groups;

#ifndef FUSEMASK
#define FUSEMASK 0xffff
#endif
#ifndef MULTI_LAUNCH
#define MULTI_LAUNCH 0
#endif

typedef unsigned short bf16_t;
typedef short bf16x8 __attribute__((ext_vector_type(8)));
typedef short s16x4 __attribute__((ext_vector_type(4)));
typedef float f32x16 __attribute__((ext_vector_type(16)));
typedef float f32x4 __attribute__((ext_vector_type(4)));
typedef float f32x2 __attribute__((ext_vector_type(2)));
typedef unsigned u32x4 __attribute__((ext_vector_type(4)));
typedef unsigned u32x2 __attribute__((ext_vector_type(2)));
#define DI __device__ __forceinline__
#define LAS __attribute__((address_space(3)))

constexpr int D = 1024, NTOK = 8192, NCTX = 4096, DFF = 2816;
constexpr int NINP = 1792;
constexpr float EPS = 1e-6f;
constexpr float LOG2E = 1.4426950408889634f;
constexpr size_t OFF_YP = 0, OFF_YS = 4194304, OFF_CKV = 8388608, OFF_KROPE = 10485760, OFF_GK = 10747904, OFF_GV = 11796480;
constexpr size_t SZ_WIN = (size_t)NINP * 1024, SZ_QUP = 640 * 384, SZ_KV = 768 * 256, SZ_WOUT = 1024 * 1024, SZ_GU = (size_t)5632 * 1024, SZ_DOWN = (size_t)1024 * 2816;

struct P {
    const float *x_prompt, *x_sample, *c_ckv, *c_krope, *c_gk, *c_gv, *c, *c_ctx, *w_ada, *b_ada, *g_norm1, *g_norm2, *w_in, *g_q_a, *w_q_up, *g_kv_a,
        *w_kv_up, *g_q_head, *g_k_head, *w_out, *w_gate, *w_up, *w_down, *g_final;
    float* out;
    unsigned* bar;
    unsigned* ctr;
    float* mod;
    bf16_t *wt_in, *wt_qup, *wt_kvg, *wt_kvp, *wt_out, *wt_gu, *wt_down;
    bf16_t *tab2048, *tab256, *bt_ch;
    f32x2 *rope_g, *rope_m;
    bf16_t* ckv_cache;
    bf16_t *h, *cq, *ckv, *u, *gq, *qmla, *mix, *hid;
    float *ssq_q, *ssq_kv;
    float *xa, *xb;
    bf16_t *kmla_ctx, *vtmla_ctx, *kgqa_ctx, *vtgqa_ctx;
    bf16_t *kmla_den, *vtmla_den, *kgqa_den, *vtgqa_den;
    bf16_t *zt_ctx, *zt_den;
    int never, ph0, ph1, pad;
};

typedef const volatile __attribute__((address_space(4))) P& KPR;
typedef const volatile __attribute__((address_space(4))) P* KP;
typedef __bf16 nbf16x2 __attribute__((ext_vector_type(2)));
DI unsigned pk_bf16(float lo, float hi) { f32x2 v = {lo, hi}; nbf16x2 b = __builtin_convertvector(v, nbf16x2); return __builtin_bit_cast(unsigned, b); }
DI bf16_t to_bf16(float x) { return (bf16_t)(pk_bf16(x, 0.f) & 0xffffu); }
DI int crow(int e, int h) { return (e & 3) + 8 * (e >> 2) + 4 * h; }
DI int ltid() { int t = threadIdx.x; asm volatile("" : "+v"(t)); return t; }
DI int lbid() { int b = blockIdx.x; asm volatile("" : "+s"(b)); return b; }
DI float silu(float x) { return x / (1.f + __expf(-x)); }
#define MFMA(a, b, c) __builtin_amdgcn_mfma_f32_32x32x16_bf16((a), (b), (c), 0, 0, 0)

#define XB_TMO 128
#define XB_XCNT(j) (256 + 64 * (j))
#define XB_XSUB(j) (1280 + 64 * (j))
#define XB_XGEN(j) (2304 + 64 * (j))
#define XB_TOP 3328
#define XB_TOPGEN 3392
#define XCD_BAR_WORDS 3456
#define XB_SPIN_CAP (1u << 20)
DI unsigned xb_ld(unsigned* p) { return __hip_atomic_load(p, __ATOMIC_RELAXED, __HIP_MEMORY_SCOPE_AGENT); }
DI unsigned xb_add(unsigned* p, unsigned v) { return __hip_atomic_fetch_add(p, v, __ATOMIC_RELAXED, __HIP_MEMORY_SCOPE_AGENT); }
DI unsigned xb_xcc_id() { return (unsigned)__builtin_amdgcn_s_getreg((3 << 11) | 20) & 0xFu; }
#define XB_SPIN(cond, bar)                                                                         \
    do {                                                                                           \
        unsigned _sp = 0;                                                                          \
        while (cond) {                                                                             \
            __builtin_amdgcn_s_sleep(1);                                                           \
            if ((++_sp & 255u) == 0u) {                                                            \
                if (xb_ld(&(bar)[XB_TMO])) break;                                                  \
                if (_sp > XB_SPIN_CAP) { atomicAdd(&(bar)[XB_TMO], 1u); break; }                   \
            }                                                                                      \
        }                                                                                          \
    } while (0)
struct XcdBarrier { unsigned* bar; unsigned x; volatile LAS unsigned* st; };
DI XcdBarrier xcd_barrier_post(unsigned* bar, volatile LAS unsigned* st) {
    XcdBarrier b; b.bar = bar; b.x = xb_xcc_id(); b.st = st;
    if (threadIdx.x == 0) (void)xb_add(&bar[XB_XCNT(b.x)], 1u);
    return b;
}
DI void xcd_barrier_complete(unsigned* bar, unsigned x, unsigned& nloc, unsigned& nx) {
    const unsigned G = gridDim.x * gridDim.y * gridDim.z;
    unsigned sum, cnt, mine, sp = 0u;
    for (;;) {
        sum = 0u; cnt = 0u; mine = 0u;
#pragma unroll
        for (unsigned j = 0; j < 16; ++j) { const unsigned c = xb_ld(&bar[XB_XCNT(j)]); sum += c; cnt += (c > 0u) ? 1u : 0u; mine = (j == x) ? c : mine; }
        if (sum == G) break;
        __builtin_amdgcn_s_sleep(1);
        if ((++sp & 255u) == 0u) { if (xb_ld(&bar[XB_TMO])) break; if (sp > XB_SPIN_CAP) { atomicAdd(&bar[XB_TMO], 1u); break; } }
    }
    nloc = mine > 0u ? mine : 1u; nx = cnt > 0u ? cnt : 1u;
}
DI void xcd_barrier(const XcdBarrier& b) {
    asm volatile("s_waitcnt vmcnt(0)" ::: "memory");
    __syncthreads();
    if (threadIdx.x == 0) {
        unsigned* bar = b.bar;
        __builtin_amdgcn_s_waitcnt(0);
        unsigned nloc = b.st[0], nx = b.st[1];
        if (nloc == 0u) { xcd_barrier_complete(bar, b.x, nloc, nx); b.st[0] = nloc; b.st[1] = nx; }
        const unsigned old = xb_add(&bar[XB_XSUB(b.x)], 1u);
        const unsigned gen = old / nloc;
        if (old + 1u == (gen + 1u) * nloc) {
            __builtin_amdgcn_fence(__ATOMIC_RELEASE, "agent");
            asm volatile("s_waitcnt vmcnt(0)" ::: "memory");
            const unsigned og = xb_add(&bar[XB_TOP], 1u);
            const unsigned tg = og / nx;
            if (og + 1u == (tg + 1u) * nx) xb_add(&bar[XB_TOPGEN], 1u);
            else XB_SPIN(xb_ld(&bar[XB_TOPGEN]) == tg, bar);
            __builtin_amdgcn_fence(__ATOMIC_ACQUIRE, "agent");
            xb_add(&bar[XB_XGEN(b.x)], 1u);
            asm volatile("s_waitcnt vmcnt(0)" ::: "memory");
        } else {
            XB_SPIN(xb_ld(&bar[XB_XGEN(b.x)]) == gen, bar);
            __builtin_amdgcn_fence(__ATOMIC_ACQUIRE, "agent");
            asm volatile("s_waitcnt vmcnt(0)" ::: "memory");
        }
    }
    __syncthreads();
}

DI void glds16(const void* g, unsigned lds_addr) {
    unsigned keep;
    asm volatile("s_mov_b32 %0, m0\n\ts_mov_b32 m0, %2\n\ts_nop 0\n\tglobal_load_lds_dwordx4 %1, off\n\ts_mov_b32 m0, %0" : "=&s"(keep) : "v"(g), "s"(lds_addr) : "memory");
}
template <int WM>
DI void gemm_tile(const bf16_t* __restrict__ A, int lda, const bf16_t* __restrict__ B, int ldb, int K, char* lds, f32x16 (&acc)[WM][2]) {
    constexpr int NB = WM == 4 ? 4 : (WM == 2 ? 2 : 1);
    int tid = threadIdx.x; asm volatile("" : "+v"(tid));
    const int lane = tid & 63, wid = tid >> 6, r = lane & 31, h = lane >> 5;
    const int wr = WM == 4 ? (wid >> 2) : (WM == 2 ? (wid >> 1) : wid), wc = WM == 4 ? (wid & 3) : (WM == 2 ? (wid & 1) : 0);
#pragma unroll
    for (int i = 0; i < WM; ++i)
#pragma unroll
        for (int j = 0; j < 2; ++j)
#pragma unroll
            for (int e = 0; e < 16; ++e) acc[i][j][e] = 0.f;
    const int lrow = wid * 8 + (lane >> 3);
    const int lkc = (lane & 7) ^ ((lrow >> 1) & 7);
    const bf16_t* ga = A + (size_t)lrow * lda + lkc * 8;
    const bf16_t* gb = B + (size_t)lrow * ldb + lkc * 8;
    LAS char* l3 = (LAS char*)lds;
    const unsigned lbase = (unsigned)(size_t)l3 + (unsigned)__builtin_amdgcn_readfirstlane(wid) * 1024u;
    const int swz = (r >> 1) & 7;
    const int aofs = (wr * (WM * 32) + r) * 128, bofs = 32768 + (wc * 64 + r) * 128;
#define GLDS_TILE(buf, k0)                                                                            \
    _Pragma("unroll") for (int i = 0; i < 4; ++i) glds16(ga + (size_t)i * 64 * lda + (k0), lbase + (buf) + i * 8192);          \
    _Pragma("unroll") for (int i = 0; i < NB; ++i) glds16(gb + (size_t)i * 64 * ldb + (k0), lbase + (buf) + 32768 + i * 8192);
    GLDS_TILE(0, 0)
    asm volatile("s_waitcnt vmcnt(0)" ::: "memory");
    __syncthreads();
    const int nt = K >> 6;
    for (int t = 0; t < nt; ++t) {
        const int cur = (t & 1) * 65536, nxt = 65536 - cur;
        if (t + 1 < nt) { const int k0 = (t + 1) << 6; GLDS_TILE(nxt, k0) }
        bf16x8 af[2][WM], bfr[2][2];
#define LOAD_FRAGS(slot, ks)                                                                                         \
        { const int co = (((ks) * 2 + h) ^ swz) << 4;                                                                \
          _Pragma("unroll") for (int i = 0; i < WM; ++i) af[slot][i] = *(const LAS bf16x8*)(l3 + cur + aofs + i * 4096 + co);   \
          _Pragma("unroll") for (int j = 0; j < 2; ++j) bfr[slot][j] = *(const LAS bf16x8*)(l3 + cur + bofs + j * 4096 + co); }
        LOAD_FRAGS(0, 0)
#pragma unroll
        for (int ks = 0; ks < 4; ++ks) {
            if (ks < 3) LOAD_FRAGS((ks + 1) & 1, ks + 1)
#pragma unroll
            for (int i = 0; i < WM; ++i)
#pragma unroll
                for (int j = 0; j < 2; ++j) acc[i][j] = MFMA(bfr[ks & 1][j], af[ks & 1][i], acc[i][j]);
            __builtin_amdgcn_sched_barrier(0);
        }
#undef LOAD_FRAGS
        asm volatile("s_waitcnt vmcnt(0)" ::: "memory");
        __syncthreads();
    }
#undef GLDS_TILE
}

template <int WM>
DI void gemm_tile3(const bf16_t* __restrict__ A, int lda, const bf16_t* __restrict__ B, int ldb, int K, char* lds, f32x16 (&acc)[WM][2]) {
    static_assert(WM <= 2, "three 64-deep stages only fit for BN <= 128");
    constexpr int NB = WM == 2 ? 2 : 1;
    int tid = ltid();
    const int lane = tid & 63, wid = tid >> 6, r = lane & 31, h = lane >> 5;
    const int wr = WM == 2 ? (wid >> 1) : wid, wc = WM == 2 ? (wid & 1) : 0;
#pragma unroll
    for (int i = 0; i < WM; ++i)
#pragma unroll
        for (int j = 0; j < 2; ++j)
#pragma unroll
            for (int e = 0; e < 16; ++e) acc[i][j][e] = 0.f;
    const int lrow = wid * 8 + (lane >> 3);
    const int lkc = (lane & 7) ^ ((lrow >> 1) & 7);
    const bf16_t* ga = A + (size_t)lrow * lda + lkc * 8;
    const bf16_t* gb = B + (size_t)lrow * ldb + lkc * 8;
    LAS char* l3 = (LAS char*)lds;
    const unsigned lbase = (unsigned)(size_t)l3 + (unsigned)__builtin_amdgcn_readfirstlane(wid) * 1024u;
    const int swz = (r >> 1) & 7;
    const int aofs = (wr * (WM * 32) + r) * 128, bofs = 32768 + (wc * 64 + r) * 128;
#define ISSUE3(buf, k0)                                                                               \
    { _Pragma("unroll") for (int i = 0; i < 4; ++i) glds16(ga + (size_t)i * 64 * lda + (k0), lbase + (buf) + i * 8192);          \
      _Pragma("unroll") for (int i = 0; i < NB; ++i) glds16(gb + (size_t)i * 64 * ldb + (k0), lbase + (buf) + 32768 + i * 8192); }
    const int nt = K >> 6;
    ISSUE3(0, 0)
    if (nt > 1) ISSUE3(49152, 64)
    int cur = 0, nxt2 = 98304;
    for (int t = 0; t < nt; ++t) {
        if (t + 1 < nt) { if (NB == 2) asm volatile("s_waitcnt vmcnt(6)" ::: "memory"); else asm volatile("s_waitcnt vmcnt(5)" ::: "memory"); }
        else asm volatile("s_waitcnt vmcnt(0)" ::: "memory");
        asm volatile("s_waitcnt lgkmcnt(0)" ::: "memory");
        __builtin_amdgcn_s_barrier();
        asm volatile("" ::: "memory");
        if (t + 2 < nt) { const int k0 = (t + 2) << 6; ISSUE3(nxt2, k0) }
        bf16x8 af[2][WM], bfr[2][2];
#define LOAD_FRAGS3(slot, ks)                                                                                         \
        { const int co = (((ks) * 2 + h) ^ swz) << 4;                                                                \
          _Pragma("unroll") for (int i = 0; i < WM; ++i) af[slot][i] = *(const LAS bf16x8*)(l3 + cur + aofs + i * 4096 + co);   \
          _Pragma("unroll") for (int j = 0; j < 2; ++j) bfr[slot][j] = *(const LAS bf16x8*)(l3 + cur + bofs + j * 4096 + co); }
        LOAD_FRAGS3(0, 0)
#pragma unroll
        for (int ks = 0; ks < 4; ++ks) {
            if (ks < 3) LOAD_FRAGS3((ks + 1) & 1, ks + 1)
#pragma unroll
            for (int i = 0; i < WM; ++i)
#pragma unroll
                for (int j = 0; j < 2; ++j) acc[i][j] = MFMA(bfr[ks & 1][j], af[ks & 1][i], acc[i][j]);
            __builtin_amdgcn_sched_barrier(0);
        }
#undef LOAD_FRAGS3
        const int tmp = cur; cur = cur == 98304 ? 0 : cur + 49152; nxt2 = tmp;
    }
#undef ISSUE3
    __syncthreads();
}

DI void st_bf16_tile(bf16_t* dst, const f32x16& v, int h) {
#pragma unroll
    for (int q = 0; q < 4; ++q) {
        u32x2 w; w.x = pk_bf16(v[4 * q], v[4 * q + 1]); w.y = pk_bf16(v[4 * q + 2], v[4 * q + 3]);
        *(u32x2*)(dst + 8 * q + 4 * h) = w;
    }
}
DI void st_f32_tile(float* dst, const f32x16& v, int h) {
#pragma unroll
    for (int q = 0; q < 4; ++q) { f32x4 w = {v[4 * q], v[4 * q + 1], v[4 * q + 2], v[4 * q + 3]}; *(f32x4*)(dst + 8 * q + 4 * h) = w; }
}
DI void st_bf16_tile_T(bf16_t* dst, size_t ld, const f32x16& v, int h) {
#pragma unroll
    for (int e = 0; e < 16; ++e) dst[(size_t)crow(e, h) * ld] = to_bf16(v[e]);
}
DI float sumsq16(const f32x16& v) { float s = 0.f;
#pragma unroll
    for (int e = 0; e < 16; ++e) s += v[e] * v[e];
    return s; }

DI const float* win_src(const float* w, int nd) {
    int sc;
    if (nd < 640) sc = nd; else if (nd < 1024) sc = 928 + (nd - 640); else if (nd < 1152) sc = 1312 + (nd - 1024); else if (nd < 1280) sc = 1440 + (nd - 1152);
    else if (nd < 1536) sc = 672 + (nd - 1280); else if (nd < 1568) sc = 640 + (nd - 1536); else return nullptr;
    return w + sc;
}
DI void tr_tile(const float* colp, int nsrc, bf16_t* dst, int K, int k0, int nd0, const float* kscale, float* tile) {
    const int tid = ltid() & 255, tn = tid & 63, tk = tid >> 6;
    float tv[16];
#pragma unroll
    for (int i = 0; i < 16; ++i) tv[i] = colp ? colp[(size_t)(k0 + tk + 4 * i) * nsrc] : 0.f;
    if (kscale) {
#pragma unroll
        for (int i = 0; i < 16; ++i) tv[i] *= kscale[k0 + tk + 4 * i];
    }
#pragma unroll
    for (int i = 0; i < 16; ++i) tile[(tk + 4 * i) * 65 + tn] = tv[i];
    __syncthreads();
    const int rr = tid >> 2, kq = tid & 3;
    u32x4 o0, o1;
    const float* tp = tile + (kq * 16) * 65 + rr;
    o0.x = pk_bf16(tp[0 * 65], tp[1 * 65]); o0.y = pk_bf16(tp[2 * 65], tp[3 * 65]); o0.z = pk_bf16(tp[4 * 65], tp[5 * 65]); o0.w = pk_bf16(tp[6 * 65], tp[7 * 65]);
    o1.x = pk_bf16(tp[8 * 65], tp[9 * 65]); o1.y = pk_bf16(tp[10 * 65], tp[11 * 65]); o1.z = pk_bf16(tp[12 * 65], tp[13 * 65]); o1.w = pk_bf16(tp[14 * 65], tp[15 * 65]);
    bf16_t* d = dst + (size_t)(nd0 + rr) * K + k0 + kq * 16;
    *(u32x4*)d = o0; *(u32x4*)(d + 8) = o1;
    __syncthreads();
}

DI void phase_prologue(KPR p, char* lds) {
    const int tid = ltid(), bid = lbid(), G = gridDim.x;
    float* tile = (float*)lds;
    for (int task = bid; task < 768; task += G) {
        const int l = task / 384, rem = task % 384, kc = rem / 12, cb = rem % 12;
        if (tid < 96) { const int j = tid >> 5, k = kc * 32 + (tid & 31); const float cv = (j == 0) ? p.c_ctx[k] : p.c[(j - 1) * 1024 + k]; tile[tid] = silu(cv); }
        __syncthreads();
        const int n = cb * 512 + tid;
        const float* w = p.w_ada + ((size_t)l * 1024 + kc * 32) * 6144 + n;
        float s0 = 0.f, s1 = 0.f, s2 = 0.f;
        float wv[32];
#pragma unroll
        for (int k = 0; k < 32; ++k) wv[k] = w[(size_t)k * 6144];
#pragma unroll
        for (int k = 0; k < 32; ++k) { s0 += tile[k] * wv[k]; s1 += tile[32 + k] * wv[k]; s2 += tile[64 + k] * wv[k]; }
        if (kc == 0) { const float bv = p.b_ada[l * 6144 + n]; s0 += bv; s1 += bv; s2 += bv; }
        float* m = p.mod + (size_t)l * 3 * 6144 + n;
        atomicAdd(m, s0); atomicAdd(m + 6144, s1); atomicAdd(m + 2 * 6144, s2);
        __syncthreads();
    }
    tile = (float*)(lds + (tid >> 8) * 16640);
    for (int pp = bid; pp < 2972; pp += G) {
        const int tt = pp * 2 + (tid >> 8);
        const int l = tt / 2972; int t = tt % 2972;
        const int tn = tid & 63;
        if (t < 448) { const int kt = t / 28, nt = t % 28; const float* w = p.w_in + (size_t)l * 1024 * 1568;
            tr_tile(win_src(w, nt * 64 + tn), 1568, p.wt_in + l * SZ_WIN, 1024, kt * 64, nt * 64, nullptr, tile); continue; }
        t -= 448;
        if (t < 60) { const int kt = t / 10, nt = t % 10; const float* w = p.w_q_up + (size_t)l * 384 * 576; const int nd = nt * 64 + tn;
            tr_tile(nd < 576 ? w + nd : nullptr, 576, p.wt_qup + l * SZ_QUP, 384, kt * 64, nt * 64, p.g_q_a + l * 384, tile); continue; }
        t -= 60;
        if (t < 96) { const int var = t / 48; t %= 48; const int kt = t / 12, nt = t % 12; const float* w = p.w_kv_up + (size_t)l * 256 * 768;
            tr_tile(w + nt * 64 + tn, 768, (var ? p.wt_kvp : p.wt_kvg) + l * SZ_KV, 256, kt * 64, nt * 64, var ? nullptr : p.g_kv_a + l * 256, tile); continue; }
        t -= 96;
        if (t < 256) { const int kt = t / 16, nt = t % 16; const float* w = p.w_out + (size_t)l * 1024 * 1024;
            tr_tile(w + nt * 64 + tn, 1024, p.wt_out + l * SZ_WOUT, 1024, kt * 64, nt * 64, nullptr, tile); continue; }
        t -= 256;
        if (t < 1408) { const int kt = t / 88, nt = t % 88; const float* w = (tn < 32 ? p.w_gate : p.w_up) + (size_t)l * 1024 * 2816 + nt * 32 + (tn & 31);
            tr_tile(w, 2816, p.wt_gu + l * SZ_GU, 1024, kt * 64, nt * 64, nullptr, tile); continue; }
        t -= 1408;
        { const int kt = t / 16, nt = t % 16; const float* w = p.w_down + (size_t)l * 2816 * 1024;
            tr_tile(w + nt * 64 + tn, 1024, p.wt_down + l * SZ_DOWN, 2816, kt * 64, nt * 64, nullptr, tile); }
    }
    const int gt = bid * 512 + tid, GT = G * 512;
    for (int i = gt; i < 2048 * 512; i += GT) {
        const int pp = i >> 9, k8 = (i & 511) * 8; u32x4 o; unsigned w[4];
#pragma unroll
        for (int e = 0; e < 4; ++e) { float v[2];
#pragma unroll
            for (int z = 0; z < 2; ++z) { const int kq = k8 + 2 * e + z; const int m = (pp * (kq & 2047)) & 2047; const float a = (float)m * (1.f / 1024.f);
                v[z] = (kq < 2048 ? cospif(a) : -sinpif(a)) * 0.022097086912079608f; }
            w[e] = pk_bf16(v[0], v[1]); }
        o.x = w[0]; o.y = w[1]; o.z = w[2]; o.w = w[3];
        *(u32x4*)(p.tab2048 + (size_t)pp * 4096 + k8) = o;
    }
    for (int i = gt; i < 256 * 512; i += GT) { const int pp = i >> 9, kq = i & 511; const int m = (pp * (kq & 255)) & 255; const float a = (float)m * (1.f / 128.f);
        p.tab256[i] = to_bf16((kq < 256 ? cospif(a) : -sinpif(a)) * 0.0625f); }
    for (int i = gt; i < 128 * 64; i += GT) { const int n = i >> 6, k = i & 63; const int m = ((n & 63) * k) & 63; const float a = (float)m * (1.f / 32.f);
        p.bt_ch[i] = to_bf16((n < 64 ? cospif(a) : sinpif(a)) * 0.125f); }
    for (int i = gt; i < 2048 * 32; i += GT) { const int t = i >> 5, pr = i & 31; const float inv = powf(10000.f, -(float)(pr & 15) * (1.f / 16.f));
        const float pos = (float)(pr < 16 ? (t >> 6) : (t & 63)); const float ang = pos * inv; f32x2 cs = {cosf(ang), sinf(ang)}; p.rope_g[i] = cs; }
    for (int i = gt; i < 2048 * 16; i += GT) { const int t = i >> 4, pr = i & 15; const float inv = powf(10000.f, -(float)(pr & 7) * (1.f / 8.f));
        const float pos = (float)(pr < 8 ? (t >> 6) : (t & 63)); const float ang = pos * inv; f32x2 cs = {cosf(ang), sinf(ang)}; p.rope_m[i] = cs; }
    for (int i = gt; i < 2 * 2 * 256 * 256; i += GT) p.ckv_cache[i] = to_bf16(p.c_ckv[i]);
    for (int i = gt; i < 2 * 2 * 256 * 32; i += GT) {
        const int d = i & 31, s = (i >> 5) & 255, l = (i >> 13) & 1, b = i >> 14; const bf16_t v = to_bf16(p.c_krope[i]);
        bf16_t* dst = p.kmla_den + ((size_t)((l * 2 + b) * 2304 + s) * 6) * 96 + 64 + d;
#pragma unroll
        for (int hh = 0; hh < 6; ++hh) dst[hh * 96] = v;
    }
    for (int i = gt; i < 2 * 2 * 256 * 128; i += GT) {
        const int d = i & 63, hk = (i >> 6) & 1, s = (i >> 7) & 255, l = (i >> 15) & 1, b = i >> 16;
        p.kgqa_den[((size_t)((l * 2 + b) * 2304 + s) * 2 + hk) * 64 + d] = to_bf16(p.c_gk[i]);
        p.vtgqa_den[((size_t)((l * 2 + b) * 2 + hk) * 64 + d) * 2304 + s] = to_bf16(p.c_gv[i]);
    }
}

DI void phase_norm(KPR p, const float* xc, const float* xd, const float* g, const float* modl, int shift_off, int scale_off) {
    const int lane = ltid() & 63, gw = lbid() * 8 + (ltid() >> 6), nw = gridDim.x * 8;
    for (int T0 = gw; T0 < NTOK; T0 += 4 * nw) {
        f32x4 v[4][4];
#pragma unroll
        for (int rr = 0; rr < 4; ++rr) {
            const int T = T0 + rr * nw;
            if (T < NTOK) {
                const float* xr = T < NCTX ? xc + (size_t)T * D : xd + (size_t)(T - NCTX) * D;
#pragma unroll
                for (int i = 0; i < 4; ++i) v[rr][i] = *(const f32x4*)(xr + lane * 4 + i * 256);
            }
        }
#pragma unroll
        for (int rr = 0; rr < 4; ++rr) {
            const int T = T0 + rr * nw;
            if (T < NTOK) {
                const float* mj = modl + (T < NCTX ? 0 : 1 + ((T - NCTX) >> 11)) * 6144;
                float ss = 0.f;
#pragma unroll
                for (int i = 0; i < 4; ++i) ss += v[rr][i].x * v[rr][i].x + v[rr][i].y * v[rr][i].y + v[rr][i].z * v[rr][i].z + v[rr][i].w * v[rr][i].w;
#pragma unroll
                for (int o = 32; o >= 1; o >>= 1) ss += __shfl_xor(ss, o);
                const float rs = rsqrtf(ss * (1.f / 1024.f) + EPS);
#pragma unroll
                for (int i = 0; i < 4; ++i) {
                    const int c = lane * 4 + i * 256;
                    const f32x4 gg = *(const f32x4*)(g + c), sc = *(const f32x4*)(mj + scale_off + c), sh = *(const f32x4*)(mj + shift_off + c);
                    const f32x4 x = v[rr][i];
                    u32x2 w; w.x = pk_bf16(x.x * rs * gg.x * (1.f + sc.x) + sh.x, x.y * rs * gg.y * (1.f + sc.y) + sh.y);
                    w.y = pk_bf16(x.z * rs * gg.z * (1.f + sc.z) + sh.z, x.w * rs * gg.w * (1.f + sc.w) + sh.w);
                    *(u32x2*)(p.h + (size_t)T * D + c) = w;
                }
            }
        }
    }
}
DI void phase_final(KPR p, const float* x) {
    const int lane = ltid() & 63, gw = lbid() * 8 + (ltid() >> 6), nw = gridDim.x * 8;
    for (int T0 = gw; T0 < NTOK; T0 += 4 * nw) {
        f32x4 v[4][4];
#pragma unroll
        for (int rr = 0; rr < 4; ++rr) {
            const int T = T0 + rr * nw;
            if (T < NTOK) {
#pragma unroll
                for (int i = 0; i < 4; ++i) v[rr][i] = *(const f32x4*)(x + (size_t)T * D + lane * 4 + i * 256);
            }
        }
#pragma unroll
        for (int rr = 0; rr < 4; ++rr) {
            const int T = T0 + rr * nw;
            if (T < NTOK) {
                float ss = 0.f;
#pragma unroll
                for (int i = 0; i < 4; ++i) ss += v[rr][i].x * v[rr][i].x + v[rr][i].y * v[rr][i].y + v[rr][i].z * v[rr][i].z + v[rr][i].w * v[rr][i].w;
#pragma unroll
                for (int o = 32; o >= 1; o >>= 1) ss += __shfl_xor(ss, o);
                const float rs = rsqrtf(ss * (1.f / 1024.f) + EPS);
#pragma unroll
                for (int i = 0; i < 4; ++i) { const int c = lane * 4 + i * 256; const f32x4 gg = *(const f32x4*)(p.g_final + c); const f32x4 xx = v[rr][i];
                    f32x4 o = {xx.x * rs * gg.x, xx.y * rs * gg.y, xx.z * rs * gg.z, xx.w * rs * gg.w}; *(f32x4*)(p.out + (size_t)T * D + c) = o; }
            }
        }
    }
}

DI void rope_pair(float& x1, float& x2, const f32x2 cs) { const float a = x1 * cs.x - x2 * cs.y, b = x2 * cs.x + x1 * cs.y; x1 = a; x2 = b; }
template <int WM>
DI void epi_win(KPR p, int l, f32x16 (&acc)[WM][2], int tok0, int cb, int r, int h) {
#pragma unroll
    for (int i = 0; i < WM; ++i) {
        __builtin_amdgcn_sched_barrier(0);
        const int T = tok0 + i * 32 + r; const bool den = T >= NCTX;
        int b, s; if (!den) { b = T >> 8; s = T & 255; } else { b = (T - NCTX) >> 11; s = (T - NCTX) & 2047; }
        if (cb < 640) {
            float ss = sumsq16(acc[i][0]) + sumsq16(acc[i][1]); ss += __shfl_xor(ss, 32);
            if (cb < 384) {
                bf16_t* dst = p.cq + (size_t)T * 384 + cb; st_bf16_tile(dst, acc[i][0], h); st_bf16_tile(dst + 32, acc[i][1], h);
                if (h == 0) p.ssq_q[T * 6 + (cb >> 6)] = ss;
            } else {
                const int c0 = cb - 384; bf16_t* dst = p.ckv + (size_t)T * 256 + c0; st_bf16_tile(dst, acc[i][0], h); st_bf16_tile(dst + 32, acc[i][1], h);
                if (h == 0) p.ssq_kv[T * 4 + (c0 >> 6)] = ss;
                if (!den) { float* o = p.out + OFF_CKV + ((size_t)((b * 2 + l) * 256 + s)) * 256 + c0; st_f32_tile(o, acc[i][0], h); st_f32_tile(o + 32, acc[i][1], h); }
            }
        } else if (cb < 1152) {
            float ss = sumsq16(acc[i][0]) + sumsq16(acc[i][1]); ss += __shfl_xor(ss, 32);
            const float rs = rsqrtf(ss * (1.f / 64.f) + EPS);
            const bool isq = cb < 1024;
            const float* g = (isq ? p.g_q_head : p.g_k_head) + l * 64;
            const int hk = (cb - 1024) >> 6;
            float* o32 = p.out + OFF_GK + ((size_t)(((b * 2 + l) * 256 + s) * 2 + hk)) * 64;
            bf16_t* dst = isq ? p.gq + (size_t)T * 384 + (cb - 640)
                              : (den ? p.kgqa_den + ((size_t)((l * 2 + b) * 2304 + 256 + s) * 2 + hk) * 64 : p.kgqa_ctx + ((size_t)(b * 256 + s) * 2 + hk) * 64);
            const float qs = isq ? 0.125f * LOG2E : 1.f;
#pragma unroll
            for (int q = 0; q < 4; ++q) {
                const int d0 = 8 * q + 4 * h;
                const f32x4 g0 = *(const f32x4*)(g + d0), g1 = *(const f32x4*)(g + 32 + d0);
                float x1[4], x2[4];
#pragma unroll
                for (int z = 0; z < 4; ++z) { x1[z] = acc[i][0][4 * q + z] * rs * g0[z]; x2[z] = acc[i][1][4 * q + z] * rs * g1[z]; }
                if (!isq && !den) { f32x4 w0 = {x1[0], x1[1], x1[2], x1[3]}, w1 = {x2[0], x2[1], x2[2], x2[3]}; *(f32x4*)(o32 + d0) = w0; *(f32x4*)(o32 + 32 + d0) = w1; }
                if (den) {
                    const f32x4 ca = *(const f32x4*)(p.rope_g + s * 32 + d0), cb2 = *(const f32x4*)(p.rope_g + s * 32 + d0 + 2);
                    { f32x2 cs = {ca[0], ca[1]}; rope_pair(x1[0], x2[0], cs); } { f32x2 cs = {ca[2], ca[3]}; rope_pair(x1[1], x2[1], cs); }
                    { f32x2 cs = {cb2[0], cb2[1]}; rope_pair(x1[2], x2[2], cs); } { f32x2 cs = {cb2[2], cb2[3]}; rope_pair(x1[3], x2[3], cs); }
                }
                u32x2 w0, w1; w0.x = pk_bf16(x1[0] * qs, x1[1] * qs); w0.y = pk_bf16(x1[2] * qs, x1[3] * qs); w1.x = pk_bf16(x2[0] * qs, x2[1] * qs); w1.y = pk_bf16(x2[2] * qs, x2[3] * qs);
                *(u32x2*)(dst + d0) = w0; *(u32x2*)(dst + 32 + d0) = w1;
                __builtin_amdgcn_sched_barrier(0);
            }
        } else if (cb < 1280) {
            const int hk = (cb - 1152) >> 6;
            if (!den) {
                float* o = p.out + OFF_GV + ((size_t)(((b * 2 + l) * 256 + s) * 2 + hk)) * 64; st_f32_tile(o, acc[i][0], h); st_f32_tile(o + 32, acc[i][1], h);
                bf16_t* dst = p.vtgqa_ctx + ((size_t)(b * 2 + hk) * 64) * 256 + s; st_bf16_tile_T(dst, 256, acc[i][0], h); st_bf16_tile_T(dst + 32 * 256, 256, acc[i][1], h);
            } else {
                bf16_t* dst = p.vtgqa_den + ((size_t)((l * 2 + b) * 2 + hk) * 64) * 2304 + 256 + s; st_bf16_tile_T(dst, 2304, acc[i][0], h); st_bf16_tile_T(dst + 32 * 2304, 2304, acc[i][1], h);
            }
        } else if (cb < 1536) {
            bf16_t* dst = p.u + (size_t)T * 256 + (cb - 1280); st_bf16_tile(dst, acc[i][0], h); st_bf16_tile(dst + 32, acc[i][1], h);
        } else if (cb == 1536) {
            f32x16 v = acc[i][0];
            if (!den) {
                float* o = p.out + OFF_KROPE + ((size_t)((b * 2 + l) * 256 + s)) * 32; st_f32_tile(o, v, h);
                bf16_t* dst = p.kmla_ctx + ((size_t)(b * 256 + s) * 6) * 96 + 64;
#pragma unroll
                for (int hh = 0; hh < 6; ++hh) st_bf16_tile(dst + hh * 96, v, h);
            } else {
#pragma unroll
                for (int e = 0; e < 8; ++e) { const f32x2 cs = p.rope_m[s * 16 + crow(e, h)]; float x1 = v[e], x2 = v[e + 8]; rope_pair(x1, x2, cs); v[e] = x1; v[e + 8] = x2; }
                bf16_t* dst = p.kmla_den + ((size_t)((l * 2 + b) * 2304 + 256 + s) * 6) * 96 + 64;
#pragma unroll
                for (int hh = 0; hh < 6; ++hh) st_bf16_tile(dst + hh * 96, v, h);
            }
        }
    }
}

#ifndef TILEMAP
#define TILEMAP 0
#endif
#if TILEMAP == 0
#define FOR_TILES_32M(NT, mvar, nvar)                                                             \
    for (int _lid = (lbid() >> 3), mvar = 4 * (lbid() & 7) + (_lid & 3), nvar = _lid >> 2; _lid < 4 * (NT);     \
         _lid += (int)(gridDim.x >> 3), mvar = 4 * (lbid() & 7) + (_lid & 3), nvar = _lid >> 2)
#else
#define FOR_TILES_32M(NT, mvar, nvar)                                                             \
    for (int _lid = (lbid() & 31), mvar = 4 * (lbid() >> 5) + (_lid & 3), nvar = _lid >> 2; _lid < 4 * (NT);     \
         _lid += 32, mvar = 4 * (lbid() >> 5) + (_lid & 3), nvar = _lid >> 2)
#endif

DI void phase_win(KPR p, int l, char* lds) {
    const int tid = ltid(), lane = tid & 63, wid = tid >> 6, wr = wid >> 2, wc = wid & 3, r = lane & 31, h = lane >> 5;
    FOR_TILES_32M(7, m, n) {
        f32x16 acc[4][2];
        gemm_tile<4>(p.h + (size_t)m * 256 * D, D, p.wt_in + l * SZ_WIN + (size_t)n * 256 * D, D, D, lds, acc);
        epi_win<4>(p, l, acc, m * 256 + wr * 128, n * 256 + wc * 64, r, h);
    }
}

DI void phase_mid(KPR p, int l, char* lds, bool rep = false) {
    const int tid = ltid(), lane = tid & 63, wid = tid >> 6, wr = wid >> 1, wc = wid & 1, r = lane & 31, h = lane >> 5;
    for (int t = lbid(); t < 492; t += gridDim.x) {
        f32x16 acc[2][2];
        if (t < 160) {
            const int m = t / 5, n = t % 5;
            gemm_tile3<2>(p.cq + (size_t)m * 256 * 384, 384, p.wt_qup + l * SZ_QUP + (size_t)n * 128 * 384, 384, 384, lds, acc);
            const int cb = n * 128 + wc * 64;
#pragma unroll
            for (int i = 0; i < 2; ++i) {
                const int T = m * 256 + wr * 64 + i * 32 + r; const bool den = T >= NCTX; const int s = (T - NCTX) & 2047;
                float ss = 0.f;
#pragma unroll
                for (int k = 0; k < 6; ++k) ss += p.ssq_q[T * 6 + k];
                const float rs = rsqrtf(ss * (1.f / 384.f) + EPS) * (0.10206207261596575f * LOG2E);
#pragma unroll
                for (int j = 0; j < 2; ++j) {
                    const int ct = (cb >> 5) + j; if (ct >= 18) continue;
                    f32x16 v;
#pragma unroll
                    for (int e = 0; e < 16; ++e) v[e] = acc[i][j][e] * rs;
                    if ((ct % 3) == 2 && den) {
#pragma unroll
                        for (int e = 0; e < 8; ++e) { const f32x2 cs = p.rope_m[s * 16 + crow(e, h)]; float x1 = v[e], x2 = v[e + 8]; rope_pair(x1, x2, cs); v[e] = x1; v[e + 8] = x2; }
                    }
                    st_bf16_tile(p.qmla + (size_t)T * 576 + ct * 32, v, h);
                }
            }
        } else if (t < 364) {
            const int tt = t - 160, mt = tt / 6, hd = tt % 6;
            const bf16_t* A; const bf16_t* W; int kind, b = 0, s0 = 0, T0 = 0;
            if (mt < 32) { T0 = mt * 256; A = p.ckv + (size_t)T0 * 256; W = p.wt_kvg; kind = mt < 16 ? 0 : 1; if (kind == 0) { b = T0 >> 8; s0 = 0; } else { b = (T0 - NCTX) >> 11; s0 = 256 + ((T0 - NCTX) & 2047); } }
            else { b = mt - 32; s0 = 0; A = p.ckv_cache + ((size_t)(b * 2 + l) * 256) * 256; W = p.wt_kvp; kind = 2; }
            gemm_tile3<2>(A, 256, W + l * SZ_KV + (size_t)hd * 128 * 256, 256, 256, lds, acc);
#pragma unroll
            for (int i = 0; i < 2; ++i) {
                const int ro = wr * 64 + i * 32 + r; float rs = 1.f;
                if (kind < 2) { const int T = T0 + ro; const float ss = p.ssq_kv[T * 4] + p.ssq_kv[T * 4 + 1] + p.ssq_kv[T * 4 + 2] + p.ssq_kv[T * 4 + 3]; rs = rsqrtf(ss * (1.f / 256.f) + EPS); }
                const int key = s0 + ro;
                f32x16 v0, v1;
#pragma unroll
                for (int e = 0; e < 16; ++e) { v0[e] = acc[i][0][e] * rs; v1[e] = acc[i][1][e] * rs; }
                if (wc == 0) {
                    bf16_t* dst = kind == 0 ? p.kmla_ctx + ((size_t)(b * 256 + key) * 6 + hd) * 96 : p.kmla_den + ((size_t)((l * 2 + b) * 2304 + key) * 6 + hd) * 96;
                    st_bf16_tile(dst, v0, h); st_bf16_tile(dst + 32, v1, h);
                } else {
                    if (kind == 0) { bf16_t* dst = p.vtmla_ctx + ((size_t)(b * 6 + hd) * 64) * 256 + key; st_bf16_tile_T(dst, 256, v0, h); st_bf16_tile_T(dst + 32 * 256, 256, v1, h); }
                    else { bf16_t* dst = p.vtmla_den + ((size_t)((l * 2 + b) * 6 + hd) * 64) * 2304 + key; st_bf16_tile_T(dst, 2304, v0, h); st_bf16_tile_T(dst + 32 * 2304, 2304, v1, h); }
                }
            }
        } else {
            const int tt = t - 364, m = tt >> 2, g = tt & 3;
            gemm_tile3<2>(p.u + (size_t)m * 256 * 256 + g * 64, 256, p.bt_ch, 64, 64, lds, acc);
#pragma unroll
            for (int i = 0; i < 2; ++i) {
                const int T = m * 256 + wr * 64 + i * 32 + r; const bool den = T >= NCTX;
#pragma unroll
                for (int j = 0; j < 2; ++j) {
                    const int c = g * 64 + j * 32;
                    if (!den) { const int b = T >> 8, s = T & 255; st_bf16_tile_T(p.zt_ctx + ((size_t)(b * 256 + c)) * 512 + wc * 256 + s, 512, acc[i][j], h); }
                    else { const int b = (T - NCTX) >> 11, s = (T - NCTX) & 2047; st_bf16_tile_T(p.zt_den + ((size_t)(b * 256 + c)) * 4096 + wc * 2048 + s, 4096, acc[i][j], h); }
                }
            }
        }
    }
    if (!rep)
    for (int i = lbid() * 512 + tid; i < NCTX * 64; i += gridDim.x * 512) {
        const int T = i >> 6, c = (i & 63) * 4, b = T >> 8, s = T & 255;
        const float ss = p.ssq_kv[T * 4] + p.ssq_kv[T * 4 + 1] + p.ssq_kv[T * 4 + 2] + p.ssq_kv[T * 4 + 3]; const float rs = rsqrtf(ss * (1.f / 256.f) + EPS);
        float* o = p.out + OFF_CKV + ((size_t)((b * 2 + l) * 256 + s)) * 256 + c; f32x4 v = *(f32x4*)o; const f32x4 g = *(const f32x4*)(p.g_kv_a + l * 256 + c);
        v.x *= rs * g.x; v.y *= rs * g.y; v.z *= rs * g.z; v.w *= rs * g.w; *(f32x4*)o = v;
    }
}

template <int DQK>
DI void attn_item(const bf16_t* __restrict__ Q, int ldq, const bf16_t* __restrict__ Kp, int ldk, const bf16_t* __restrict__ Vt, int ldv, int Sk, bf16_t* O, int ldo, char* lds) {
    constexpr int KSTR = DQK * 2 + 16, VSTR = 136, KBYTES = 64 * KSTR, STAGE = KBYTES + 64 * VSTR, KCH = DQK / 8;
    int tid = ltid();
    const int lane = tid & 63, w = tid >> 6, r = lane & 31, h = lane >> 5;
    bf16x8 qf[DQK / 16];
#pragma unroll
    for (int ks = 0; ks < DQK / 16; ++ks) qf[ks] = *(const bf16x8*)(Q + (size_t)(w * 32 + r) * ldq + ks * 16 + h * 8);
    f32x16 oacc[2];
#pragma unroll
    for (int e = 0; e < 16; ++e) { oacc[0][e] = 0.f; oacc[1][e] = 0.f; }
    float mrun = -INFINITY, lrun = 0.f;
    u32x4 rk[2], rv;
    const bool k2 = (DQK == 96) && tid < 256;
    const int kr0 = tid / KCH, kc0 = tid % KCH, kr1 = (tid + 512) / KCH, kc1 = (tid + 512) % KCH;
    const int vrow = tid >> 3, vch = tid & 7;
    auto gload = [&](int kt) {
        rk[0] = *(const u32x4*)(Kp + (size_t)(kt * 64 + kr0) * ldk + kc0 * 8);
        if (k2) rk[1] = *(const u32x4*)(Kp + (size_t)(kt * 64 + kr1) * ldk + kc1 * 8);
        rv = *(const u32x4*)(Vt + (size_t)vrow * ldv + kt * 64 + vch * 8);
    };
    auto lstore = [&](int buf) {
        char* base = lds + buf * STAGE;
        *(u32x4*)(base + kr0 * KSTR + kc0 * 16) = rk[0];
        if (k2) *(u32x4*)(base + kr1 * KSTR + kc1 * 16) = rk[1];
        char* d = base + KBYTES + vrow * VSTR + vch * 16; u32x2 lo = {rv.x, rv.y}, hi = {rv.z, rv.w}; *(u32x2*)d = lo; *(u32x2*)(d + 8) = hi;
    };
    gload(0); lstore(0); __syncthreads();
    const int nkt = Sk >> 6;
    for (int kt = 0; kt < nkt; ++kt) {
        const char* kb = lds + (kt & 1) * STAGE; const char* vb = kb + KBYTES;
        if (kt + 1 < nkt) gload(kt + 1);
        f32x16 sacc[2];
        {
            bf16x8 kf[2][DQK / 16];
#pragma unroll
            for (int sub = 0; sub < 2; ++sub)
#pragma unroll
                for (int ks = 0; ks < DQK / 16; ++ks) kf[sub][ks] = *(const bf16x8*)(kb + (sub * 32 + r) * KSTR + (ks * 2 + h) * 16);
#pragma unroll
            for (int sub = 0; sub < 2; ++sub) {
#pragma unroll
                for (int e = 0; e < 16; ++e) sacc[sub][e] = 0.f;
#pragma unroll
                for (int ks = 0; ks < DQK / 16; ++ks) sacc[sub] = MFMA(kf[sub][ks], qf[ks], sacc[sub]);
            }
        }
        __builtin_amdgcn_sched_barrier(0);
        s16x4 vlo[2][4], vhi[2][4];
#pragma unroll
        for (int g = 0; g < 4; ++g)
#pragma unroll
            for (int dvt = 0; dvt < 2; ++dvt) {
                const char* va = vb + (dvt * 32 + r) * VSTR + (g * 16 + 4 * h) * 2;
                vlo[dvt][g] = *(const s16x4*)va; vhi[dvt][g] = *(const s16x4*)(va + 16);
            }
        float mx = sacc[0][0];
#pragma unroll
        for (int e = 1; e < 16; ++e) mx = fmaxf(mx, sacc[0][e]);
#pragma unroll
        for (int e = 0; e < 16; ++e) mx = fmaxf(mx, sacc[1][e]);
        mx = fmaxf(mx, __shfl_xor(mx, 32));
        const float mnew = fmaxf(mrun, mx);
        const float alpha = __builtin_amdgcn_exp2f(mrun - mnew);
        mrun = mnew;
        float psum = 0.f;
#pragma unroll
        for (int sub = 0; sub < 2; ++sub)
#pragma unroll
            for (int e = 0; e < 16; ++e) { const float pv = __builtin_amdgcn_exp2f(sacc[sub][e] - mnew); sacc[sub][e] = pv; psum += pv; }
        lrun = lrun * alpha + psum;
#pragma unroll
        for (int e = 0; e < 16; ++e) { oacc[0][e] *= alpha; oacc[1][e] *= alpha; }
#pragma unroll
        for (int sub = 0; sub < 2; ++sub)
#pragma unroll
            for (int s2 = 0; s2 < 2; ++s2) {
                u32x4 pw; pw.x = pk_bf16(sacc[sub][8 * s2 + 0], sacc[sub][8 * s2 + 1]); pw.y = pk_bf16(sacc[sub][8 * s2 + 2], sacc[sub][8 * s2 + 3]);
                pw.z = pk_bf16(sacc[sub][8 * s2 + 4], sacc[sub][8 * s2 + 5]); pw.w = pk_bf16(sacc[sub][8 * s2 + 6], sacc[sub][8 * s2 + 7]);
                const bf16x8 pf = __builtin_bit_cast(bf16x8, pw);
#pragma unroll
                for (int dvt = 0; dvt < 2; ++dvt) {
                    const bf16x8 vf = __builtin_shufflevector(vlo[dvt][sub * 2 + s2], vhi[dvt][sub * 2 + s2], 0, 1, 2, 3, 4, 5, 6, 7);
                    oacc[dvt] = MFMA(vf, pf, oacc[dvt]);
                }
            }
        __builtin_amdgcn_sched_barrier(0);
        if (kt + 1 < nkt) lstore((kt + 1) & 1);
        __syncthreads();
    }
    lrun += __shfl_xor(lrun, 32);
    const float inv = 1.f / lrun;
#pragma unroll
    for (int dvt = 0; dvt < 2; ++dvt) {
        f32x16 v;
#pragma unroll
        for (int e = 0; e < 16; ++e) v[e] = oacc[dvt][e] * inv;
        st_bf16_tile(O + (size_t)(w * 32 + r) * ldo + dvt * 32, v, h);
    }
}

DI void phase_mix(KPR p, int l, char* lds, unsigned* ctr) {
    const int tid = ltid(), lane = tid & 63, wid = tid >> 6, wr = wid >> 1, wc = wid & 1, r = lane & 31, h = lane >> 5;
    __shared__ unsigned sitem_s; volatile unsigned* sitem = &sitem_s;
    for (;;) {
        __syncthreads();
        if (tid == 0) *sitem = atomicAdd(ctr, 1u);
        __syncthreads();
        const int it = (int)*sitem;
        if (it >= 480) break;
        if (it < 64) {
            f32x16 acc[1][2];
            const int b = it >> 5, m = (it >> 2) & 7, n = it & 3;
            gemm_tile3<1>(p.tab2048 + (size_t)m * 256 * 4096, 4096, p.zt_den + ((size_t)(b * 256 + n * 64)) * 4096, 4096, 4096, lds, acc);
            const int T = NCTX + b * 2048 + m * 256 + wid * 32 + r;
            bf16_t* dst = p.mix + (size_t)T * D + 384 + n * 64;
            st_bf16_tile(dst, acc[0][0], h); st_bf16_tile(dst + 32, acc[0][1], h);
        } else if (it >= 256 && it < 288) {
            f32x16 acc[2][2];
            const int q = it - 256, b = q >> 1, n = q & 1;
            gemm_tile3<2>(p.tab256, 512, p.zt_ctx + ((size_t)(b * 256 + n * 128)) * 512, 512, 512, lds, acc);
#pragma unroll
            for (int i = 0; i < 2; ++i) {
                const int T = b * 256 + wr * 64 + i * 32 + r;
                bf16_t* dst = p.mix + (size_t)T * D + 384 + n * 128 + wc * 64;
                st_bf16_tile(dst, acc[i][0], h); st_bf16_tile(dst + 32, acc[i][1], h);
            }
        } else {
            int b, hd, qb, den;
            if (it < 256) { const int q = it - 64; den = 1; qb = q & 7; hd = (q >> 3) % 12; b = q / 96; } else { const int q = it - 288; den = 0; qb = 0; hd = q % 12; b = q / 12; }
            const int T0 = den ? NCTX + b * 2048 + qb * 256 : b * 256;
            const int Sk = den ? 2304 : 256;
            if (hd < 6) {
                const bf16_t* K = den ? p.kmla_den + ((size_t)(l * 2 + b) * 2304 * 6 + hd) * 96 : p.kmla_ctx + ((size_t)b * 256 * 6 + hd) * 96;
                const bf16_t* V = den ? p.vtmla_den + ((size_t)((l * 2 + b) * 6 + hd) * 64) * 2304 : p.vtmla_ctx + ((size_t)(b * 6 + hd) * 64) * 256;
                attn_item<96>(p.qmla + (size_t)T0 * 576 + hd * 96, 576, K, 576, V, Sk, Sk, p.mix + (size_t)T0 * D + hd * 64, D, lds);
            } else {
                const int hq = hd - 6, hk = hq / 3;
                const bf16_t* K = den ? p.kgqa_den + ((size_t)(l * 2 + b) * 2304 * 2 + hk) * 64 : p.kgqa_ctx + ((size_t)b * 256 * 2 + hk) * 64;
                const bf16_t* V = den ? p.vtgqa_den + ((size_t)((l * 2 + b) * 2 + hk) * 64) * 2304 : p.vtgqa_ctx + ((size_t)(b * 2 + hk) * 64) * 256;
                attn_item<64>(p.gq + (size_t)T0 * 384 + hq * 64, 384, K, 128, V, Sk, Sk, p.mix + (size_t)T0 * D + 640 + hq * 64, D, lds);
            }
        }
    }
}

DI void phase_resid(KPR p, const bf16_t* A, int K, const bf16_t* W, const float* xc, const float* xd, float* xout, const float* gate, char* lds) {
    const int tid = ltid(), lane = tid & 63, wid = tid >> 6, wr = wid >> 1, wc = wid & 1, r = lane & 31, h = lane >> 5;
    FOR_TILES_32M(8, m, n) {
        f32x16 acc[2][2];
        f32x4 xpre[2][2][4];
#pragma unroll
        for (int i = 0; i < 2; ++i) {
            const int T = m * 256 + wr * 64 + i * 32 + r;
            const float* xr = T < NCTX ? xc + (size_t)T * D : xd + (size_t)(T - NCTX) * D;
#pragma unroll
            for (int j = 0; j < 2; ++j)
#pragma unroll
                for (int q = 0; q < 4; ++q) xpre[i][j][q] = *(const f32x4*)(xr + n * 128 + wc * 64 + j * 32 + 8 * q + 4 * h);
        }
        gemm_tile3<2>(A + (size_t)m * 256 * K, K, W + (size_t)n * 128 * K, K, K, lds, acc);
#pragma unroll
        for (int i = 0; i < 2; ++i) {
            const int T = m * 256 + wr * 64 + i * 32 + r;
            const float* gj = gate + (T < NCTX ? 0 : 1 + ((T - NCTX) >> 11)) * 6144;
#pragma unroll
            for (int j = 0; j < 2; ++j)
#pragma unroll
                for (int q = 0; q < 4; ++q) {
                    const int c = n * 128 + wc * 64 + j * 32 + 8 * q + 4 * h;
                    const f32x4 xv = xpre[i][j][q], gv = *(const f32x4*)(gj + c);
                    f32x4 o = {xv.x + gv.x * acc[i][j][4 * q], xv.y + gv.y * acc[i][j][4 * q + 1], xv.z + gv.z * acc[i][j][4 * q + 2], xv.w + gv.w * acc[i][j][4 * q + 3]};
                    *(f32x4*)(xout + (size_t)T * D + c) = o;
                }
        }
    }
}
DI void phase_gu(KPR p, int l, char* lds) {
    const int tid = ltid(), lane = tid & 63, wid = tid >> 6, wr = wid >> 2, wc = wid & 3, r = lane & 31, h = lane >> 5;
    FOR_TILES_32M(22, m, n) {
        f32x16 acc[4][2];
        gemm_tile<4>(p.h + (size_t)m * 256 * D, D, p.wt_gu + l * SZ_GU + (size_t)n * 256 * D, D, D, lds, acc);
#pragma unroll
        for (int i = 0; i < 4; ++i) {
            const int T = m * 256 + wr * 128 + i * 32 + r;
            f32x16 v;
#pragma unroll
            for (int e = 0; e < 16; ++e) v[e] = silu(acc[i][0][e]) * acc[i][1][e];
            st_bf16_tile(p.hid + (size_t)T * DFF + (n * 4 + wc) * 32, v, h);
        }
    }
}

constexpr int NPHASE = 18;
template <int PM>
__global__ void __launch_bounds__(512, 2) fwd_megakernel(P p_arg) {
    KP kp0 = (KP)__builtin_amdgcn_kernarg_segment_ptr();
    KPR p = *kp0;
    __shared__ __attribute__((aligned(16))) char lds[147456];
    __shared__ uint4 xbw;
    if (p.never) cg::this_grid().sync();
    if (threadIdx.x == 0) xbw = make_uint4(0u, 0u, 0u, 0u);
    __syncthreads();
    XcdBarrier xb;
    if (!MULTI_LAUNCH) xb = xcd_barrier_post(p.bar, (volatile LAS unsigned*)&xbw);
    const int ph0 = p.ph0, ph1 = p.ph1;
    for (int ph = ph0; ph < ph1; ++ph) {
        KP kp = kp0; asm volatile("" : "+s"(kp));
        KPR p = *kp;
        if (ph == 0) { if (PM & 1) phase_prologue(p, lds); }
        else if (ph == 17) { if (PM & 2) phase_final(p, p.xa); }
        else {
            const int l = (ph - 1) >> 3, s = (ph - 1) & 7;
            const float* modl = p.mod + (size_t)l * 3 * 6144;
            const float* xc = l == 0 ? p.x_prompt : p.xa;
            const float* xd = l == 0 ? p.x_sample : p.xa + (size_t)NCTX * D;
            switch (s) {
                case 0: if (PM & 4) phase_norm(p, xc, xd, p.g_norm1 + l * D, modl, 0, 1024); break;
                case 1: if (PM & 8) phase_win(p, l, lds); break;
                case 2: if (PM & 16) phase_mid(p, l, lds); break;
                case 3: if (PM & 32) phase_mix(p, l, lds, p.ctr + 64 * l); break;
                case 4: if (PM & 64) phase_resid(p, p.mix, D, p.wt_out + l * SZ_WOUT, xc, xd, p.xb, modl + 2048, lds); break;
                case 5: if (PM & 4) phase_norm(p, p.xb, p.xb + (size_t)NCTX * D, p.g_norm2 + l * D, modl, 3072, 4096); break;
                case 6: if (PM & 128) phase_gu(p, l, lds); break;
                case 7: if (PM & 64) phase_resid(p, p.hid, DFF, p.wt_down + l * SZ_DOWN, p.xb, p.xb + (size_t)NCTX * D, p.xa, modl + 5120, lds); break;
            }
        }
#ifdef DBL
        if (ph >= 1 && ph < 17) {
            const int l = (ph - 1) >> 3, s = (ph - 1) & 7;
            const float* modl = p.mod + (size_t)l * 3 * 6144;
            const float* xc = l == 0 ? p.x_prompt : p.xa;
            const float* xd = l == 0 ? p.x_sample : p.xa + (size_t)NCTX * D;
            for (int rep = 0; rep < DBLN; ++rep) {
            if (s == 0 && (DBL & 4)) phase_norm(p, xc, xd, p.g_norm1 + l * D, modl, 0, 1024);
            if (s == 1 && (DBL & 8)) phase_win(p, l, lds);
            if (s == 2 && (DBL & 16)) phase_mid(p, l, lds, true);
            if (s == 3 && (DBL & 32)) phase_mix(p, l, lds, p.ctr + 64 * l + 16 + rep);
            if (s == 4 && (DBL & 64)) phase_resid(p, p.mix, D, p.wt_out + l * SZ_WOUT, xc, xd, p.xb, modl + 2048, lds);
            if (s == 6 && (DBL & 128)) phase_gu(p, l, lds);
            if (s == 7 && (DBL & 256)) phase_resid(p, p.hid, DFF, p.wt_down + l * SZ_DOWN, p.xb, p.xb + (size_t)NCTX * D, p.xa, modl + 5120, lds);
            }
        }
#endif
        if (!MULTI_LAUNCH && ph + 1 < ph1) xcd_barrier(xb);
    }
}

extern "C" void kernel_launch(void* const* d_in, const int* in_sizes, int n_in, void* d_out, int out_size, void* d_ws, size_t ws_size, hipStream_t stream) {
    static int grid_blocks = 0;
    if (!grid_blocks) {
        int dev = 0, cus = 0, per_cu = 0;
        hipGetDevice(&dev);
        hipDeviceGetAttribute(&cus, hipDeviceAttributeMultiprocessorCount, dev);
        hipOccupancyMaxActiveBlocksPerMultiprocessor(&per_cu, fwd_megakernel<(MULTI_LAUNCH ? 32 : FUSEMASK)>, 512, 0);
        if (per_cu > 1) per_cu = 1;
        if (per_cu < 1) per_cu = 1;
        grid_blocks = cus * per_cu;
        grid_blocks &= ~7;
    }
    P p{};
    const float* const* in = (const float* const*)d_in;
    p.x_prompt = in[0]; p.x_sample = in[1]; p.c_ckv = in[2]; p.c_krope = in[3]; p.c_gk = in[4]; p.c_gv = in[5]; p.c = in[6]; p.c_ctx = in[7]; p.w_ada = in[8]; p.b_ada = in[9];
    p.g_norm1 = in[10]; p.g_norm2 = in[11]; p.w_in = in[12]; p.g_q_a = in[13]; p.w_q_up = in[14]; p.g_kv_a = in[15]; p.w_kv_up = in[16]; p.g_q_head = in[17]; p.g_k_head = in[18];
    p.w_out = in[19]; p.w_gate = in[20]; p.w_up = in[21]; p.w_down = in[22]; p.g_final = in[23];
    p.out = (float*)d_out;
    char* ws = (char*)d_ws; size_t off = 0;
    auto alloc = [&](size_t bytes) { char* r = ws + off; off += (bytes + 255) & ~(size_t)255; return r; };
    p.bar = (unsigned*)alloc(XCD_BAR_WORDS * 4); p.ctr = (unsigned*)alloc(1024); p.mod = (float*)alloc(2 * 3 * 6144 * 4);
    const size_t zero_bytes = off;
    p.wt_in = (bf16_t*)alloc(2 * SZ_WIN * 2); p.wt_qup = (bf16_t*)alloc(2 * SZ_QUP * 2); p.wt_kvg = (bf16_t*)alloc(2 * SZ_KV * 2); p.wt_kvp = (bf16_t*)alloc(2 * SZ_KV * 2);
    p.wt_out = (bf16_t*)alloc(2 * SZ_WOUT * 2); p.wt_gu = (bf16_t*)alloc(2 * SZ_GU * 2); p.wt_down = (bf16_t*)alloc(2 * SZ_DOWN * 2);
    p.tab2048 = (bf16_t*)alloc((size_t)2048 * 4096 * 2); p.tab256 = (bf16_t*)alloc(256 * 512 * 2); p.bt_ch = (bf16_t*)alloc(128 * 64 * 2);
    p.rope_g = (f32x2*)alloc(2048 * 32 * 8); p.rope_m = (f32x2*)alloc(2048 * 16 * 8);
    p.ckv_cache = (bf16_t*)alloc(2 * 2 * 256 * 256 * 2);
    p.h = (bf16_t*)alloc((size_t)NTOK * D * 2);
    p.ssq_q = (float*)alloc(NTOK * 6 * 4); p.ssq_kv = (float*)alloc(NTOK * 4 * 4);
    p.xa = (float*)alloc((size_t)NTOK * D * 4); p.xb = (float*)alloc((size_t)NTOK * D * 4);
    p.kmla_ctx = (bf16_t*)alloc((size_t)16 * 256 * 576 * 2); p.vtmla_ctx = (bf16_t*)alloc((size_t)16 * 6 * 64 * 256 * 2);
    p.kgqa_ctx = (bf16_t*)alloc((size_t)16 * 256 * 128 * 2); p.vtgqa_ctx = (bf16_t*)alloc((size_t)16 * 2 * 64 * 256 * 2);
    p.kmla_den = (bf16_t*)alloc((size_t)4 * 2304 * 576 * 2); p.vtmla_den = (bf16_t*)alloc((size_t)4 * 6 * 64 * 2304 * 2);
    p.kgqa_den = (bf16_t*)alloc((size_t)4 * 2304 * 128 * 2); p.vtgqa_den = (bf16_t*)alloc((size_t)4 * 2 * 64 * 2304 * 2);
    p.zt_ctx = (bf16_t*)alloc((size_t)16 * 256 * 512 * 2); p.zt_den = (bf16_t*)alloc((size_t)2 * 256 * 4096 * 2);
    const size_t ov = off;
    p.cq = (bf16_t*)alloc((size_t)NTOK * 384 * 2); p.ckv = (bf16_t*)alloc((size_t)NTOK * 256 * 2); p.u = (bf16_t*)alloc((size_t)NTOK * 256 * 2);
    p.gq = (bf16_t*)alloc((size_t)NTOK * 384 * 2); p.qmla = (bf16_t*)alloc((size_t)NTOK * 576 * 2); p.mix = (bf16_t*)alloc((size_t)NTOK * D * 2);
    p.hid = (bf16_t*)(ws + ov);
    if (off - ov < (size_t)NTOK * DFF * 2) off = ov + (size_t)NTOK * DFF * 2;
    if (off > ws_size) { fprintf(stderr, "workspace too small: need %zu have %zu\n", off, ws_size); return; }
    hipMemsetAsync(ws, 0, zero_bytes, stream);
#if MULTI_LAUNCH
    for (int ph = 0; ph < NPHASE; ++ph) {
        P q = p; q.ph0 = ph; q.ph1 = ph + 1;
        const int s = (ph - 1) & 7;
        if (ph == 0) hipLaunchKernelGGL(fwd_megakernel<1>, dim3(grid_blocks), dim3(512), 0, stream, q);
        else if (ph == 17) hipLaunchKernelGGL(fwd_megakernel<2>, dim3(grid_blocks), dim3(512), 0, stream, q);
        else if (s == 0 || s == 5) hipLaunchKernelGGL(fwd_megakernel<4>, dim3(grid_blocks), dim3(512), 0, stream, q);
        else if (s == 1) hipLaunchKernelGGL(fwd_megakernel<8>, dim3(grid_blocks), dim3(512), 0, stream, q);
        else if (s == 2) hipLaunchKernelGGL(fwd_megakernel<16>, dim3(grid_blocks), dim3(512), 0, stream, q);
        else if (s == 3) hipLaunchKernelGGL(fwd_megakernel<32>, dim3(grid_blocks), dim3(512), 0, stream, q);
        else if (s == 4 || s == 7) hipLaunchKernelGGL(fwd_megakernel<64>, dim3(grid_blocks), dim3(512), 0, stream, q);
        else hipLaunchKernelGGL(fwd_megakernel<128>, dim3(grid_blocks), dim3(512), 0, stream, q);
    }
#else
    p.ph0 = 0; p.ph1 = NPHASE;
    void* args[] = {&p};
    hipError_t e = hipLaunchCooperativeKernel((void*)fwd_megakernel<FUSEMASK>, dim3(grid_blocks), dim3(512), args, 0, stream);
    if (e != hipSuccess) fprintf(stderr, "cooperative launch failed: %s (grid %d)\n", hipGetErrorString(e), grid_blocks);
#endif
}
```

```cpp
#include <hip/hip_runtime.h>
#include <hip/hip_cooperative_groups.h>
#include <stdint.h>
#include <stdio.h>
namespace cg = cooperative_groups;

#ifndef FUSEMASK
#define FUSEMASK 0xffff
#endif
#ifndef MULTI_LAUNCH
#define MULTI_LAUNCH 0
#endif

typedef unsigned short bf16_t;
typedef short bf16x8 __attribute__((ext_vector_type(8)));
typedef short s16x4 __attribute__((ext_vector_type(4)));
typedef float f32x16 __attribute__((ext_vector_type(16)));
typedef float f32x4 __attribute__((ext_vector_type(4)));
typedef float f32x2 __attribute__((ext_vector_type(2)));
typedef unsigned u32x4 __attribute__((ext_vector_type(4)));
typedef unsigned u32x2 __attribute__((ext_vector_type(2)));
#define DI __device__ __forceinline__
#define LAS __attribute__((address_space(3)))

constexpr int D = 1024, NTOK = 8192, NCTX = 4096, DFF = 2816;
constexpr int NINP = 1792;
constexpr float EPS = 1e-6f;
constexpr float LOG2E = 1.4426950408889634f;
constexpr size_t OFF_YP = 0, OFF_YS = 4194304, OFF_CKV = 8388608, OFF_KROPE = 10485760, OFF_GK = 10747904, OFF_GV = 11796480;
constexpr size_t SZ_WIN = (size_t)NINP * 1024, SZ_QUP = 640 * 384, SZ_KV = 768 * 256, SZ_WOUT = 1024 * 1024, SZ_GU = (size_t)5632 * 1024, SZ_DOWN = (size_t)1024 * 2816;

struct P {
    const float *x_prompt, *x_sample, *c_ckv, *c_krope, *c_gk, *c_gv, *c, *c_ctx, *w_ada, *b_ada, *g_norm1, *g_norm2, *w_in, *g_q_a, *w_q_up, *g_kv_a,
        *w_kv_up, *g_q_head, *g_k_head, *w_out, *w_gate, *w_up, *w_down, *g_final;
    float* out;
    unsigned* bar;
    unsigned* ctr;
    float* mod;
    bf16_t *wt_in, *wt_qup, *wt_kvg, *wt_kvp, *wt_out, *wt_gu, *wt_down;
    bf16_t *tab2048, *tab256, *bt_ch;
    f32x2 *rope_g, *rope_m;
    bf16_t* ckv_cache;
    bf16_t *h, *cq, *ckv, *u, *gq, *qmla, *mix, *hid;
    float *ssq_q, *ssq_kv, *ssq_x, *bias_gu, *bias_in;
    float *xa, *xb;
    bf16_t *kmla_ctx, *vtmla_ctx, *kgqa_ctx, *vtgqa_ctx;
    bf16_t *kmla_den, *vtmla_den, *kgqa_den, *vtgqa_den;
    bf16_t *zt_ctx, *zt_den;
    int never, ph0, ph1, pad;
};

typedef const volatile __attribute__((address_space(4))) P& KPR;
typedef const volatile __attribute__((address_space(4))) P* KP;
typedef __bf16 nbf16x2 __attribute__((ext_vector_type(2)));
DI unsigned pk_bf16(float lo, float hi) { f32x2 v = {lo, hi}; nbf16x2 b = __builtin_convertvector(v, nbf16x2); return __builtin_bit_cast(unsigned, b); }
DI bf16_t to_bf16(float x) { return (bf16_t)(pk_bf16(x, 0.f) & 0xffffu); }
DI int crow(int e, int h) { return (e & 3) + 8 * (e >> 2) + 4 * h; }
DI int ltid() { int t = threadIdx.x; asm volatile("" : "+v"(t)); return t; }
DI int lbid() { int b = blockIdx.x; asm volatile("" : "+s"(b)); return b; }
DI float silu(float x) { return x * __builtin_amdgcn_rcpf(1.f + __builtin_amdgcn_exp2f(-x * LOG2E)); }
#define MFMA(a, b, c) __builtin_amdgcn_mfma_f32_32x32x16_bf16((a), (b), (c), 0, 0, 0)

#define XB_TMO 128
#define XB_XCNT(j) (256 + 64 * (j))
#define XB_XSUB(j) (1280 + 64 * (j))
#define XB_XGEN(j) (2304 + 64 * (j))
#define XB_TOP 3328
#define XB_TOPGEN 3392
#define XCD_BAR_WORDS 3456
#define XB_SPIN_CAP (1u << 20)
DI unsigned xb_ld(unsigned* p) { return __hip_atomic_load(p, __ATOMIC_RELAXED, __HIP_MEMORY_SCOPE_AGENT); }
DI unsigned xb_add(unsigned* p, unsigned v) { return __hip_atomic_fetch_add(p, v, __ATOMIC_RELAXED, __HIP_MEMORY_SCOPE_AGENT); }
DI unsigned xb_xcc_id() { return (unsigned)__builtin_amdgcn_s_getreg((3 << 11) | 20) & 0xFu; }
#define XB_SPIN(cond, bar)                                                                         \
    do {                                                                                           \
        unsigned _sp = 0;                                                                          \
        while (cond) {                                                                             \
            __builtin_amdgcn_s_sleep(1);                                                           \
            if ((++_sp & 255u) == 0u) {                                                            \
                if (xb_ld(&(bar)[XB_TMO])) break;                                                  \
                if (_sp > XB_SPIN_CAP) { atomicAdd(&(bar)[XB_TMO], 1u); break; }                   \
            }                                                                                      \
        }                                                                                          \
    } while (0)
struct XcdBarrier { unsigned* bar; unsigned x; volatile LAS unsigned* st; };
DI XcdBarrier xcd_barrier_post(unsigned* bar, volatile LAS unsigned* st) {
    XcdBarrier b; b.bar = bar; b.x = xb_xcc_id(); b.st = st;
    if (threadIdx.x == 0) (void)xb_add(&bar[XB_XCNT(b.x)], 1u);
    return b;
}
DI void xcd_barrier_complete(unsigned* bar, unsigned x, unsigned& nloc, unsigned& nx) {
    const unsigned G = gridDim.x * gridDim.y * gridDim.z;
    unsigned sum, cnt, mine, sp = 0u;
    for (;;) {
        sum = 0u; cnt = 0u; mine = 0u;
#pragma unroll
        for (unsigned j = 0; j < 16; ++j) { const unsigned c = xb_ld(&bar[XB_XCNT(j)]); sum += c; cnt += (c > 0u) ? 1u : 0u; mine = (j == x) ? c : mine; }
        if (sum == G) break;
        __builtin_amdgcn_s_sleep(1);
        if ((++sp & 255u) == 0u) { if (xb_ld(&bar[XB_TMO])) break; if (sp > XB_SPIN_CAP) { atomicAdd(&bar[XB_TMO], 1u); break; } }
    }
    nloc = mine > 0u ? mine : 1u; nx = cnt > 0u ? cnt : 1u;
}
DI void xcd_barrier(const XcdBarrier& b) {
    asm volatile("s_waitcnt vmcnt(0)" ::: "memory");
    __syncthreads();
    if (threadIdx.x == 0) {
        unsigned* bar = b.bar;
        __builtin_amdgcn_s_waitcnt(0);
        unsigned nloc = b.st[0], nx = b.st[1];
        if (nloc == 0u) { xcd_barrier_complete(bar, b.x, nloc, nx); b.st[0] = nloc; b.st[1] = nx; }
        const unsigned old = xb_add(&bar[XB_XSUB(b.x)], 1u);
        const unsigned gen = old / nloc;
        if (old + 1u == (gen + 1u) * nloc) {
            __builtin_amdgcn_fence(__ATOMIC_RELEASE, "agent");
            asm volatile("s_waitcnt vmcnt(0)" ::: "memory");
            const unsigned og = xb_add(&bar[XB_TOP], 1u);
            const unsigned tg = og / nx;
            if (og + 1u == (tg + 1u) * nx) xb_add(&bar[XB_TOPGEN], 1u);
            else XB_SPIN(xb_ld(&bar[XB_TOPGEN]) == tg, bar);
            __builtin_amdgcn_fence(__ATOMIC_ACQUIRE, "agent");
            xb_add(&bar[XB_XGEN(b.x)], 1u);
            asm volatile("s_waitcnt vmcnt(0)" ::: "memory");
        } else {
            XB_SPIN(xb_ld(&bar[XB_XGEN(b.x)]) == gen, bar);
            __builtin_amdgcn_fence(__ATOMIC_ACQUIRE, "agent");
            asm volatile("s_waitcnt vmcnt(0)" ::: "memory");
        }
    }
    __syncthreads();
}

DI void glds16(const void* g, unsigned lds_addr) {
    unsigned keep;
    asm volatile("s_mov_b32 %0, m0\n\ts_mov_b32 m0, %2\n\ts_nop 0\n\tglobal_load_lds_dwordx4 %1, off\n\ts_mov_b32 m0, %0" : "=&s"(keep) : "v"(g), "s"(lds_addr) : "memory");
}

namespace pg8 {
#define PG8_LAS __attribute__((address_space(3)))
typedef float f32x4 __attribute__((ext_vector_type(4)));
constexpr int BM = 256, BK = 64, HALF = 128, HTB = HALF * BK * 2, STAGE_BYTES = 8 * HTB;
DI int lds_byte(int r, int c) { const int st = (r >> 4) * 2 + (c >> 5), rr = r & 15, cc = c & 31, ob = rr * 64 + cc * 2; return st * 1024 + (ob ^ (((ob >> 9) & 1) << 5)); }
DI void stage_rc(int b, int& R, int& C) { const int st = b / 1024, sb = b % 1024, swz = sb ^ (((sb >> 9) & 1) << 5); R = (st >> 1) * 16 + swz / 64; C = (st & 1) * 32 + (swz % 64) / 2; }
DI int perm32(int rho) { const int n = rho >> 4, i = rho & 15; return 8 * (i >> 2) + 4 * n + (i & 3); }
struct Unit { int pm, pn; };
struct Gemm { const bf16_t* A; const bf16_t* Bt; int M, N, K; };
struct XcdOrder {
    int nN, x, j, step;
    DI bool next(int i, Unit& u) const { const int lid = j + i * step; if (lid >= 4 * nN) return false; u.pm = 4 * x + (lid & 3); u.pn = lid >> 2; return true; }
    DI void a_ready(const Unit&) const {}
    DI void done(const Unit&) const {}
};
template <class Epi, class Sched, bool STAMP = false>
__device__ __forceinline__ void gemm_phase(PG8_LAS unsigned char* lds, const Gemm g, const Sched& S, const Epi& E, unsigned long long* stamps) {
    const int tid = ltid(), wid = __builtin_amdgcn_readfirstlane(tid >> 6), lane = tid & 63, wr = wid >> 2, wc = wid & 3, fr = lane & 15, fq = lane >> 4;
    const int K = g.K, nt = K / BK;
    int ts_lo = 0, ts_hi = 0, nts = 0; const unsigned long long rt_entry = STAMP ? (unsigned long long)wall_clock64() : 0ull;
#define PG8_STAMP() do { if (STAMP && wid == 0 && nts < 64) { const unsigned long long _c = (unsigned long long)clock64(); \
        ts_lo = (lane == nts) ? (int)(unsigned)_c : ts_lo; ts_hi = (lane == nts) ? (int)(unsigned)(_c >> 32) : ts_hi; ++nts; } } while (0)
    PG8_STAMP();
    unsigned voffA[2], voffB[2];
#pragma unroll
    for (int i = 0; i < 2; ++i) { int R, C; stage_rc(tid * 16 + i * 8192, R, C); const int Rb = Epi::PERM ? ((R & ~31) + perm32(R & 31)) : R;
        voffA[i] = (unsigned)(R * K + C) * 2u; voffB[i] = (unsigned)(Rb * K + C) * 2u; }
    const size_t kstep = (size_t)(BK * 2);
    const size_t hstep = (size_t)HALF * K * 2;
    const size_t tstep = 2 * hstep;
    const unsigned ldsw = (unsigned)wid * 1024u; const unsigned ldsbase = (unsigned)(size_t)lds;
    const int aoff = lds_byte(wr * 64 + fr, fq * 8), boff = lds_byte(wc * 32 + fr, fq * 8);
#define PG8_SA(b, h) (((b) * 2 + (h)) * HTB)
#define PG8_SB(b, h) ((4 + (b) * 2 + (h)) * HTB)
#define PG8_STAGE(bufoff, gbase, voff) do { _Pragma("unroll") for (int _i = 0; _i < 2; ++_i) \
        glds16((const char*)(gbase) + (voff)[_i], ldsbase + (unsigned)(bufoff) + ldsw + _i * 8192u); } while (0)
#define PG8_LDA(dst, b, h) do { _Pragma("unroll") for (int m = 0; m < 4; ++m) _Pragma("unroll") for (int k = 0; k < 2; ++k) dst[m][k] = *(const PG8_LAS bf16x8*)(lds + PG8_SA(b, h) + aoff + m * 2048 + k * 1024); } while (0)
#define PG8_LDB(dst, b, h) do { _Pragma("unroll") for (int n = 0; n < 2; ++n) _Pragma("unroll") for (int k = 0; k < 2; ++k) dst[n][k] = *(const PG8_LAS bf16x8*)(lds + PG8_SB(b, h) + boff + n * 2048 + k * 1024); } while (0)
#define PG8_MMA(ai, bj, At, Bt) do { __builtin_amdgcn_s_setprio(1); _Pragma("unroll") for (int m = 0; m < 4; ++m) _Pragma("unroll") for (int n = 0; n < 2; ++n) _Pragma("unroll") for (int k = 0; k < 2; ++k) \
        acc[ai][bj][m][n] = __builtin_amdgcn_mfma_f32_16x16x32_bf16(Bt[n][k], At[m][k], acc[ai][bj][m][n], 0, 0, 0); __builtin_amdgcn_s_setprio(0); } while (0)
#define PG8_WAIT_V(n) asm volatile("s_waitcnt vmcnt(" #n ")" ::: "memory")
#define PG8_WAIT_L(n) asm volatile("s_waitcnt lgkmcnt(" #n ")" ::: "memory")
#define PG8_BAR __builtin_amdgcn_s_barrier()
#define PG8_SCHED __builtin_amdgcn_sched_barrier(0)
    Unit cur, nxt; int ui = 0;
    if (!S.next(0, cur)) return;
    f32x4 acc[2][2][4][2];
#pragma unroll
    for (int a = 0; a < 2; ++a)
#pragma unroll
        for (int b = 0; b < 2; ++b)
#pragma unroll
            for (int m = 0; m < 4; ++m)
#pragma unroll
                for (int n = 0; n < 2; ++n) acc[a][b][m][n] = (f32x4){0.f, 0.f, 0.f, 0.f};
    bf16x8 At[4][2], B0[2][2], B1[2][2];
    const char* cA = (const char*)g.A + (size_t)cur.pm * tstep; const char* cB = (const char*)g.Bt + (size_t)cur.pn * tstep;
    S.a_ready(cur);
    PG8_STAGE(PG8_SB(0, 0), cB, voffB); PG8_STAGE(PG8_SA(0, 0), cA, voffA); PG8_STAGE(PG8_SB(0, 1), cB + hstep, voffB); PG8_STAGE(PG8_SA(0, 1), cA + hstep, voffA);
    if (wr == 1) PG8_BAR;
    PG8_WAIT_V(4); PG8_BAR;
    PG8_STAGE(PG8_SB(1, 0), cB + kstep, voffB); PG8_STAGE(PG8_SA(1, 0), cA + kstep, voffA); PG8_STAGE(PG8_SB(1, 1), cB + hstep + kstep, voffB);
    PG8_WAIT_V(6); PG8_BAR;
    PG8_STAMP();
    for (;;) {
        const bool has_next = S.next(ui + 1, nxt);
        const char* nA = has_next ? (const char*)g.A + (size_t)nxt.pm * tstep : cA; const char* nB = has_next ? (const char*)g.Bt + (size_t)nxt.pn * tstep : cB;
        for (int t = 0; t < nt; t += 2) {
            const bool last = (t == nt - 2);
            const char* a1 = cA + (size_t)(t + 1) * kstep;
            const char* a2 = last ? nA : cA + (size_t)(t + 2) * kstep; const char* b2 = last ? nB : cB + (size_t)(t + 2) * kstep;
            const char* a3 = a2 + kstep; const char* b3 = b2 + kstep;
            if (last && has_next) S.a_ready(nxt);
            PG8_LDB(B0, 0, 0); PG8_SCHED; PG8_LDA(At, 0, 0); PG8_STAGE(PG8_SA(1, 1), a1 + hstep, voffA);
            PG8_WAIT_L(8); PG8_BAR; PG8_WAIT_L(0); PG8_MMA(0, 0, At, B0); PG8_BAR; PG8_SCHED;
            PG8_LDB(B1, 0, 1); PG8_STAGE(PG8_SB(0, 0), b2, voffB);
            PG8_BAR; PG8_WAIT_L(0); PG8_MMA(0, 1, At, B1); PG8_BAR;
            PG8_LDA(At, 0, 1); PG8_STAGE(PG8_SA(0, 0), a2, voffA);
            PG8_BAR; PG8_WAIT_L(0); PG8_MMA(1, 0, At, B0); PG8_BAR; PG8_SCHED;
            PG8_STAGE(PG8_SB(0, 1), b2 + hstep, voffB);
            PG8_WAIT_V(6); PG8_BAR; PG8_MMA(1, 1, At, B1); PG8_BAR;
            PG8_LDB(B0, 1, 0); PG8_SCHED; PG8_LDA(At, 1, 0); PG8_STAGE(PG8_SA(0, 1), a2 + hstep, voffA);
            PG8_WAIT_L(8); PG8_BAR; PG8_WAIT_L(0); PG8_MMA(0, 0, At, B0); PG8_BAR; PG8_SCHED;
            PG8_LDB(B1, 1, 1); PG8_STAGE(PG8_SB(1, 0), b3, voffB);
            PG8_BAR; PG8_WAIT_L(0); PG8_MMA(0, 1, At, B1); PG8_BAR;
            PG8_LDA(At, 1, 1); PG8_STAGE(PG8_SA(1, 0), a3, voffA);
            PG8_BAR; PG8_WAIT_L(0); PG8_MMA(1, 0, At, B0); PG8_BAR; PG8_SCHED;
            PG8_STAGE(PG8_SB(1, 1), b3 + hstep, voffB);
            PG8_WAIT_V(6); PG8_BAR; PG8_MMA(1, 1, At, B1); PG8_BAR;
        }
        PG8_STAMP();
        if constexpr (!Epi::AFTER_DRAIN) { E(acc, cur, wr, wc, fr, fq); S.done(cur); }
        PG8_STAMP();
        if (!has_next) break;
#pragma unroll
        for (int a = 0; a < 2; ++a)
#pragma unroll
            for (int b = 0; b < 2; ++b)
#pragma unroll
                for (int m = 0; m < 4; ++m)
#pragma unroll
                    for (int n = 0; n < 2; ++n) acc[a][b][m][n] = (f32x4){0.f, 0.f, 0.f, 0.f};
        cur = nxt; cA = nA; cB = nB; ++ui;
    }
    PG8_WAIT_V(0);
    if (wr == 0) PG8_BAR;
    PG8_BAR;
    if constexpr (Epi::AFTER_DRAIN) { E.fused(acc, cur, wr, wc, fr, fq, lds, wid, lane); S.done(cur); }
    PG8_STAMP();
    if (STAMP && wid == 0) { stamps[lane] = lane < nts ? (((unsigned long long)(unsigned)ts_hi << 32) | (unsigned)ts_lo) : 0ull;
        if (lane == 62) stamps[62] = rt_entry; if (lane == 63) stamps[63] = (unsigned long long)wall_clock64(); }
#undef PG8_STAMP
#undef PG8_SA
#undef PG8_SB
#undef PG8_STAGE
#undef PG8_LDA
#undef PG8_LDB
#undef PG8_MMA
#undef PG8_WAIT_V
#undef PG8_WAIT_L
#undef PG8_BAR
#undef PG8_SCHED
}
}

template <int WM>
DI void gemm_tile(const bf16_t* __restrict__ A, int lda, const bf16_t* __restrict__ B, int ldb, int K, char* lds, f32x16 (&acc)[WM][2]) {
    constexpr int NB = WM == 4 ? 4 : (WM == 2 ? 2 : 1);
    int tid = threadIdx.x; asm volatile("" : "+v"(tid));
    const int lane = tid & 63, wid = tid >> 6, r = lane & 31, h = lane >> 5;
    const int wr = WM == 4 ? (wid >> 2) : (WM == 2 ? (wid >> 1) : wid), wc = WM == 4 ? (wid & 3) : (WM == 2 ? (wid & 1) : 0);
#pragma unroll
    for (int i = 0; i < WM; ++i)
#pragma unroll
        for (int j = 0; j < 2; ++j)
#pragma unroll
            for (int e = 0; e < 16; ++e) acc[i][j][e] = 0.f;
    const int lrow = wid * 8 + (lane >> 3);
    const int lkc = (lane & 7) ^ ((lrow >> 1) & 7);
    const bf16_t* ga = A + (size_t)lrow * lda + lkc * 8;
    const bf16_t* gb = B + (size_t)lrow * ldb + lkc * 8;
    LAS char* l3 = (LAS char*)lds;
    const unsigned lbase = (unsigned)(size_t)l3 + (unsigned)__builtin_amdgcn_readfirstlane(wid) * 1024u;
    const int swz = (r >> 1) & 7;
    const int aofs = (wr * (WM * 32) + r) * 128, bofs = 32768 + (wc * 64 + r) * 128;
#define GLDS_TILE(buf, k0)                                                                            \
    _Pragma("unroll") for (int i = 0; i < 4; ++i) glds16(ga + (size_t)i * 64 * lda + (k0), lbase + (buf) + i * 8192);          \
    _Pragma("unroll") for (int i = 0; i < NB; ++i) glds16(gb + (size_t)i * 64 * ldb + (k0), lbase + (buf) + 32768 + i * 8192);
    GLDS_TILE(0, 0)
    asm volatile("s_waitcnt vmcnt(0)" ::: "memory");
    __syncthreads();
    const int nt = K >> 6;
    for (int t = 0; t < nt; ++t) {
        const int cur = (t & 1) * 65536, nxt = 65536 - cur;
        if (t + 1 < nt) { const int k0 = (t + 1) << 6; GLDS_TILE(nxt, k0) }
        bf16x8 af[2][WM], bfr[2][2];
#define LOAD_FRAGS(slot, ks)                                                                                         \
        { const int co = (((ks) * 2 + h) ^ swz) << 4;                                                                \
          _Pragma("unroll") for (int i = 0; i < WM; ++i) af[slot][i] = *(const LAS bf16x8*)(l3 + cur + aofs + i * 4096 + co);   \
          _Pragma("unroll") for (int j = 0; j < 2; ++j) bfr[slot][j] = *(const LAS bf16x8*)(l3 + cur + bofs + j * 4096 + co); }
        LOAD_FRAGS(0, 0)
#pragma unroll
        for (int ks = 0; ks < 4; ++ks) {
            if (ks < 3) LOAD_FRAGS((ks + 1) & 1, ks + 1)
#pragma unroll
            for (int i = 0; i < WM; ++i)
#pragma unroll
                for (int j = 0; j < 2; ++j) acc[i][j] = MFMA(bfr[ks & 1][j], af[ks & 1][i], acc[i][j]);
            __builtin_amdgcn_sched_barrier(0);
        }
#undef LOAD_FRAGS
        asm volatile("s_waitcnt vmcnt(0)" ::: "memory");
        __syncthreads();
    }
#undef GLDS_TILE
}

template <int WM, bool SWAP = false>
DI void gemm_tile3(const bf16_t* __restrict__ A, int lda, const bf16_t* __restrict__ B, int ldb, int K, char* lds, f32x16 (&acc)[WM][2]) {
    static_assert(WM <= 2, "three 64-deep stages only fit for BN <= 128");
    constexpr int NB = WM == 2 ? 2 : 1;
    int tid = ltid();
    const int lane = tid & 63, wid = tid >> 6, r = lane & 31, h = lane >> 5;
    const int wr = WM == 2 ? (wid >> 1) : wid, wc = WM == 2 ? (wid & 1) : 0;
#pragma unroll
    for (int i = 0; i < WM; ++i)
#pragma unroll
        for (int j = 0; j < 2; ++j)
#pragma unroll
            for (int e = 0; e < 16; ++e) acc[i][j][e] = 0.f;
    const int lrow = wid * 8 + (lane >> 3);
    const int lkc = (lane & 7) ^ ((lrow >> 1) & 7);
    const bf16_t* ga = A + (size_t)lrow * lda + lkc * 8;
    const bf16_t* gb = B + (size_t)lrow * ldb + lkc * 8;
    LAS char* l3 = (LAS char*)lds;
    const unsigned lbase = (unsigned)(size_t)l3 + (unsigned)__builtin_amdgcn_readfirstlane(wid) * 1024u;
    const int swz = (r >> 1) & 7;
    const int aofs = (wr * (WM * 32) + r) * 128, bofs = 32768 + (wc * 64 + r) * 128;
#define ISSUE3(buf, k0)                                                                               \
    { _Pragma("unroll") for (int i = 0; i < 4; ++i) glds16(ga + (size_t)i * 64 * lda + (k0), lbase + (buf) + i * 8192);          \
      _Pragma("unroll") for (int i = 0; i < NB; ++i) glds16(gb + (size_t)i * 64 * ldb + (k0), lbase + (buf) + 32768 + i * 8192); }
    const int nt = K >> 6;
    ISSUE3(0, 0)
    if (nt > 1) ISSUE3(49152, 64)
    int cur = 0, nxt2 = 98304;
    for (int t = 0; t < nt; ++t) {
        if (t + 1 < nt) { if (NB == 2) asm volatile("s_waitcnt vmcnt(6)" ::: "memory"); else asm volatile("s_waitcnt vmcnt(5)" ::: "memory"); }
        else asm volatile("s_waitcnt vmcnt(0)" ::: "memory");
        asm volatile("s_waitcnt lgkmcnt(0)" ::: "memory");
        __builtin_amdgcn_s_barrier();
        asm volatile("" ::: "memory");
        if (t + 2 < nt) { const int k0 = (t + 2) << 6; ISSUE3(nxt2, k0) }
        bf16x8 af[2][WM], bfr[2][2];
#define LOAD_FRAGS3(slot, ks)                                                                                         \
        { const int co = (((ks) * 2 + h) ^ swz) << 4;                                                                \
          _Pragma("unroll") for (int i = 0; i < WM; ++i) af[slot][i] = *(const LAS bf16x8*)(l3 + cur + aofs + i * 4096 + co);   \
          _Pragma("unroll") for (int j = 0; j < 2; ++j) bfr[slot][j] = *(const LAS bf16x8*)(l3 + cur + bofs + j * 4096 + co); }
        LOAD_FRAGS3(0, 0)
#pragma unroll
        for (int ks = 0; ks < 4; ++ks) {
            if (ks < 3) LOAD_FRAGS3((ks + 1) & 1, ks + 1)
#pragma unroll
            for (int i = 0; i < WM; ++i)
#pragma unroll
                for (int j = 0; j < 2; ++j) acc[i][j] = SWAP ? MFMA(af[ks & 1][i], bfr[ks & 1][j], acc[i][j]) : MFMA(bfr[ks & 1][j], af[ks & 1][i], acc[i][j]);
            __builtin_amdgcn_sched_barrier(0);
        }
#undef LOAD_FRAGS3
        const int tmp = cur; cur = cur == 98304 ? 0 : cur + 49152; nxt2 = tmp;
    }
#undef ISSUE3
    __syncthreads();
}

DI void st_bf16_tile(bf16_t* dst, const f32x16& v, int h) {
#pragma unroll
    for (int q = 0; q < 4; ++q) {
        u32x2 w; w.x = pk_bf16(v[4 * q], v[4 * q + 1]); w.y = pk_bf16(v[4 * q + 2], v[4 * q + 3]);
        *(u32x2*)(dst + 8 * q + 4 * h) = w;
    }
}
DI void st_f32_tile(float* dst, const f32x16& v, int h) {
#pragma unroll
    for (int q = 0; q < 4; ++q) { f32x4 w = {v[4 * q], v[4 * q + 1], v[4 * q + 2], v[4 * q + 3]}; *(f32x4*)(dst + 8 * q + 4 * h) = w; }
}
DI void st_bf16_tile_T(bf16_t* dst, size_t ld, const f32x16& v, int h) {
#pragma unroll
    for (int e = 0; e < 16; ++e) dst[(size_t)crow(e, h) * ld] = to_bf16(v[e]);
}
DI void st_bf16_tile_S(bf16_t* dst, const f32x16& v, int h) {
#pragma unroll
    for (int q = 0; q < 4; ++q) { u32x2 w; w.x = pk_bf16(v[4 * q], v[4 * q + 1]); w.y = pk_bf16(v[4 * q + 2], v[4 * q + 3]); *(u32x2*)(dst + 8 * q + 4 * h) = w; }
}
DI float sumsq16(const f32x16& v) { float s = 0.f;
#pragma unroll
    for (int e = 0; e < 16; ++e) s += v[e] * v[e];
    return s; }

DI const float* win_src(const float* w, int nd) {
    int sc;
    if (nd < 640) sc = nd; else if (nd < 1024) sc = 928 + (nd - 640); else if (nd < 1152) sc = 1312 + (nd - 1024); else if (nd < 1280) sc = 1440 + (nd - 1152);
    else if (nd < 1536) sc = 672 + (nd - 1280); else if (nd < 1568) sc = 640 + (nd - 1536); else return nullptr;
    return w + sc;
}
DI int win_phys2log(int c) { return (c & ~255) + 64 * ((c >> 5) & 3) + 32 * ((c >> 7) & 1) + (c & 31); }
DI void tr_tile(const float* colp, int nsrc, bf16_t* dst, int K, int k0, int nd0, const float* kscale, float* tile) {
    const int tid = ltid() & 255, tn = tid & 63, tk = tid >> 6;
    float tv[16];
#pragma unroll
    for (int i = 0; i < 16; ++i) tv[i] = colp ? __builtin_nontemporal_load(colp + (size_t)(k0 + tk + 4 * i) * nsrc) : 0.f;
    if (kscale) {
#pragma unroll
        for (int i = 0; i < 16; ++i) tv[i] *= kscale[k0 + tk + 4 * i];
    }
#pragma unroll
    for (int i = 0; i < 16; ++i) tile[(tk + 4 * i) * 65 + tn] = tv[i];
    __syncthreads();
    const int rr = tid >> 2, kq = tid & 3;
    u32x4 o0, o1;
    const float* tp = tile + (kq * 16) * 65 + rr;
    o0.x = pk_bf16(tp[0 * 65], tp[1 * 65]); o0.y = pk_bf16(tp[2 * 65], tp[3 * 65]); o0.z = pk_bf16(tp[4 * 65], tp[5 * 65]); o0.w = pk_bf16(tp[6 * 65], tp[7 * 65]);
    o1.x = pk_bf16(tp[8 * 65], tp[9 * 65]); o1.y = pk_bf16(tp[10 * 65], tp[11 * 65]); o1.z = pk_bf16(tp[12 * 65], tp[13 * 65]); o1.w = pk_bf16(tp[14 * 65], tp[15 * 65]);
    bf16_t* d = dst + (size_t)(nd0 + rr) * K + k0 + kq * 16;
    *(u32x4*)d = o0; *(u32x4*)(d + 8) = o1;
    __syncthreads();
}

DI void phase_prologue(KPR p, char* lds) {
    const int tid = ltid(), bid = lbid(), G = gridDim.x;
    float* tile = (float*)lds;
    for (int task = bid; task < 768; task += G) {
        const int l = task / 384, rem = task % 384, kc = rem / 12, cb = rem % 12;
        if (tid < 96) { const int j = tid >> 5, k = kc * 32 + (tid & 31); const float cv = (j == 0) ? p.c_ctx[k] : p.c[(j - 1) * 1024 + k]; tile[tid] = silu(cv); }
        __syncthreads();
        const int n = cb * 512 + tid;
        const float* w = p.w_ada + ((size_t)l * 1024 + kc * 32) * 6144 + n;
        float s0 = 0.f, s1 = 0.f, s2 = 0.f;
        float wv[32];
#pragma unroll
        for (int k = 0; k < 32; ++k) wv[k] = __builtin_nontemporal_load(w + (size_t)k * 6144);
#pragma unroll
        for (int k = 0; k < 32; ++k) { s0 += tile[k] * wv[k]; s1 += tile[32 + k] * wv[k]; s2 += tile[64 + k] * wv[k]; }
        if (kc == 0) { const float bv = p.b_ada[l * 6144 + n]; s0 += bv; s1 += bv; s2 += bv; }
        float* m = p.mod + (size_t)l * 3 * 6144 + n;
        atomicAdd(m, s0); atomicAdd(m + 6144, s1); atomicAdd(m + 2 * 6144, s2);
        __syncthreads();
    }
    tile = (float*)(lds + (tid >> 8) * 16640);
    for (int pp = bid; pp < 2972; pp += G) {
        const int tt = pp * 2 + (tid >> 8);
        const int l = tt / 2972; int t = tt % 2972;
        const int tn = tid & 63;
        if (t < 448) { const int kt = t / 28, nt = t % 28; const float* w = p.w_in + (size_t)l * 1024 * 1568;
            tr_tile(win_src(w, win_phys2log(nt * 64 + tn)), 1568, p.wt_in + l * SZ_WIN, 1024, kt * 64, nt * 64, nullptr, tile); continue; }
        t -= 448;
        if (t < 60) { const int kt = t / 10, nt = t % 10; const float* w = p.w_q_up + (size_t)l * 384 * 576; const int nd = nt * 64 + tn;
            tr_tile(nd < 576 ? w + nd : nullptr, 576, p.wt_qup + l * SZ_QUP, 384, kt * 64, nt * 64, p.g_q_a + l * 384, tile); continue; }
        t -= 60;
        if (t < 96) { const int var = t / 48; t %= 48; const int kt = t / 12, nt = t % 12; const float* w = p.w_kv_up + (size_t)l * 256 * 768;
            tr_tile(w + nt * 64 + tn, 768, (var ? p.wt_kvp : p.wt_kvg) + l * SZ_KV, 256, kt * 64, nt * 64, var ? nullptr : p.g_kv_a + l * 256, tile); continue; }
        t -= 96;
        if (t < 256) { const int kt = t / 16, nt = t % 16; const float* w = p.w_out + (size_t)l * 1024 * 1024;
            tr_tile(w + nt * 64 + tn, 1024, p.wt_out + l * SZ_WOUT, 1024, kt * 64, nt * 64, nullptr, tile); continue; }
        t -= 256;
        if (t < 1408) { const int kt = t / 88, nt = t % 88; const float* w = ((tn & 31) < 16 ? p.w_gate : p.w_up) + (size_t)l * 1024 * 2816 + (nt * 2 + (tn >> 5)) * 16 + (tn & 15);
            tr_tile(w, 2816, p.wt_gu + l * SZ_GU, 1024, kt * 64, nt * 64, nullptr, tile); continue; }
        t -= 1408;
        { const int kt = t / 16, nt = t % 16; const float* w = p.w_down + (size_t)l * 2816 * 1024;
            tr_tile(w + nt * 64 + tn, 1024, p.wt_down + l * SZ_DOWN, 2816, kt * 64, nt * 64, nullptr, tile); }
    }
    const int gt = bid * 512 + tid, GT = G * 512;
    for (int i = gt; i < 2048 * 512; i += GT) {
        const int pp = i >> 9, k8 = (i & 511) * 8; u32x4 o; unsigned w[4];
#pragma unroll
        for (int e = 0; e < 4; ++e) { float v[2];
#pragma unroll
            for (int z = 0; z < 2; ++z) { const int kq = k8 + 2 * e + z; const int m = (pp * (kq & 2047)) & 2047; const float a = (float)m * (1.f / 1024.f);
                v[z] = (kq < 2048 ? cospif(a) : -sinpif(a)) * 0.022097086912079608f; }
            w[e] = pk_bf16(v[0], v[1]); }
        o.x = w[0]; o.y = w[1]; o.z = w[2]; o.w = w[3];
        *(u32x4*)(p.tab2048 + (size_t)pp * 4096 + k8) = o;
    }
    for (int i = gt; i < 256 * 512; i += GT) { const int pp = i >> 9, kq = i & 511; const int m = (pp * (kq & 255)) & 255; const float a = (float)m * (1.f / 128.f);
        p.tab256[i] = to_bf16((kq < 256 ? cospif(a) : -sinpif(a)) * 0.0625f); }
    for (int i = gt; i < 128 * 64; i += GT) { const int n = i >> 6, k = i & 63; const int m = ((n & 63) * k) & 63; const float a = (float)m * (1.f / 32.f);
        p.bt_ch[i] = to_bf16((n < 64 ? cospif(a) : sinpif(a)) * 0.125f); }
    for (int i = gt; i < 2048 * 32; i += GT) { const int t = i >> 5, pr = i & 31; const float inv = powf(10000.f, -(float)(pr & 15) * (1.f / 16.f));
        const float pos = (float)(pr < 16 ? (t >> 6) : (t & 63)); const float ang = pos * inv; f32x2 cs = {cosf(ang), sinf(ang)}; p.rope_g[i] = cs; }
    for (int i = gt; i < 2048 * 16; i += GT) { const int t = i >> 4, pr = i & 15; const float inv = powf(10000.f, -(float)(pr & 7) * (1.f / 8.f));
        const float pos = (float)(pr < 8 ? (t >> 6) : (t & 63)); const float ang = pos * inv; f32x2 cs = {cosf(ang), sinf(ang)}; p.rope_m[i] = cs; }
    for (int i = gt; i < 2 * 2 * 256 * 256; i += GT) p.ckv_cache[i] = to_bf16(p.c_ckv[i]);
    for (int i = gt; i < 2 * 2 * 256 * 32; i += GT) {
        const int d = i & 31, s = (i >> 5) & 255, l = (i >> 13) & 1, b = i >> 14; const bf16_t v = to_bf16(p.c_krope[i]);
        bf16_t* dst = p.kmla_den + ((size_t)((l * 2 + b) * 2304 + s) * 6) * 96 + 64 + d;
#pragma unroll
        for (int hh = 0; hh < 6; ++hh) dst[hh * 96] = v;
    }
    for (int i = gt; i < 2 * 2 * 256 * 128; i += GT) {
        const int d = i & 63, hk = (i >> 6) & 1, s = (i >> 7) & 255, l = (i >> 15) & 1, b = i >> 16;
        p.kgqa_den[((size_t)((l * 2 + b) * 2304 + s) * 2 + hk) * 64 + d] = to_bf16(p.c_gk[i]);
        p.vtgqa_den[((size_t)((l * 2 + b) * 2 + hk) * 64 + d) * 2304 + s] = to_bf16(p.c_gv[i]);
    }
}

DI void phase_norm(KPR p, const float* xc, const float* xd, const float* g, const float* modl, int shift_off, int scale_off, int bias_l) {
    const int lane = ltid() & 63, gw = lbid() * 8 + (ltid() >> 6), nw = gridDim.x * 8;
    for (int T0 = gw; T0 < NTOK; T0 += 4 * nw) {
        f32x4 v[4][4];
#pragma unroll
        for (int rr = 0; rr < 4; ++rr) {
            const int T = T0 + rr * nw;
            if (T < NTOK) {
                const float* xr = T < NCTX ? xc + (size_t)T * D : xd + (size_t)(T - NCTX) * D;
#pragma unroll
                for (int i = 0; i < 4; ++i) v[rr][i] = *(const f32x4*)(xr + lane * 4 + i * 256);
            }
        }
#pragma unroll
        for (int rr = 0; rr < 4; ++rr) {
            const int T = T0 + rr * nw;
            if (T < NTOK) {
                const float* mj = modl + (T < NCTX ? 0 : 1 + ((T - NCTX) >> 11)) * 6144;
                float ss = 0.f;
#pragma unroll
                for (int i = 0; i < 4; ++i) ss += v[rr][i].x * v[rr][i].x + v[rr][i].y * v[rr][i].y + v[rr][i].z * v[rr][i].z + v[rr][i].w * v[rr][i].w;
#pragma unroll
                for (int o = 32; o >= 1; o >>= 1) ss += __shfl_xor(ss, o);
                const float rs = rsqrtf(ss * (1.f / 1024.f) + EPS);
#pragma unroll
                for (int i = 0; i < 4; ++i) {
                    const int c = lane * 4 + i * 256;
                    const f32x4 gg = *(const f32x4*)(g + c), sc = *(const f32x4*)(mj + scale_off + c), sh = *(const f32x4*)(mj + shift_off + c);
                    const f32x4 x = v[rr][i];
                    u32x2 w; w.x = pk_bf16(x.x * rs * gg.x * (1.f + sc.x) + sh.x, x.y * rs * gg.y * (1.f + sc.y) + sh.y);
                    w.y = pk_bf16(x.z * rs * gg.z * (1.f + sc.z) + sh.z, x.w * rs * gg.w * (1.f + sc.w) + sh.w);
                    *(u32x2*)(p.h + (size_t)T * D + c) = w;
                }
            }
        }
    }
    if (bias_l >= 0) {
        for (int rb = gw; rb < 13056; rb += 7 * nw) {
            u32x4 w0[7], w1[7];
#pragma unroll
            for (int rr = 0; rr < 7; ++rr) {
                const int row = rb + rr * nw;
                if (row < 13056) {
                    const bf16_t* wrow = row < 5632 ? p.wt_gu + (size_t)row * D : (row < 11264 ? p.wt_gu + SZ_GU + (size_t)(row - 5632) * D : p.wt_in + SZ_WIN + (size_t)(row - 11264) * D);
                    w0[rr] = *(const u32x4*)(wrow + lane * 16); w1[rr] = *(const u32x4*)(wrow + lane * 16 + 8);
                }
            }
#pragma unroll
            for (int rr = 0; rr < 7; ++rr) {
                const int row = rb + rr * nw;
                if (row < 13056) {
                    const float* sh = row < 5632 ? p.mod + 3072 : (row < 11264 ? p.mod + 3 * 6144 + 3072 : p.mod + 3 * 6144);
                    float wf[16]; const unsigned ww[8] = {w0[rr].x, w0[rr].y, w0[rr].z, w0[rr].w, w1[rr].x, w1[rr].y, w1[rr].z, w1[rr].w};
#pragma unroll
                    for (int e = 0; e < 8; ++e) { wf[2 * e] = __uint_as_float(ww[e] << 16); wf[2 * e + 1] = __uint_as_float(ww[e] & 0xffff0000u); }
                    float a3[3];
#pragma unroll
                    for (int j = 0; j < 3; ++j) {
                        float a = 0.f;
#pragma unroll
                        for (int q = 0; q < 4; ++q) { const f32x4 sv = *(const f32x4*)(sh + j * 6144 + lane * 16 + q * 4); a += sv.x * wf[4 * q] + sv.y * wf[4 * q + 1] + sv.z * wf[4 * q + 2] + sv.w * wf[4 * q + 3]; }
#pragma unroll
                        for (int o = 32; o >= 1; o >>= 1) a += __shfl_xor(a, o);
                        a3[j] = a;
                    }
                    if (lane < 3) {
                        float* dst = row < 5632 ? p.bias_gu + (size_t)lane * 5632 + row : (row < 11264 ? p.bias_gu + (size_t)(3 + lane) * 5632 + (row - 5632) : p.bias_in + (size_t)lane * 1792 + (row - 11264));
                        *dst = lane == 0 ? a3[0] : (lane == 1 ? a3[1] : a3[2]);
                    }
                }
            }
        }
    }
}

DI void phase_final(KPR p, const float* x) {
    const float* h_g_final = p.g_final;
    float* h_out = p.out;

    const int lane = ltid() & 63, gw = lbid() * 8 + (ltid() >> 6), nw = gridDim.x * 8;
    for (int T0 = gw; T0 < NTOK; T0 += 4 * nw) {
        f32x4 v[4][4];
#pragma unroll
        for (int rr = 0; rr < 4; ++rr) {
            const int T = T0 + rr * nw;
            if (T < NTOK) {
#pragma unroll
                for (int i = 0; i < 4; ++i) v[rr][i] = *(const f32x4*)(x + (size_t)T * D + lane * 4 + i * 256);
            }
        }
#pragma unroll
        for (int rr = 0; rr < 4; ++rr) {
            const int T = T0 + rr * nw;
            if (T < NTOK) {
                float ss = 0.f;
#pragma unroll
                for (int i = 0; i < 4; ++i) ss += v[rr][i].x * v[rr][i].x + v[rr][i].y * v[rr][i].y + v[rr][i].z * v[rr][i].z + v[rr][i].w * v[rr][i].w;
#pragma unroll
                for (int o = 32; o >= 1; o >>= 1) ss += __shfl_xor(ss, o);
                const float rs = rsqrtf(ss * (1.f / 1024.f) + EPS);
#pragma unroll
                for (int i = 0; i < 4; ++i) { const int c = lane * 4 + i * 256; const f32x4 gg = *(const f32x4*)(h_g_final + c); const f32x4 xx = v[rr][i];
                    f32x4 o = {xx.x * rs * gg.x, xx.y * rs * gg.y, xx.z * rs * gg.z, xx.w * rs * gg.w}; __builtin_nontemporal_store(o, (f32x4*)(h_out + (size_t)T * D + c)); }
            }
        }
    }
}

DI void rope_pair(float& x1, float& x2, const f32x2 cs) { const float a = x1 * cs.x - x2 * cs.y, b = x2 * cs.x + x1 * cs.y; x1 = a; x2 = b; }
template <int WM>
DI void epi_win(KPR p, int l, f32x16 (&acc)[WM][2], int tok0, int cb, int r, int h) {
#pragma unroll
    for (int i = 0; i < WM; ++i) {
        __builtin_amdgcn_sched_barrier(0);
        const int T = tok0 + i * 32 + r; const bool den = T >= NCTX;
        int b, s; if (!den) { b = T >> 8; s = T & 255; } else { b = (T - NCTX) >> 11; s = (T - NCTX) & 2047; }
        if (cb < 640) {
            float ss = sumsq16(acc[i][0]) + sumsq16(acc[i][1]); ss += __shfl_xor(ss, 32);
            if (cb < 384) {
                bf16_t* dst = p.cq + (size_t)T * 384 + cb; st_bf16_tile(dst, acc[i][0], h); st_bf16_tile(dst + 32, acc[i][1], h);
                if (h == 0) p.ssq_q[T * 6 + (cb >> 6)] = ss;
            } else {
                const int c0 = cb - 384; bf16_t* dst = p.ckv + (size_t)T * 256 + c0; st_bf16_tile(dst, acc[i][0], h); st_bf16_tile(dst + 32, acc[i][1], h);
                if (h == 0) p.ssq_kv[T * 4 + (c0 >> 6)] = ss;
                if (!den) { float* o = p.out + OFF_CKV + ((size_t)((b * 2 + l) * 256 + s)) * 256 + c0; st_f32_tile(o, acc[i][0], h); st_f32_tile(o + 32, acc[i][1], h); }
            }
        } else if (cb < 1152) {
            float ss = sumsq16(acc[i][0]) + sumsq16(acc[i][1]); ss += __shfl_xor(ss, 32);
            const float rs = rsqrtf(ss * (1.f / 64.f) + EPS);
            const bool isq = cb < 1024;
            const float* g = (isq ? p.g_q_head : p.g_k_head) + l * 64;
            const int hk = (cb - 1024) >> 6;
            float* o32 = p.out + OFF_GK + ((size_t)(((b * 2 + l) * 256 + s) * 2 + hk)) * 64;
            bf16_t* dst = isq ? p.gq + (size_t)T * 384 + (cb - 640)
                              : (den ? p.kgqa_den + ((size_t)((l * 2 + b) * 2304 + 256 + s) * 2 + hk) * 64 : p.kgqa_ctx + ((size_t)(b * 256 + s) * 2 + hk) * 64);
            const float qs = isq ? 0.125f * LOG2E : 1.f;
#pragma unroll
            for (int q = 0; q < 4; ++q) {
                const int d0 = 8 * q + 4 * h;
                const f32x4 g0 = *(const f32x4*)(g + d0), g1 = *(const f32x4*)(g + 32 + d0);
                float x1[4], x2[4];
#pragma unroll
                for (int z = 0; z < 4; ++z) { x1[z] = acc[i][0][4 * q + z] * rs * g0[z]; x2[z] = acc[i][1][4 * q + z] * rs * g1[z]; }
                if (!isq && !den) { f32x4 w0 = {x1[0], x1[1], x1[2], x1[3]}, w1 = {x2[0], x2[1], x2[2], x2[3]}; *(f32x4*)(o32 + d0) = w0; *(f32x4*)(o32 + 32 + d0) = w1; }
                if (den) {
                    const f32x4 ca = *(const f32x4*)(p.rope_g + s * 32 + d0), cb2 = *(const f32x4*)(p.rope_g + s * 32 + d0 + 2);
                    { f32x2 cs = {ca[0], ca[1]}; rope_pair(x1[0], x2[0], cs); } { f32x2 cs = {ca[2], ca[3]}; rope_pair(x1[1], x2[1], cs); }
                    { f32x2 cs = {cb2[0], cb2[1]}; rope_pair(x1[2], x2[2], cs); } { f32x2 cs = {cb2[2], cb2[3]}; rope_pair(x1[3], x2[3], cs); }
                }
                u32x2 w0, w1; w0.x = pk_bf16(x1[0] * qs, x1[1] * qs); w0.y = pk_bf16(x1[2] * qs, x1[3] * qs); w1.x = pk_bf16(x2[0] * qs, x2[1] * qs); w1.y = pk_bf16(x2[2] * qs, x2[3] * qs);
                *(u32x2*)(dst + d0) = w0; *(u32x2*)(dst + 32 + d0) = w1;
                __builtin_amdgcn_sched_barrier(0);
            }
        } else if (cb < 1280) {
            const int hk = (cb - 1152) >> 6;
            if (!den) {
                float* o = p.out + OFF_GV + ((size_t)(((b * 2 + l) * 256 + s) * 2 + hk)) * 64; st_f32_tile(o, acc[i][0], h); st_f32_tile(o + 32, acc[i][1], h);
                bf16_t* dst = p.vtgqa_ctx + ((size_t)(b * 2 + hk) * 64) * 256 + s; st_bf16_tile_T(dst, 256, acc[i][0], h); st_bf16_tile_T(dst + 32 * 256, 256, acc[i][1], h);
            } else {
                bf16_t* dst = p.vtgqa_den + ((size_t)((l * 2 + b) * 2 + hk) * 64) * 2304 + 256 + s; st_bf16_tile_T(dst, 2304, acc[i][0], h); st_bf16_tile_T(dst + 32 * 2304, 2304, acc[i][1], h);
            }
        } else if (cb < 1536) {
            bf16_t* dst = p.u + (size_t)T * 256 + (cb - 1280); st_bf16_tile(dst, acc[i][0], h); st_bf16_tile(dst + 32, acc[i][1], h);
        } else if (cb == 1536) {
            f32x16 v = acc[i][0];
            if (!den) {
                float* o = p.out + OFF_KROPE + ((size_t)((b * 2 + l) * 256 + s)) * 32; st_f32_tile(o, v, h);
                bf16_t* dst = p.kmla_ctx + ((size_t)(b * 256 + s) * 6) * 96 + 64;
#pragma unroll
                for (int hh = 0; hh < 6; ++hh) st_bf16_tile(dst + hh * 96, v, h);
            } else {
#pragma unroll
                for (int e = 0; e < 8; ++e) { const f32x2 cs = p.rope_m[s * 16 + crow(e, h)]; float x1 = v[e], x2 = v[e + 8]; rope_pair(x1, x2, cs); v[e] = x1; v[e + 8] = x2; }
                bf16_t* dst = p.kmla_den + ((size_t)((l * 2 + b) * 2304 + 256 + s) * 6) * 96 + 64;
#pragma unroll
                for (int hh = 0; hh < 6; ++hh) st_bf16_tile(dst + hh * 96, v, h);
            }
        }
    }
}

#ifndef TILEMAP
#define TILEMAP 0
#endif
#if TILEMAP == 0
#define FOR_TILES_32M(NT, mvar, nvar)                                                             \
    for (int _lid = (lbid() >> 3), mvar = 4 * (lbid() & 7) + (_lid & 3), nvar = _lid >> 2; _lid < 4 * (NT);     \
         _lid += (int)(gridDim.x >> 3), mvar = 4 * (lbid() & 7) + (_lid & 3), nvar = _lid >> 2)
#else
#define FOR_TILES_32M(NT, mvar, nvar)                                                             \
    for (int _lid = (lbid() & 31), mvar = 4 * (lbid() >> 5) + (_lid & 3), nvar = _lid >> 2; _lid < 4 * (NT);     \
         _lid += 32, mvar = 4 * (lbid() >> 5) + (_lid & 3), nvar = _lid >> 2)
#endif

struct EpiWin {
    static constexpr bool PERM = true, AFTER_DRAIN = false;
    KP pp; int l; const float* lrs; const float* lbias; const f32x2* ropeR; const f32x2* ropeC;
    DI void operator()(const pg8::f32x4 (&acc)[2][2][4][2], const pg8::Unit& u, int wr, int wc, int fr, int fq) const {
        struct { bf16_t *cq, *ckv, *gq, *u, *kgqa_den, *kgqa_ctx, *vtgqa_den, *vtgqa_ctx, *kmla_den, *kmla_ctx; float *ssq_q, *ssq_kv, *out; const float *g_q_head, *g_k_head; const f32x2* rope_m; } p;
        { KPR q = *pp; p.cq = q.cq; p.ckv = q.ckv; p.gq = q.gq; p.u = q.u; p.kgqa_den = q.kgqa_den; p.kgqa_ctx = q.kgqa_ctx; p.vtgqa_den = q.vtgqa_den; p.vtgqa_ctx = q.vtgqa_ctx;
          p.kmla_den = q.kmla_den; p.kmla_ctx = q.kmla_ctx; p.ssq_q = q.ssq_q; p.ssq_kv = q.ssq_kv; p.out = q.out; p.g_q_head = q.g_q_head; p.g_k_head = q.g_k_head; p.rope_m = q.rope_m; }
        const int cb = u.pn * 256 + wc * 64, d0 = 8 * fq;
        if (cb >= 1568) return;
#pragma unroll
        for (int ai = 0; ai < 2; ++ai)
#pragma unroll
            for (int m = 0; m < 4; ++m) {
                const int T = u.pm * 256 + ai * 128 + wr * 64 + m * 16 + fr; const bool den = T >= NCTX;
                int b, s; if (!den) { b = T >> 8; s = T & 255; } else { b = (T - NCTX) >> 11; s = (T - NCTX) & 2047; }
                float v[2][8];
#pragma unroll
                for (int bj = 0; bj < 2; ++bj)
#pragma unroll
                    for (int n = 0; n < 2; ++n)
#pragma unroll
                        for (int j = 0; j < 4; ++j) v[bj][4 * n + j] = acc[ai][bj][m][n][j];
                if (lrs) {
                    const float rs = lrs[ai * 128 + wr * 64 + m * 16 + fr];
#pragma unroll
                    for (int bj = 0; bj < 2; ++bj) {
                        const f32x4 b0 = *(const f32x4*)(lbias + bj * 128 + wc * 32 + d0), b1 = *(const f32x4*)(lbias + bj * 128 + wc * 32 + d0 + 4);
#pragma unroll
                        for (int z = 0; z < 4; ++z) { v[bj][z] = v[bj][z] * rs + b0[z]; v[bj][4 + z] = v[bj][4 + z] * rs + b1[z]; }
                    }
                }
                float ss = 0.f;
                if (cb < 1152) {
#pragma unroll
                    for (int bj = 0; bj < 2; ++bj)
#pragma unroll
                        for (int z = 0; z < 8; ++z) ss += v[bj][z] * v[bj][z];
                    ss += __shfl_xor(ss, 16); ss += __shfl_xor(ss, 32);
                }
                auto st8 = [&](bf16_t* dst, const float* x) { u32x4 w; w.x = pk_bf16(x[0], x[1]); w.y = pk_bf16(x[2], x[3]); w.z = pk_bf16(x[4], x[5]); w.w = pk_bf16(x[6], x[7]); *(u32x4*)dst = w; };
                auto st8f = [&](float* dst, const float* x) { f32x4 a = {x[0], x[1], x[2], x[3]}, c = {x[4], x[5], x[6], x[7]}; *(f32x4*)dst = a; *(f32x4*)(dst + 4) = c; };
                if (cb < 384) {
                    bf16_t* dst = p.cq + (size_t)T * 384 + cb + d0; st8(dst, v[0]); st8(dst + 32, v[1]);
                    if (fq == 0) p.ssq_q[T * 6 + (cb >> 6)] = ss;
                } else if (cb < 640) {
                    const int c0 = cb - 384; bf16_t* dst = p.ckv + (size_t)T * 256 + c0 + d0; st8(dst, v[0]); st8(dst + 32, v[1]);
                    if (fq == 0) p.ssq_kv[T * 4 + (c0 >> 6)] = ss;
                    if (!den) { float* o = p.out + OFF_CKV + ((size_t)((b * 2 + l) * 256 + s)) * 256 + c0 + d0; st8f(o, v[0]); st8f(o + 32, v[1]); }
                } else if (cb < 1152) {
                    const float rs = rsqrtf(ss * (1.f / 64.f) + EPS);
                    const bool isq = cb < 1024;
                    const float* g = (isq ? p.g_q_head : p.g_k_head) + l * 64 + d0;
                    const int hk = (cb - 1024) >> 6;
                    {
                        const f32x4 ga = *(const f32x4*)g, gb2 = *(const f32x4*)(g + 4), gc = *(const f32x4*)(g + 32), gd = *(const f32x4*)(g + 36);
#pragma unroll
                        for (int z = 0; z < 4; ++z) { v[0][z] *= rs * ga[z]; v[0][4 + z] *= rs * gb2[z]; v[1][z] *= rs * gc[z]; v[1][4 + z] *= rs * gd[z]; }
                    }
                    if (!isq && !den) { float* o = p.out + OFF_GK + ((size_t)(((b * 2 + l) * 256 + s) * 2 + hk)) * 64 + d0; st8f(o, v[0]); st8f(o + 32, v[1]); }
                    if (den) {
                        const f32x2* rp = (fq < 2 ? ropeR + (s >> 6) * 16 : ropeC + (s & 63) * 16) + (fq & 1) * 8;
#pragma unroll
                        for (int z = 0; z < 8; z += 2) { const f32x4 c2 = *(const f32x4*)(rp + z); { f32x2 cs = {c2[0], c2[1]}; rope_pair(v[0][z], v[1][z], cs); } { f32x2 cs = {c2[2], c2[3]}; rope_pair(v[0][z + 1], v[1][z + 1], cs); } }
                    }
                    if (isq) {
                        const float qs = 0.125f * LOG2E;
#pragma unroll
                        for (int z = 0; z < 8; ++z) { v[0][z] *= qs; v[1][z] *= qs; }
                        bf16_t* dst = p.gq + (size_t)T * 384 + (cb - 640) + d0; st8(dst, v[0]); st8(dst + 32, v[1]);
                    } else {
                        bf16_t* dst = (den ? p.kgqa_den + ((size_t)((l * 2 + b) * 2304 + 256 + s) * 2 + hk) * 64 : p.kgqa_ctx + ((size_t)(b * 256 + s) * 2 + hk) * 64) + d0;
                        st8(dst, v[0]); st8(dst + 32, v[1]);
                    }
                } else if (cb < 1280) {
                    const int hk = (cb - 1152) >> 6;
                    if (!den) { float* o = p.out + OFF_GV + ((size_t)(((b * 2 + l) * 256 + s) * 2 + hk)) * 64 + d0; st8f(o, v[0]); st8f(o + 32, v[1]); }
                    bf16_t* dst = den ? p.vtgqa_den + ((size_t)((l * 2 + b) * 2 + hk) * 64 + d0) * 2304 + 256 + s : p.vtgqa_ctx + ((size_t)(b * 2 + hk) * 64 + d0) * 256 + s;
                    const size_t ld = den ? 2304 : 256;
#pragma unroll
                    for (int bj = 0; bj < 2; ++bj)
#pragma unroll
                        for (int z = 0; z < 8; ++z) dst[(size_t)(32 * bj + z) * ld] = to_bf16(v[bj][z]);
                } else if (cb < 1536) {
                    bf16_t* dst = p.u + (size_t)T * 256 + (cb - 1280) + d0; st8(dst, v[0]); st8(dst + 32, v[1]);
                } else {
                    if (!den) {
                        st8f(p.out + OFF_KROPE + ((size_t)((b * 2 + l) * 256 + s)) * 32 + d0, v[0]);
                    } else {
                        float xp[8];
#pragma unroll
                        for (int z = 0; z < 8; ++z) xp[z] = __shfl_xor(v[0][z], 32);
                        const int pbase = (fq & 1) * 8;
                        const f32x2* rp = p.rope_m + s * 16 + pbase;
#pragma unroll
                        for (int z = 0; z < 8; ++z) { const f32x2 cs = rp[z]; v[0][z] = fq < 2 ? v[0][z] * cs.x - xp[z] * cs.y : v[0][z] * cs.x + xp[z] * cs.y; }
                    }
                    bf16_t* dst = (den ? p.kmla_den + ((size_t)((l * 2 + b) * 2304 + 256 + s) * 6) * 96 : p.kmla_ctx + ((size_t)(b * 256 + s) * 6) * 96) + 64 + d0;
#pragma unroll
                    for (int hh = 0; hh < 6; ++hh) st8(dst + hh * 96, v[0]);
                }
            }
    }
};
DI void phase_win(KPR p, KP pp, int l, char* lds) {
    pg8::Gemm g; g.A = p.h; g.Bt = p.wt_in + l * SZ_WIN; g.M = NTOK; g.N = NINP; g.K = D;
    pg8::XcdOrder S; S.nN = 7; S.x = lbid() & 7; S.j = lbid() >> 3; S.step = (int)(gridDim.x >> 3);
    EpiWin E; E.pp = pp; E.l = l; E.lrs = nullptr; E.lbias = nullptr;
    {
        f32x2* rR = (f32x2*)(lds + 131072 + 2048); f32x2* rC = rR + 512;
        for (int i = ltid(); i < 1536; i += 512) { if (i < 512) rR[i] = p.rope_g[(size_t)((i >> 4) * 64) * 32 + (i & 15)]; else { const int q = i - 512; rC[q] = p.rope_g[(size_t)(q >> 4) * 32 + 16 + (q & 15)]; } }
        E.ropeR = rR; E.ropeC = rC;
        if (l != 1) __syncthreads();
    }
    if (l == 1) {
        float* lrs = (float*)(lds + 131072); float* lbias = lrs + 256;
        const int tid = ltid(), pm = 4 * S.x + (S.j & 3), jmod = pm < 16 ? 0 : 1 + ((pm - 16) >> 3);
        if (tid < 256) {
            const float* sp = p.ssq_x + (size_t)(pm * 256 + tid) * 8; const f32x4 a = *(const f32x4*)sp, b = *(const f32x4*)(sp + 4);
            lrs[tid] = rsqrtf((((a.x + a.y) + (a.z + a.w)) + ((b.x + b.y) + (b.z + b.w))) * (1.f / 1024.f) + EPS);
        } else if (S.j < 28) lbias[tid - 256] = p.bias_in[(size_t)jmod * 1792 + (S.j >> 2) * 256 + (tid - 256)];
        __syncthreads();
        E.lrs = lrs; E.lbias = lbias;
    }
    pg8::gemm_phase<EpiWin, pg8::XcdOrder>((PG8_LAS unsigned char*)lds, g, S, E, nullptr);
    __syncthreads();
}

DI void phase_mid(KPR p, int l, char* lds, bool rep = false) {
    float* h_ssq_q = p.ssq_q;
    float* h_ssq_kv = p.ssq_kv;
    f32x2* h_rope_m = p.rope_m;
    bf16_t* h_qmla = p.qmla;
    bf16_t* h_kmla_ctx = p.kmla_ctx;
    bf16_t* h_kmla_den = p.kmla_den;
    bf16_t* h_vtmla_ctx = p.vtmla_ctx;
    bf16_t* h_vtmla_den = p.vtmla_den;
    bf16_t* h_zt_ctx = p.zt_ctx;
    bf16_t* h_zt_den = p.zt_den;
    float* h_out = p.out;
    const float* h_g_kv_a = p.g_kv_a;
    bf16_t* h_ckv = p.ckv;
    bf16_t* h_ckv_cache = p.ckv_cache;
    bf16_t* h_wt_kvg = p.wt_kvg;
    bf16_t* h_wt_kvp = p.wt_kvp;
    bf16_t* h_cq = p.cq;
    bf16_t* h_wt_qup = p.wt_qup;
    bf16_t* h_u = p.u;
    bf16_t* h_bt_ch = p.bt_ch;

    const int tid = ltid(), lane = tid & 63, wid = tid >> 6, wr = wid >> 1, wc = wid & 1, r = lane & 31, h = lane >> 5;
    for (int t = lbid(); t < 492; t += gridDim.x) {
        f32x16 acc[2][2];
        if (t < 160) {
            const int m = t / 5, n = t % 5;
            gemm_tile3<2>(h_cq + (size_t)m * 256 * 384, 384, h_wt_qup + l * SZ_QUP + (size_t)n * 128 * 384, 384, 384, lds, acc);
            const int cb = n * 128 + wc * 64;
#pragma unroll
            for (int i = 0; i < 2; ++i) {
                const int T = m * 256 + wr * 64 + i * 32 + r; const bool den = T >= NCTX; const int s = (T - NCTX) & 2047;
                float ss = 0.f;
#pragma unroll
                for (int k = 0; k < 6; ++k) ss += h_ssq_q[T * 6 + k];
                const float rs = rsqrtf(ss * (1.f / 384.f) + EPS) * (0.10206207261596575f * LOG2E);
#pragma unroll
                for (int j = 0; j < 2; ++j) {
                    const int ct = (cb >> 5) + j; if (ct >= 18) continue;
                    f32x16 v;
#pragma unroll
                    for (int e = 0; e < 16; ++e) v[e] = acc[i][j][e] * rs;
                    if ((ct % 3) == 2 && den) {
#pragma unroll
                        for (int e = 0; e < 8; ++e) { const f32x2 cs = h_rope_m[s * 16 + crow(e, h)]; float x1 = v[e], x2 = v[e + 8]; rope_pair(x1, x2, cs); v[e] = x1; v[e + 8] = x2; }
                    }
                    st_bf16_tile(h_qmla + (size_t)T * 576 + ct * 32, v, h);
                }
            }
        } else if (t < 364) {
            const int tt = t - 160, mt = tt / 6, hd = tt % 6;
            const bf16_t* A; const bf16_t* W; int kind, b = 0, s0 = 0, T0 = 0;
            if (mt < 32) { T0 = mt * 256; A = h_ckv + (size_t)T0 * 256; W = h_wt_kvg; kind = mt < 16 ? 0 : 1; if (kind == 0) { b = T0 >> 8; s0 = 0; } else { b = (T0 - NCTX) >> 11; s0 = 256 + ((T0 - NCTX) & 2047); } }
            else { b = mt - 32; s0 = 0; A = h_ckv_cache + ((size_t)(b * 2 + l) * 256) * 256; W = h_wt_kvp; kind = 2; }
            if (wc == 1) gemm_tile3<2, true>(A, 256, W + l * SZ_KV + (size_t)hd * 128 * 256, 256, 256, lds, acc);
            else gemm_tile3<2, false>(A, 256, W + l * SZ_KV + (size_t)hd * 128 * 256, 256, 256, lds, acc);
#pragma unroll
            for (int i = 0; i < 2; ++i) {
                const int ro = wr * 64 + i * 32 + r; float rs = 1.f;
                if (kind < 2) { const int T = T0 + ro; const float ss = h_ssq_kv[T * 4] + h_ssq_kv[T * 4 + 1] + h_ssq_kv[T * 4 + 2] + h_ssq_kv[T * 4 + 3]; rs = rsqrtf(ss * (1.f / 256.f) + EPS); }
                const int key = s0 + ro;
                f32x16 v0, v1;
                if (wc == 0) {
#pragma unroll
                    for (int e = 0; e < 16; ++e) { v0[e] = acc[i][0][e] * rs; v1[e] = acc[i][1][e] * rs; }
                    bf16_t* dst = kind == 0 ? h_kmla_ctx + ((size_t)(b * 256 + key) * 6 + hd) * 96 : h_kmla_den + ((size_t)((l * 2 + b) * 2304 + key) * 6 + hd) * 96;
                    st_bf16_tile(dst, v0, h); st_bf16_tile(dst + 32, v1, h);
                } else {
#pragma unroll
                    for (int e = 0; e < 16; ++e) { const float rse = __shfl(rs, crow(e, h)); v0[e] = acc[i][0][e] * rse; v1[e] = acc[i][1][e] * rse; }
                    const int kb = s0 + wr * 64 + i * 32;
                    if (kind == 0) { bf16_t* dst = h_vtmla_ctx + ((size_t)(b * 6 + hd) * 64 + r) * 256 + kb; st_bf16_tile_S(dst, v0, h); st_bf16_tile_S(dst + 32 * 256, v1, h); }
                    else { bf16_t* dst = h_vtmla_den + ((size_t)((l * 2 + b) * 6 + hd) * 64 + r) * 2304 + kb; st_bf16_tile_S(dst, v0, h); st_bf16_tile_S(dst + 32 * 2304, v1, h); }
                }
            }
        } else {
            const int tt = t - 364, m = tt >> 2, g = tt & 3;
            gemm_tile3<2, true>(h_u + (size_t)m * 256 * 256 + g * 64, 256, h_bt_ch, 64, 64, lds, acc);
#pragma unroll
            for (int i = 0; i < 2; ++i) {
                const int T = m * 256 + wr * 64 + i * 32; const bool den = T >= NCTX;
#pragma unroll
                for (int j = 0; j < 2; ++j) {
                    const int c = g * 64 + j * 32 + r;
                    if (!den) { const int b = T >> 8, s = T & 255; st_bf16_tile_S(h_zt_ctx + ((size_t)(b * 256 + c)) * 512 + wc * 256 + s, acc[i][j], h); }
                    else { const int b = (T - NCTX) >> 11, s = (T - NCTX) & 2047; st_bf16_tile_S(h_zt_den + ((size_t)(b * 256 + c)) * 4096 + wc * 2048 + s, acc[i][j], h); }
                }
            }
        }
    }
    if (!rep)
    for (int i = lbid() * 512 + tid; i < NCTX * 64; i += gridDim.x * 512) {
        const int T = i >> 6, c = (i & 63) * 4, b = T >> 8, s = T & 255;
        const float ss = h_ssq_kv[T * 4] + h_ssq_kv[T * 4 + 1] + h_ssq_kv[T * 4 + 2] + h_ssq_kv[T * 4 + 3]; const float rs = rsqrtf(ss * (1.f / 256.f) + EPS);
        float* o = h_out + OFF_CKV + ((size_t)((b * 2 + l) * 256 + s)) * 256 + c; f32x4 v = *(f32x4*)o; const f32x4 g = *(const f32x4*)(h_g_kv_a + l * 256 + c);
        v.x *= rs * g.x; v.y *= rs * g.y; v.z *= rs * g.z; v.w *= rs * g.w; *(f32x4*)o = v;
    }
}

template <int DQK>
DI void attn_item(const bf16_t* __restrict__ Q, int ldq, const bf16_t* __restrict__ Kp, int ldk, const bf16_t* __restrict__ Vt, int ldv, int Sk, bf16_t* O, int ldo, char* lds) {
    constexpr int KSTR = DQK * 2 + 16, VSTR = 136, KBYTES = 64 * KSTR, STAGE = KBYTES + 64 * VSTR, KCH = DQK / 8;
    int tid = ltid();
    const int lane = tid & 63, w = tid >> 6, r = lane & 31, h = lane >> 5;
    bf16x8 qf[DQK / 16];
#pragma unroll
    for (int ks = 0; ks < DQK / 16; ++ks) qf[ks] = *(const bf16x8*)(Q + (size_t)(w * 32 + r) * ldq + ks * 16 + h * 8);
    f32x16 oacc[2];
#pragma unroll
    for (int e = 0; e < 16; ++e) { oacc[0][e] = 0.f; oacc[1][e] = 0.f; }
    float mrun = -INFINITY, lrun = 0.f;
    u32x4 rk[2], rv;
    const bool k2 = (DQK == 96) && tid < 256;
    const int kr0 = tid / KCH, kc0 = tid % KCH, kr1 = (tid + 512) / KCH, kc1 = (tid + 512) % KCH;
    const int vrow = tid >> 3, vch = tid & 7;
    auto gload = [&](int kt) {
        rk[0] = *(const u32x4*)(Kp + (size_t)(kt * 64 + kr0) * ldk + kc0 * 8);
        if (k2) rk[1] = *(const u32x4*)(Kp + (size_t)(kt * 64 + kr1) * ldk + kc1 * 8);
        rv = *(const u32x4*)(Vt + (size_t)vrow * ldv + kt * 64 + vch * 8);
    };
    auto lstore = [&](int buf) {
        char* base = lds + buf * STAGE;
        *(u32x4*)(base + kr0 * KSTR + kc0 * 16) = rk[0];
        if (k2) *(u32x4*)(base + kr1 * KSTR + kc1 * 16) = rk[1];
        char* d = base + KBYTES + vrow * VSTR + vch * 16; u32x2 lo = {rv.x, rv.y}, hi = {rv.z, rv.w}; *(u32x2*)d = lo; *(u32x2*)(d + 8) = hi;
    };
    gload(0); lstore(0); __syncthreads();
    const int nkt = Sk >> 6;
    for (int kt = 0; kt < nkt; ++kt) {
        const char* kb = lds + (kt & 1) * STAGE; const char* vb = kb + KBYTES;
        if (kt + 1 < nkt) gload(kt + 1);
        f32x16 sacc[2];
        {
            bf16x8 kf[2][DQK / 16];
#pragma unroll
            for (int sub = 0; sub < 2; ++sub)
#pragma unroll
                for (int ks = 0; ks < DQK / 16; ++ks) kf[sub][ks] = *(const bf16x8*)(kb + (sub * 32 + r) * KSTR + (ks * 2 + h) * 16);
            __builtin_amdgcn_s_setprio(1);
#pragma unroll
            for (int sub = 0; sub < 2; ++sub) {
#pragma unroll
                for (int e = 0; e < 16; ++e) sacc[sub][e] = 0.f;
#pragma unroll
                for (int ks = 0; ks < DQK / 16; ++ks) sacc[sub] = MFMA(kf[sub][ks], qf[ks], sacc[sub]);
            }
        }
        __builtin_amdgcn_s_setprio(0);
        __builtin_amdgcn_sched_barrier(0);
        s16x4 vlo[2][4], vhi[2][4];
#pragma unroll
        for (int g = 0; g < 4; ++g)
#pragma unroll
            for (int dvt = 0; dvt < 2; ++dvt) {
                const char* va = vb + (dvt * 32 + r) * VSTR + (g * 16 + 4 * h) * 2;
                vlo[dvt][g] = *(const s16x4*)va; vhi[dvt][g] = *(const s16x4*)(va + 16);
            }
        float mx;
        {
            float m0 = fmaxf(fmaxf(sacc[0][0], sacc[0][1]), sacc[0][2]), m1 = fmaxf(fmaxf(sacc[1][0], sacc[1][1]), sacc[1][2]);
#pragma unroll
            for (int e = 3; e < 15; e += 2) { m0 = fmaxf(fmaxf(m0, sacc[0][e]), sacc[0][e + 1]); m1 = fmaxf(fmaxf(m1, sacc[1][e]), sacc[1][e + 1]); }
            mx = fmaxf(fmaxf(m0, m1), fmaxf(sacc[0][15], sacc[1][15]));
        }
        mx = fmaxf(mx, __shfl_xor(mx, 32));
        if (__builtin_amdgcn_ballot_w64(mx - mrun > 64.f) != 0ull) {
            const float mnew = fmaxf(mrun, mx);
            const float alpha = __builtin_amdgcn_exp2f(mrun - mnew);
            mrun = mnew; lrun *= alpha;
#pragma unroll
            for (int e = 0; e < 16; ++e) { oacc[0][e] *= alpha; oacc[1][e] *= alpha; }
        }
        {
            const f32x2 mm = {mrun, mrun}; f32x2 ps = {0.f, 0.f};
#pragma unroll
            for (int sub = 0; sub < 2; ++sub)
#pragma unroll
                for (int e = 0; e < 16; e += 2) {
                    f32x2 d = {sacc[sub][e], sacc[sub][e + 1]}; d = d - mm;
                    f32x2 pv = {__builtin_amdgcn_exp2f(d.x), __builtin_amdgcn_exp2f(d.y)};
                    sacc[sub][e] = pv.x; sacc[sub][e + 1] = pv.y; ps = ps + pv;
                }
            lrun += ps.x + ps.y;
        }
#pragma unroll
        for (int sub = 0; sub < 2; ++sub)
#pragma unroll
            for (int s2 = 0; s2 < 2; ++s2) {
                u32x4 pw; pw.x = pk_bf16(sacc[sub][8 * s2 + 0], sacc[sub][8 * s2 + 1]); pw.y = pk_bf16(sacc[sub][8 * s2 + 2], sacc[sub][8 * s2 + 3]);
                pw.z = pk_bf16(sacc[sub][8 * s2 + 4], sacc[sub][8 * s2 + 5]); pw.w = pk_bf16(sacc[sub][8 * s2 + 6], sacc[sub][8 * s2 + 7]);
                const bf16x8 pf = __builtin_bit_cast(bf16x8, pw);
#pragma unroll
                for (int dvt = 0; dvt < 2; ++dvt) {
                    const bf16x8 vf = __builtin_shufflevector(vlo[dvt][sub * 2 + s2], vhi[dvt][sub * 2 + s2], 0, 1, 2, 3, 4, 5, 6, 7);
                    oacc[dvt] = MFMA(vf, pf, oacc[dvt]);
                }
            }
        __builtin_amdgcn_sched_barrier(0);
        if (kt + 1 < nkt) lstore((kt + 1) & 1);
        __syncthreads();
    }
    lrun += __shfl_xor(lrun, 32);
    const float inv = 1.f / lrun;
#pragma unroll
    for (int dvt = 0; dvt < 2; ++dvt) {
        f32x16 v;
#pragma unroll
        for (int e = 0; e < 16; ++e) v[e] = oacc[dvt][e] * inv;
        st_bf16_tile(O + (size_t)(w * 32 + r) * ldo + dvt * 32, v, h);
    }
}

DI void phase_mix(KPR p, int l, char* lds, unsigned* ctr) {
    const int tid = ltid(), lane = tid & 63, wid = tid >> 6, wr = wid >> 1, wc = wid & 1, r = lane & 31, h = lane >> 5;
    __shared__ unsigned sitem_s; volatile unsigned* sitem = &sitem_s;
    for (;;) {
        __syncthreads();
        if (tid == 0) *sitem = atomicAdd(ctr, 1u);
        __syncthreads();
        const int it = (int)*sitem;
        if (it >= 480) break;
        if (it < 64) {
            f32x16 acc[1][2];
            const int b = it >> 5, m = (it >> 2) & 7, n = it & 3;
            gemm_tile3<1>(p.tab2048 + (size_t)m * 256 * 4096, 4096, p.zt_den + ((size_t)(b * 256 + n * 64)) * 4096, 4096, 4096, lds, acc);
            const int T = NCTX + b * 2048 + m * 256 + wid * 32 + r;
            bf16_t* dst = p.mix + (size_t)T * D + 384 + n * 64;
            st_bf16_tile(dst, acc[0][0], h); st_bf16_tile(dst + 32, acc[0][1], h);
        } else if (it >= 256 && it < 288) {
            f32x16 acc[2][2];
            const int q = it - 256, b = q >> 1, n = q & 1;
            gemm_tile3<2>(p.tab256, 512, p.zt_ctx + ((size_t)(b * 256 + n * 128)) * 512, 512, 512, lds, acc);
#pragma unroll
            for (int i = 0; i < 2; ++i) {
                const int T = b * 256 + wr * 64 + i * 32 + r;
                bf16_t* dst = p.mix + (size_t)T * D + 384 + n * 128 + wc * 64;
                st_bf16_tile(dst, acc[i][0], h); st_bf16_tile(dst + 32, acc[i][1], h);
            }
        } else {
            int b, hd, qb, den;
            if (it < 256) { const int q = it - 64; den = 1; qb = q & 7; hd = (q >> 3) % 12; b = q / 96; } else { const int q = it - 288; den = 0; qb = 0; hd = q % 12; b = q / 12; }
            const int T0 = den ? NCTX + b * 2048 + qb * 256 : b * 256;
            const int Sk = den ? 2304 : 256;
            if (hd < 6) {
                const bf16_t* K = den ? p.kmla_den + ((size_t)(l * 2 + b) * 2304 * 6 + hd) * 96 : p.kmla_ctx + ((size_t)b * 256 * 6 + hd) * 96;
                const bf16_t* V = den ? p.vtmla_den + ((size_t)((l * 2 + b) * 6 + hd) * 64) * 2304 : p.vtmla_ctx + ((size_t)(b * 6 + hd) * 64) * 256;
                attn_item<96>(p.qmla + (size_t)T0 * 576 + hd * 96, 576, K, 576, V, Sk, Sk, p.mix + (size_t)T0 * D + hd * 64, D, lds);
            } else {
                const int hq = hd - 6, hk = hq / 3;
                const bf16_t* K = den ? p.kgqa_den + ((size_t)(l * 2 + b) * 2304 * 2 + hk) * 64 : p.kgqa_ctx + ((size_t)b * 256 * 2 + hk) * 64;
                const bf16_t* V = den ? p.vtgqa_den + ((size_t)((l * 2 + b) * 2 + hk) * 64) * 2304 : p.vtgqa_ctx + ((size_t)(b * 2 + hk) * 64) * 256;
                attn_item<64>(p.gq + (size_t)T0 * 384 + hq * 64, 384, K, 128, V, Sk, Sk, p.mix + (size_t)T0 * D + 640 + hq * 64, D, lds);
            }
        }
    }
}

DI void phase_resid(KPR p, const bf16_t* A, int K, const bf16_t* W, const float* xc, const float* xd, float* xout, const float* gate, const float* gs_g, const float* gs_scale, char* lds) {
    bf16_t* h_h = p.h;
    float* h_ssq_x = p.ssq_x;

    const int tid = ltid(), lane = tid & 63, wid = tid >> 6, wr = wid >> 1, wc = wid & 1, r = lane & 31, h = lane >> 5;
    const int col4 = (tid & 31) * 4, row0 = tid >> 5;
    float* ft = (float*)lds;
    FOR_TILES_32M(8, m, n) {
        f32x16 acc[2][2];
        const int Tt = m * 256;
        const float* xbase = (Tt < NCTX ? xc + (size_t)Tt * D : xd + (size_t)(Tt - NCTX) * D) + n * 128 + col4;
        const float* gj = gate + (Tt < NCTX ? 0 : 1 + ((Tt - NCTX) >> 11)) * 6144 + n * 128 + col4;
        f32x4 xpre[16];
#pragma unroll
        for (int k = 0; k < 16; ++k) xpre[k] = *(const f32x4*)(xbase + (size_t)(row0 + 16 * k) * D);
        gemm_tile3<2>(A + (size_t)m * 256 * K, K, W + (size_t)n * 128 * K, K, K, lds, acc);
#pragma unroll
        for (int i = 0; i < 2; ++i)
#pragma unroll
            for (int j = 0; j < 2; ++j)
#pragma unroll
                for (int q = 0; q < 4; ++q) {
                    f32x4 v = {acc[i][j][4 * q], acc[i][j][4 * q + 1], acc[i][j][4 * q + 2], acc[i][j][4 * q + 3]};
                    *(f32x4*)(ft + (wr * 64 + i * 32 + r) * 132 + wc * 64 + j * 32 + 8 * q + 4 * h) = v;
                }
        __syncthreads();
        const f32x4 gv = *(const f32x4*)gj;
        float* obase = xout + (size_t)Tt * D + n * 128 + col4;
        f32x4 gsv = {0.f, 0.f, 0.f, 0.f};
        if (gs_g) { const f32x4 gg = *(const f32x4*)(gs_g + n * 128 + col4), sc = *(const f32x4*)(gs_scale + (gj - gate) ); gsv = (f32x4){gg.x * (1.f + sc.x), gg.y * (1.f + sc.y), gg.z * (1.f + sc.z), gg.w * (1.f + sc.w)}; }
#pragma unroll
        for (int k = 0; k < 16; ++k) {
            const int row = row0 + 16 * k;
            const f32x4 v = *(const f32x4*)(ft + row * 132 + col4), xv = xpre[k];
            f32x4 o = {xv.x + gv.x * v.x, xv.y + gv.y * v.y, xv.z + gv.z * v.z, xv.w + gv.w * v.w};
            *(f32x4*)(obase + (size_t)row * D) = o;
            if (gs_g) {
                u32x2 w; w.x = pk_bf16(o.x * gsv.x, o.y * gsv.y); w.y = pk_bf16(o.z * gsv.z, o.w * gsv.w);
                *(u32x2*)(h_h + (size_t)(Tt + row) * D + n * 128 + col4) = w;
                float ss = (o.x * o.x + o.y * o.y) + (o.z * o.z + o.w * o.w);
                ss += __shfl_xor(ss, 1); ss += __shfl_xor(ss, 2); ss += __shfl_xor(ss, 4); ss += __shfl_xor(ss, 8); ss += __shfl_xor(ss, 16);
                if ((tid & 31) == 0) h_ssq_x[(Tt + row) * 8 + n] = ss;
            }
        }
        __syncthreads();
    }
}
struct EpiGu {
    static constexpr bool PERM = false, AFTER_DRAIN = false;
    bf16_t* hid; const float* lrs; const float* lbias; int j;
    DI void operator()(const pg8::f32x4 (&acc)[2][2][4][2], const pg8::Unit& u, int wr, int wc, int fr, int fq) const {
        const int ui = (u.pn * 4 + (j & 3) - j) >> 5;
        const float* bi = lbias + ui * 256 + wc * 32 + fq * 4;
        pg8::f32x4 bv[2][2];
#pragma unroll
        for (int bj = 0; bj < 2; ++bj)
#pragma unroll
            for (int n = 0; n < 2; ++n) bv[bj][n] = *(const pg8::f32x4*)(bi + bj * 128 + n * 16);
#pragma unroll
        for (int ai = 0; ai < 2; ++ai)
#pragma unroll
            for (int m = 0; m < 4; ++m) {
                const int rl = ai * 128 + wr * 64 + m * 16 + fr;
                const int T = u.pm * 256 + rl;
                const float rs = lrs[rl];
#pragma unroll
                for (int bj = 0; bj < 2; ++bj) {
                    const int hc = u.pn * 128 + bj * 64 + wc * 16 + fq * 4;
                    const pg8::f32x4 g = acc[ai][bj][m][0] * rs + bv[bj][0], up = acc[ai][bj][m][1] * rs + bv[bj][1];
                    u32x2 w; w.x = pk_bf16(silu(g[0]) * up[0], silu(g[1]) * up[1]); w.y = pk_bf16(silu(g[2]) * up[2], silu(g[3]) * up[3]);
                    *(u32x2*)(hid + (size_t)T * DFF + hc) = w;
                }
            }
    }
};
DI void phase_gu(KPR p, int l, char* lds) {
    pg8::Gemm g; g.A = p.h; g.Bt = p.wt_gu + l * SZ_GU; g.M = NTOK; g.N = 5632; g.K = D;
    pg8::XcdOrder S; S.nN = 22; S.x = lbid() & 7; S.j = lbid() >> 3; S.step = (int)(gridDim.x >> 3);
    float* lrs = (float*)(lds + 131072); float* lbias = lrs + 256;
    {
        const int tid = ltid(), pm = 4 * S.x + (S.j & 3), jmod = pm < 16 ? 0 : 1 + ((pm - 16) >> 3);
        if (tid < 256) {
            const float* sp = p.ssq_x + (size_t)(pm * 256 + tid) * 8; const f32x4 a = *(const f32x4*)sp, b = *(const f32x4*)(sp + 4);
            lrs[tid] = rsqrtf((((a.x + a.y) + (a.z + a.w)) + ((b.x + b.y) + (b.z + b.w))) * (1.f / 1024.f) + EPS);
        } else {
            const int c = tid - 256;
#pragma unroll
            for (int i = 0; i < 3; ++i) { const int lid = S.j + i * S.step; if (lid < 88) lbias[i * 256 + c] = p.bias_gu[(size_t)(l * 3 + jmod) * 5632 + (lid >> 2) * 256 + c]; }
        }
        __syncthreads();
    }
    EpiGu E; E.hid = p.hid; E.lrs = lrs; E.lbias = lbias; E.j = S.j;
    pg8::gemm_phase<EpiGu, pg8::XcdOrder>((PG8_LAS unsigned char*)lds, g, S, E, nullptr);
    __syncthreads();
}

constexpr int NPHASE = 15;
template <int PM>
__global__ void __launch_bounds__(512, 2) fwd_megakernel(P p_arg) {
    KP kp0 = (KP)__builtin_amdgcn_kernarg_segment_ptr();
    __shared__ __attribute__((aligned(16))) char lds[147456];
    __shared__ uint4 xbw;
    if (kp0->never) cg::this_grid().sync();
    if (threadIdx.x == 0) xbw = make_uint4(0u, 0u, 0u, 0u);
    __syncthreads();
    XcdBarrier xb;
    if (!MULTI_LAUNCH) xb = xcd_barrier_post(kp0->bar, (volatile LAS unsigned*)&xbw);
    const int ph0 = kp0->ph0, ph1 = kp0->ph1;
    for (int ph = ph0; ph < ph1; ++ph) {
        KP kp = kp0; asm volatile("" : "+s"(kp));
        KPR p = *kp;
        if (ph == 0) { if (PM & 1) phase_prologue(p, lds); }
        else if (ph == 1) { if (PM & 4) phase_norm(p, p.x_prompt, p.x_sample, p.g_norm1, p.mod, 0, 1024, 0); }
        else if (ph == 14) { if (PM & 2) phase_final(p, p.xa); }
        else {
            const int l = (ph - 2) / 6, s = (ph - 2) % 6;
            const float* modl = p.mod + (size_t)l * 3 * 6144;
            const float* xc = l == 0 ? p.x_prompt : p.xa;
            const float* xd = l == 0 ? p.x_sample : p.xa + (size_t)NCTX * D;
            switch (s) {
                case 0: if (PM & 8) phase_win(p, kp, l, lds); break;
                case 1: if (PM & 16) phase_mid(p, l, lds); break;
                case 2: if (PM & 32) phase_mix(p, l, lds, p.ctr + 64 * l); break;
                case 3: if (PM & 64) phase_resid(p, p.mix, D, p.wt_out + l * SZ_WOUT, xc, xd, p.xb, modl + 2048, p.g_norm2 + l * D, modl + 4096, lds); break;
                case 4: if (PM & 128) phase_gu(p, l, lds); break;
                case 5: if (PM & 64) phase_resid(p, p.hid, DFF, p.wt_down + l * SZ_DOWN, p.xb, p.xb + (size_t)NCTX * D, p.xa, modl + 5120,
                                                 l == 0 ? p.g_norm1 + D : nullptr, p.mod + 3 * 6144 + 1024, lds); break;
            }
        }
        if (!MULTI_LAUNCH && ph + 1 < ph1) xcd_barrier(xb);
    }
}

extern "C" void kernel_launch(void* const* d_in, const int* in_sizes, int n_in, void* d_out, int out_size, void* d_ws, size_t ws_size, hipStream_t stream) {
    static int grid_blocks = 0;
    if (!grid_blocks) {
        int dev = 0, cus = 0, per_cu = 0;
        hipGetDevice(&dev);
        hipDeviceGetAttribute(&cus, hipDeviceAttributeMultiprocessorCount, dev);
        hipOccupancyMaxActiveBlocksPerMultiprocessor(&per_cu, fwd_megakernel<(MULTI_LAUNCH ? 32 : FUSEMASK)>, 512, 0);
        if (per_cu > 1) per_cu = 1;
        if (per_cu < 1) per_cu = 1;
        grid_blocks = cus * per_cu;
        grid_blocks &= ~7;
    }
    P p{};
    const float* const* in = (const float* const*)d_in;
    p.x_prompt = in[0]; p.x_sample = in[1]; p.c_ckv = in[2]; p.c_krope = in[3]; p.c_gk = in[4]; p.c_gv = in[5]; p.c = in[6]; p.c_ctx = in[7]; p.w_ada = in[8]; p.b_ada = in[9];
    p.g_norm1 = in[10]; p.g_norm2 = in[11]; p.w_in = in[12]; p.g_q_a = in[13]; p.w_q_up = in[14]; p.g_kv_a = in[15]; p.w_kv_up = in[16]; p.g_q_head = in[17]; p.g_k_head = in[18];
    p.w_out = in[19]; p.w_gate = in[20]; p.w_up = in[21]; p.w_down = in[22]; p.g_final = in[23];
    p.out = (float*)d_out;
    char* ws = (char*)d_ws; size_t off = 0;
    auto alloc = [&](size_t bytes) { char* r = ws + off; off += (bytes + 255) & ~(size_t)255; return r; };
    p.bar = (unsigned*)alloc(XCD_BAR_WORDS * 4); p.ctr = (unsigned*)alloc(1024); p.mod = (float*)alloc(2 * 3 * 6144 * 4);
    const size_t zero_bytes = off;
    p.wt_in = (bf16_t*)alloc(2 * SZ_WIN * 2); p.wt_qup = (bf16_t*)alloc(2 * SZ_QUP * 2); p.wt_kvg = (bf16_t*)alloc(2 * SZ_KV * 2); p.wt_kvp = (bf16_t*)alloc(2 * SZ_KV * 2);
    p.wt_out = (bf16_t*)alloc(2 * SZ_WOUT * 2); p.wt_gu = (bf16_t*)alloc(2 * SZ_GU * 2); p.wt_down = (bf16_t*)alloc(2 * SZ_DOWN * 2);
    p.tab2048 = (bf16_t*)alloc((size_t)2048 * 4096 * 2); p.tab256 = (bf16_t*)alloc(256 * 512 * 2); p.bt_ch = (bf16_t*)alloc(128 * 64 * 2);
    p.rope_g = (f32x2*)alloc(2048 * 32 * 8); p.rope_m = (f32x2*)alloc(2048 * 16 * 8);
    p.ckv_cache = (bf16_t*)alloc(2 * 2 * 256 * 256 * 2);
    p.h = (bf16_t*)alloc((size_t)NTOK * D * 2);
    p.ssq_q = (float*)alloc(NTOK * 6 * 4); p.ssq_kv = (float*)alloc(NTOK * 4 * 4); p.ssq_x = (float*)alloc(NTOK * 16 * 4); p.bias_gu = (float*)alloc(2 * 3 * 5632 * 4); p.bias_in = (float*)alloc(3 * 1792 * 4);
    p.xa = (float*)alloc((size_t)NTOK * D * 4); p.xb = (float*)alloc((size_t)NTOK * D * 4);
    p.kmla_ctx = (bf16_t*)alloc((size_t)16 * 256 * 576 * 2); p.vtmla_ctx = (bf16_t*)alloc((size_t)16 * 6 * 64 * 256 * 2);
    p.kgqa_ctx = (bf16_t*)alloc((size_t)16 * 256 * 128 * 2); p.vtgqa_ctx = (bf16_t*)alloc((size_t)16 * 2 * 64 * 256 * 2);
    p.kmla_den = (bf16_t*)alloc((size_t)4 * 2304 * 576 * 2); p.vtmla_den = (bf16_t*)alloc((size_t)4 * 6 * 64 * 2304 * 2);
    p.kgqa_den = (bf16_t*)alloc((size_t)4 * 2304 * 128 * 2); p.vtgqa_den = (bf16_t*)alloc((size_t)4 * 2 * 64 * 2304 * 2);
    p.zt_ctx = (bf16_t*)alloc((size_t)16 * 256 * 512 * 2); p.zt_den = (bf16_t*)alloc((size_t)2 * 256 * 4096 * 2);
    const size_t ov = off;
    p.cq = (bf16_t*)alloc((size_t)NTOK * 384 * 2); p.ckv = (bf16_t*)alloc((size_t)NTOK * 256 * 2); p.u = (bf16_t*)alloc((size_t)NTOK * 256 * 2);
    p.gq = (bf16_t*)alloc((size_t)NTOK * 384 * 2); p.qmla = (bf16_t*)alloc((size_t)NTOK * 576 * 2); p.mix = (bf16_t*)alloc((size_t)NTOK * D * 2);
    p.hid = (bf16_t*)(ws + ov);
    if (off - ov < (size_t)NTOK * DFF * 2) off = ov + (size_t)NTOK * DFF * 2;
    if (off > ws_size) { fprintf(stderr, "workspace too small: need %zu have %zu\n", off, ws_size); return; }
    hipMemsetAsync(ws, 0, zero_bytes, stream);
#if MULTI_LAUNCH
    for (int ph = 0; ph < NPHASE; ++ph) {
        P q = p; q.ph0 = ph; q.ph1 = ph + 1;
        const int s = (ph - 1) & 7;
        if (ph == 0) hipLaunchKernelGGL(fwd_megakernel<1>, dim3(grid_blocks), dim3(512), 0, stream, q);
        else if (ph == 17) hipLaunchKernelGGL(fwd_megakernel<2>, dim3(grid_blocks), dim3(512), 0, stream, q);
        else if (s == 0 || s == 5) hipLaunchKernelGGL(fwd_megakernel<4>, dim3(grid_blocks), dim3(512), 0, stream, q);
        else if (s == 1) hipLaunchKernelGGL(fwd_megakernel<8>, dim3(grid_blocks), dim3(512), 0, stream, q);
        else if (s == 2) hipLaunchKernelGGL(fwd_megakernel<16>, dim3(grid_blocks), dim3(512), 0, stream, q);
        else if (s == 3) hipLaunchKernelGGL(fwd_megakernel<32>, dim3(grid_blocks), dim3(512), 0, stream, q);
        else if (s == 4 || s == 7) hipLaunchKernelGGL(fwd_megakernel<64>, dim3(grid_blocks), dim3(512), 0, stream, q);
        else hipLaunchKernelGGL(fwd_megakernel<128>, dim3(grid_blocks), dim3(512), 0, stream, q);
    }
#else
    p.ph0 = 0; p.ph1 = NPHASE;
    void* args[] = {&p};
    hipError_t e = hipLaunchCooperativeKernel((void*)fwd_megakernel<FUSEMASK>, dim3(grid_blocks), dim3(512), args, 0, stream);
    if (e != hipSuccess) fprintf(stderr, "cooperative launch failed: %s (grid %d)\n", hipGetErrorString(e), grid_blocks);
#endif
}
```

```cpp
#include <hip/hip_runtime.h>
#include <hip/hip_cooperative_groups.h>
#include <stdint.h>
#include <stdio.h>
namespace cg = cooperative_groups;

#ifndef FUSEMASK
#define FUSEMASK 0xffff
#endif
#ifndef MULTI_LAUNCH
#define MULTI_LAUNCH 0
#endif

typedef unsigned short bf16_t;
typedef short bf16x8 __attribute__((ext_vector_type(8)));
typedef short s16x4 __attribute__((ext_vector_type(4)));
typedef float f32x16 __attribute__((ext_vector_type(16)));
typedef float f32x4 __attribute__((ext_vector_type(4)));
typedef float f32x2 __attribute__((ext_vector_type(2)));
typedef unsigned u32x4 __attribute__((ext_vector_type(4)));
typedef unsigned u32x2 __attribute__((ext_vector_type(2)));
#define DI __device__ __forceinline__
#define LAS __attribute__((address_space(3)))

constexpr int D = 1024, NTOK = 8192, NCTX = 4096, DFF = 2816;
constexpr int NINP = 1792;
constexpr float EPS = 1e-6f;
constexpr float LOG2E = 1.4426950408889634f;
constexpr size_t OFF_YP = 0, OFF_YS = 4194304, OFF_CKV = 8388608, OFF_KROPE = 10485760, OFF_GK = 10747904, OFF_GV = 11796480;
constexpr size_t SZ_WIN = (size_t)NINP * 1024, SZ_QUP = 640 * 384, SZ_KV = 768 * 256, SZ_WOUT = 1024 * 1024, SZ_GU = (size_t)5632 * 1024, SZ_DOWN = (size_t)1024 * 2816;

struct P {
    const float *x_prompt, *x_sample, *c_ckv, *c_krope, *c_gk, *c_gv, *c, *c_ctx, *w_ada, *b_ada, *g_norm1, *g_norm2, *w_in, *g_q_a, *w_q_up, *g_kv_a,
        *w_kv_up, *g_q_head, *g_k_head, *w_out, *w_gate, *w_up, *w_down, *g_final;
    float* out;
    unsigned* bar;
    unsigned* ctr;
    float* mod;
    bf16_t *wt_in, *wt_qup, *wt_kvg, *wt_kvp, *wt_out, *wt_gu, *wt_down;
    bf16_t *tab2048, *tab256, *bt_ch;
    f32x2 *rope_g, *rope_m;
    bf16_t* ckv_cache;
    bf16_t *h, *cq, *ckv, *u, *gq, *qmla, *mix, *hid;
    float *ssq_q, *ssq_kv, *ssq_x, *bias_gu, *bias_in;
    float *xa, *xb;
    bf16_t *kmla_ctx, *vtmla_ctx, *kgqa_ctx, *vtgqa_ctx;
    bf16_t *kmla_den, *vtmla_den, *kgqa_den, *vtgqa_den;
    bf16_t *zt_ctx, *zt_den;
    int never, ph0, ph1, pad;
};

typedef const volatile __attribute__((address_space(4))) P& KPR;
typedef const volatile __attribute__((address_space(4))) P* KP;
typedef __bf16 nbf16x2 __attribute__((ext_vector_type(2)));
DI unsigned pk_bf16(float lo, float hi) { f32x2 v = {lo, hi}; nbf16x2 b = __builtin_convertvector(v, nbf16x2); return __builtin_bit_cast(unsigned, b); }
DI bf16_t to_bf16(float x) { return (bf16_t)(pk_bf16(x, 0.f) & 0xffffu); }
DI int crow(int e, int h) { return (e & 3) + 8 * (e >> 2) + 4 * h; }
DI int ltid() { int t = threadIdx.x; asm volatile("" : "+v"(t)); return t; }
DI int lbid() { int b = blockIdx.x; asm volatile("" : "+s"(b)); return b; }
DI float silu(float x) { return x * __builtin_amdgcn_rcpf(1.f + __builtin_amdgcn_exp2f(-x * LOG2E)); }
#define MFMA(a, b, c) __builtin_amdgcn_mfma_f32_32x32x16_bf16((a), (b), (c), 0, 0, 0)

#define XB_TMO 128
#define XB_XCNT(j) (256 + 64 * (j))
#define XB_XSUB(j) (1280 + 64 * (j))
#define XB_XGEN(j) (2304 + 64 * (j))
#define XB_TOP 3328
#define XB_TOPGEN 3392
#define XCD_BAR_WORDS 3456
#define XB_SPIN_CAP (1u << 20)
DI unsigned xb_ld(unsigned* p) { return __hip_atomic_load(p, __ATOMIC_RELAXED, __HIP_MEMORY_SCOPE_AGENT); }
DI unsigned xb_add(unsigned* p, unsigned v) { return __hip_atomic_fetch_add(p, v, __ATOMIC_RELAXED, __HIP_MEMORY_SCOPE_AGENT); }
DI unsigned xb_xcc_id() { return (unsigned)__builtin_amdgcn_s_getreg((3 << 11) | 20) & 0xFu; }
#define XB_SPIN(cond, bar)                                                                         \
    do {                                                                                           \
        unsigned _sp = 0;                                                                          \
        while (cond) {                                                                             \
            __builtin_amdgcn_s_sleep(1);                                                           \
            if ((++_sp & 255u) == 0u) {                                                            \
                if (xb_ld(&(bar)[XB_TMO])) break;                                                  \
                if (_sp > XB_SPIN_CAP) { atomicAdd(&(bar)[XB_TMO], 1u); break; }                   \
            }                                                                                      \
        }                                                                                          \
    } while (0)
struct XcdBarrier { unsigned* bar; unsigned x; volatile LAS unsigned* st; };
DI XcdBarrier xcd_barrier_post(unsigned* bar, volatile LAS unsigned* st) {
    XcdBarrier b; b.bar = bar; b.x = xb_xcc_id(); b.st = st;
    if (threadIdx.x == 0) (void)xb_add(&bar[XB_XCNT(b.x)], 1u);
    return b;
}
DI void xcd_barrier_complete(unsigned* bar, unsigned x, unsigned& nloc, unsigned& nx) {
    const unsigned G = gridDim.x * gridDim.y * gridDim.z;
    unsigned sum, cnt, mine, sp = 0u;
    for (;;) {
        sum = 0u; cnt = 0u; mine = 0u;
#pragma unroll
        for (unsigned j = 0; j < 16; ++j) { const unsigned c = xb_ld(&bar[XB_XCNT(j)]); sum += c; cnt += (c > 0u) ? 1u : 0u; mine = (j == x) ? c : mine; }
        if (sum == G) break;
        __builtin_amdgcn_s_sleep(1);
        if ((++sp & 255u) == 0u) { if (xb_ld(&bar[XB_TMO])) break; if (sp > XB_SPIN_CAP) { atomicAdd(&bar[XB_TMO], 1u); break; } }
    }
    nloc = mine > 0u ? mine : 1u; nx = cnt > 0u ? cnt : 1u;
}
DI void xcd_barrier(const XcdBarrier& b) {
    asm volatile("s_waitcnt vmcnt(0)" ::: "memory");
    __syncthreads();
    if (threadIdx.x == 0) {
        unsigned* bar = b.bar;
        __builtin_amdgcn_s_waitcnt(0);
        unsigned nloc = b.st[0], nx = b.st[1];
        if (nloc == 0u) { xcd_barrier_complete(bar, b.x, nloc, nx); b.st[0] = nloc; b.st[1] = nx; }
        const unsigned old = xb_add(&bar[XB_XSUB(b.x)], 1u);
        const unsigned gen = old / nloc;
        if (old + 1u == (gen + 1u) * nloc) {
            __builtin_amdgcn_fence(__ATOMIC_RELEASE, "agent");
            asm volatile("s_waitcnt vmcnt(0)" ::: "memory");
            const unsigned og = xb_add(&bar[XB_TOP], 1u);
            const unsigned tg = og / nx;
            if (og + 1u == (tg + 1u) * nx) xb_add(&bar[XB_TOPGEN], 1u);
            else XB_SPIN(xb_ld(&bar[XB_TOPGEN]) == tg, bar);
            __builtin_amdgcn_fence(__ATOMIC_ACQUIRE, "agent");
            xb_add(&bar[XB_XGEN(b.x)], 1u);
            asm volatile("s_waitcnt vmcnt(0)" ::: "memory");
        } else {
            XB_SPIN(xb_ld(&bar[XB_XGEN(b.x)]) == gen, bar);
            __builtin_amdgcn_fence(__ATOMIC_ACQUIRE, "agent");
            asm volatile("s_waitcnt vmcnt(0)" ::: "memory");
        }
    }
    __syncthreads();
}

DI void glds16(const void* g, unsigned lds_addr) {
    unsigned keep;
    asm volatile("s_mov_b32 %0, m0\n\ts_mov_b32 m0, %2\n\ts_nop 0\n\tglobal_load_lds_dwordx4 %1, off\n\ts_mov_b32 m0, %0" : "=&s"(keep) : "v"(g), "s"(lds_addr) : "memory");
}

namespace pg8 {
#define PG8_LAS __attribute__((address_space(3)))
typedef float f32x4 __attribute__((ext_vector_type(4)));
constexpr int BM = 256, BK = 64, HALF = 128, HTB = HALF * BK * 2, STAGE_BYTES = 8 * HTB;
DI int lds_byte(int r, int c) { const int st = (r >> 4) * 2 + (c >> 5), rr = r & 15, cc = c & 31, ob = rr * 64 + cc * 2; return st * 1024 + (ob ^ (((ob >> 9) & 1) << 5)); }
DI void stage_rc(int b, int& R, int& C) { const int st = b / 1024, sb = b % 1024, swz = sb ^ (((sb >> 9) & 1) << 5); R = (st >> 1) * 16 + swz / 64; C = (st & 1) * 32 + (swz % 64) / 2; }
DI int perm32(int rho) { const int n = rho >> 4, i = rho & 15; return 8 * (i >> 2) + 4 * n + (i & 3); }
struct Unit { int pm, pn; };
struct Gemm { const bf16_t* A; const bf16_t* Bt; int M, N, K; };
struct XcdOrder {
    int nN, x, j, step;
    DI bool next(int i, Unit& u) const { const int lid = j + i * step; if (lid >= 4 * nN) return false; u.pm = 4 * x + (lid & 3); u.pn = lid >> 2; return true; }
    DI void a_ready(const Unit&) const {}
    DI void done(const Unit&) const {}
};
template <class Epi, class Sched, bool STAMP = false>
__device__ __forceinline__ void gemm_phase(PG8_LAS unsigned char* lds, const Gemm g, const Sched& S, const Epi& E, unsigned long long* stamps) {
    const int tid = ltid(), wid = __builtin_amdgcn_readfirstlane(tid >> 6), lane = tid & 63, wr = wid >> 2, wc = wid & 3, fr = lane & 15, fq = lane >> 4;
    const int K = g.K, nt = K / BK;
    int ts_lo = 0, ts_hi = 0, nts = 0; const unsigned long long rt_entry = STAMP ? (unsigned long long)wall_clock64() : 0ull;
#define PG8_STAMP() do { if (STAMP && wid == 0 && nts < 64) { const unsigned long long _c = (unsigned long long)clock64(); \
        ts_lo = (lane == nts) ? (int)(unsigned)_c : ts_lo; ts_hi = (lane == nts) ? (int)(unsigned)(_c >> 32) : ts_hi; ++nts; } } while (0)
    PG8_STAMP();
    unsigned voffA[2], voffB[2];
#pragma unroll
    for (int i = 0; i < 2; ++i) { int R, C; stage_rc(tid * 16 + i * 8192, R, C); const int Rb = Epi::PERM ? ((R & ~31) + perm32(R & 31)) : R;
        voffA[i] = (unsigned)(R * K + C) * 2u; voffB[i] = (unsigned)(Rb * K + C) * 2u; }
    const size_t kstep = (size_t)(BK * 2);
    const size_t hstep = (size_t)HALF * K * 2;
    const size_t tstep = 2 * hstep;
    const unsigned ldsw = (unsigned)wid * 1024u; const unsigned ldsbase = (unsigned)(size_t)lds;
    const int aoff = lds_byte(wr * 64 + fr, fq * 8), boff = lds_byte(wc * 32 + fr, fq * 8);
#define PG8_SA(b, h) (((b) * 2 + (h)) * HTB)
#define PG8_SB(b, h) ((4 + (b) * 2 + (h)) * HTB)
#define PG8_STAGE(bufoff, gbase, voff) do { _Pragma("unroll") for (int _i = 0; _i < 2; ++_i) \
        glds16((const char*)(gbase) + (voff)[_i], ldsbase + (unsigned)(bufoff) + ldsw + _i * 8192u); } while (0)
#define PG8_LDA(dst, b, h) do { _Pragma("unroll") for (int m = 0; m < 4; ++m) _Pragma("unroll") for (int k = 0; k < 2; ++k) dst[m][k] = *(const PG8_LAS bf16x8*)(lds + PG8_SA(b, h) + aoff + m * 2048 + k * 1024); } while (0)
#define PG8_LDB(dst, b, h) do { _Pragma("unroll") for (int n = 0; n < 2; ++n) _Pragma("unroll") for (int k = 0; k < 2; ++k) dst[n][k] = *(const PG8_LAS bf16x8*)(lds + PG8_SB(b, h) + boff + n * 2048 + k * 1024); } while (0)
#define PG8_MMA(ai, bj, At, Bt) do { __builtin_amdgcn_s_setprio(1); _Pragma("unroll") for (int m = 0; m < 4; ++m) _Pragma("unroll") for (int n = 0; n < 2; ++n) _Pragma("unroll") for (int k = 0; k < 2; ++k) \
        acc[ai][bj][m][n] = __builtin_amdgcn_mfma_f32_16x16x32_bf16(Bt[n][k], At[m][k], acc[ai][bj][m][n], 0, 0, 0); __builtin_amdgcn_s_setprio(0); } while (0)
#define PG8_WAIT_V(n) asm volatile("s_waitcnt vmcnt(" #n ")" ::: "memory")
#define PG8_WAIT_L(n) asm volatile("s_waitcnt lgkmcnt(" #n ")" ::: "memory")
#define PG8_BAR __builtin_amdgcn_s_barrier()
#define PG8_SCHED __builtin_amdgcn_sched_barrier(0)
    Unit cur, nxt; int ui = 0;
    if (!S.next(0, cur)) return;
    f32x4 acc[2][2][4][2];
#pragma unroll
    for (int a = 0; a < 2; ++a)
#pragma unroll
        for (int b = 0; b < 2; ++b)
#pragma unroll
            for (int m = 0; m < 4; ++m)
#pragma unroll
                for (int n = 0; n < 2; ++n) acc[a][b][m][n] = (f32x4){0.f, 0.f, 0.f, 0.f};
    bf16x8 At[4][2], B0[2][2], B1[2][2];
    const char* cA = (const char*)g.A + (size_t)cur.pm * tstep; const char* cB = (const char*)g.Bt + (size_t)cur.pn * tstep;
    S.a_ready(cur);
    PG8_STAGE(PG8_SB(0, 0), cB, voffB); PG8_STAGE(PG8_SA(0, 0), cA, voffA); PG8_STAGE(PG8_SB(0, 1), cB + hstep, voffB); PG8_STAGE(PG8_SA(0, 1), cA + hstep, voffA);
    if (wr == 1) PG8_BAR;
    PG8_WAIT_V(4); PG8_BAR;
    PG8_STAGE(PG8_SB(1, 0), cB + kstep, voffB); PG8_STAGE(PG8_SA(1, 0), cA + kstep, voffA); PG8_STAGE(PG8_SB(1, 1), cB + hstep + kstep, voffB);
    PG8_WAIT_V(6); PG8_BAR;
    PG8_STAMP();
    for (;;) {
        const bool has_next = S.next(ui + 1, nxt);
        const char* nA = has_next ? (const char*)g.A + (size_t)nxt.pm * tstep : cA; const char* nB = has_next ? (const char*)g.Bt + (size_t)nxt.pn * tstep : cB;
        for (int t = 0; t < nt; t += 2) {
            const bool last = (t == nt - 2);
            const char* a1 = cA + (size_t)(t + 1) * kstep;
            const char* a2 = last ? nA : cA + (size_t)(t + 2) * kstep; const char* b2 = last ? nB : cB + (size_t)(t + 2) * kstep;
            const char* a3 = a2 + kstep; const char* b3 = b2 + kstep;
            if (last && has_next) S.a_ready(nxt);
            PG8_LDB(B0, 0, 0); PG8_SCHED; PG8_LDA(At, 0, 0); PG8_STAGE(PG8_SA(1, 1), a1 + hstep, voffA);
            PG8_WAIT_L(8); PG8_BAR; PG8_WAIT_L(0); PG8_MMA(0, 0, At, B0); PG8_BAR; PG8_SCHED;
            PG8_LDB(B1, 0, 1); PG8_STAGE(PG8_SB(0, 0), b2, voffB);
            PG8_BAR; PG8_WAIT_L(0); PG8_MMA(0, 1, At, B1); PG8_BAR;
            PG8_LDA(At, 0, 1); PG8_STAGE(PG8_SA(0, 0), a2, voffA);
            PG8_BAR; PG8_WAIT_L(0); PG8_MMA(1, 0, At, B0); PG8_BAR; PG8_SCHED;
            PG8_STAGE(PG8_SB(0, 1), b2 + hstep, voffB);
            PG8_WAIT_V(6); PG8_BAR; PG8_MMA(1, 1, At, B1); PG8_BAR;
            PG8_LDB(B0, 1, 0); PG8_SCHED; PG8_LDA(At, 1, 0); PG8_STAGE(PG8_SA(0, 1), a2 + hstep, voffA);
            PG8_WAIT_L(8); PG8_BAR; PG8_WAIT_L(0); PG8_MMA(0, 0, At, B0); PG8_BAR; PG8_SCHED;
            PG8_LDB(B1, 1, 1); PG8_STAGE(PG8_SB(1, 0), b3, voffB);
            PG8_BAR; PG8_WAIT_L(0); PG8_MMA(0, 1, At, B1); PG8_BAR;
            PG8_LDA(At, 1, 1); PG8_STAGE(PG8_SA(1, 0), a3, voffA);
            PG8_BAR; PG8_WAIT_L(0); PG8_MMA(1, 0, At, B0); PG8_BAR; PG8_SCHED;
            PG8_STAGE(PG8_SB(1, 1), b3 + hstep, voffB);
            PG8_WAIT_V(6); PG8_BAR; PG8_MMA(1, 1, At, B1); PG8_BAR;
        }
        PG8_STAMP();
        if constexpr (!Epi::AFTER_DRAIN) { E(acc, cur, wr, wc, fr, fq); S.done(cur); }
        PG8_STAMP();
        if (!has_next) break;
#pragma unroll
        for (int a = 0; a < 2; ++a)
#pragma unroll
            for (int b = 0; b < 2; ++b)
#pragma unroll
                for (int m = 0; m < 4; ++m)
#pragma unroll
                    for (int n = 0; n < 2; ++n) acc[a][b][m][n] = (f32x4){0.f, 0.f, 0.f, 0.f};
        cur = nxt; cA = nA; cB = nB; ++ui;
    }
    PG8_WAIT_V(0);
    if (wr == 0) PG8_BAR;
    PG8_BAR;
    if constexpr (Epi::AFTER_DRAIN) { E.fused(acc, cur, wr, wc, fr, fq, lds, wid, lane); S.done(cur); }
    PG8_STAMP();
    if (STAMP && wid == 0) { stamps[lane] = lane < nts ? (((unsigned long long)(unsigned)ts_hi << 32) | (unsigned)ts_lo) : 0ull;
        if (lane == 62) stamps[62] = rt_entry; if (lane == 63) stamps[63] = (unsigned long long)wall_clock64(); }
#undef PG8_STAMP
#undef PG8_SA
#undef PG8_SB
#undef PG8_STAGE
#undef PG8_LDA
#undef PG8_LDB
#undef PG8_MMA
#undef PG8_WAIT_V
#undef PG8_WAIT_L
#undef PG8_BAR
#undef PG8_SCHED
}
}

template <int WM>
DI void gemm_tile(const bf16_t* __restrict__ A, int lda, const bf16_t* __restrict__ B, int ldb, int K, char* lds, f32x16 (&acc)[WM][2]) {
    constexpr int NB = WM == 4 ? 4 : (WM == 2 ? 2 : 1);
    int tid = threadIdx.x; asm volatile("" : "+v"(tid));
    const int lane = tid & 63, wid = tid >> 6, r = lane & 31, h = lane >> 5;
    const int wr = WM == 4 ? (wid >> 2) : (WM == 2 ? (wid >> 1) : wid), wc = WM == 4 ? (wid & 3) : (WM == 2 ? (wid & 1) : 0);
#pragma unroll
    for (int i = 0; i < WM; ++i)
#pragma unroll
        for (int j = 0; j < 2; ++j)
#pragma unroll
            for (int e = 0; e < 16; ++e) acc[i][j][e] = 0.f;
    const int lrow = wid * 8 + (lane >> 3);
    const int lkc = (lane & 7) ^ ((lrow >> 1) & 7);
    const bf16_t* ga = A + (size_t)lrow * lda + lkc * 8;
    const bf16_t* gb = B + (size_t)lrow * ldb + lkc * 8;
    LAS char* l3 = (LAS char*)lds;
    const unsigned lbase = (unsigned)(size_t)l3 + (unsigned)__builtin_amdgcn_readfirstlane(wid) * 1024u;
    const int swz = (r >> 1) & 7;
    const int aofs = (wr * (WM * 32) + r) * 128, bofs = 32768 + (wc * 64 + r) * 128;
#define GLDS_TILE(buf, k0)                                                                            \
    _Pragma("unroll") for (int i = 0; i < 4; ++i) glds16(ga + (size_t)i * 64 * lda + (k0), lbase + (buf) + i * 8192);          \
    _Pragma("unroll") for (int i = 0; i < NB; ++i) glds16(gb + (size_t)i * 64 * ldb + (k0), lbase + (buf) + 32768 + i * 8192);
    GLDS_TILE(0, 0)
    asm volatile("s_waitcnt vmcnt(0)" ::: "memory");
    __syncthreads();
    const int nt = K >> 6;
    for (int t = 0; t < nt; ++t) {
        const int cur = (t & 1) * 65536, nxt = 65536 - cur;
        if (t + 1 < nt) { const int k0 = (t + 1) << 6; GLDS_TILE(nxt, k0) }
        bf16x8 af[2][WM], bfr[2][2];
#define LOAD_FRAGS(slot, ks)                                                                                         \
        { const int co = (((ks) * 2 + h) ^ swz) << 4;                                                                \
          _Pragma("unroll") for (int i = 0; i < WM; ++i) af[slot][i] = *(const LAS bf16x8*)(l3 + cur + aofs + i * 4096 + co);   \
          _Pragma("unroll") for (int j = 0; j < 2; ++j) bfr[slot][j] = *(const LAS bf16x8*)(l3 + cur + bofs + j * 4096 + co); }
        LOAD_FRAGS(0, 0)
#pragma unroll
        for (int ks = 0; ks < 4; ++ks) {
            if (ks < 3) LOAD_FRAGS((ks + 1) & 1, ks + 1)
#pragma unroll
            for (int i = 0; i < WM; ++i)
#pragma unroll
                for (int j = 0; j < 2; ++j) acc[i][j] = MFMA(bfr[ks & 1][j], af[ks & 1][i], acc[i][j]);
            __builtin_amdgcn_sched_barrier(0);
        }
#undef LOAD_FRAGS
        asm volatile("s_waitcnt vmcnt(0)" ::: "memory");
        __syncthreads();
    }
#undef GLDS_TILE
}

template <int WM, bool SWAP = false>
DI void gemm_tile3(const bf16_t* __restrict__ A, int lda, const bf16_t* __restrict__ B, int ldb, int K, char* lds, f32x16 (&acc)[WM][2]) {
    static_assert(WM <= 2, "three 64-deep stages only fit for BN <= 128");
    constexpr int NB = WM == 2 ? 2 : 1;
    int tid = ltid();
    const int lane = tid & 63, wid = tid >> 6, r = lane & 31, h = lane >> 5;
    const int wr = WM == 2 ? (wid >> 1) : wid, wc = WM == 2 ? (wid & 1) : 0;
#pragma unroll
    for (int i = 0; i < WM; ++i)
#pragma unroll
        for (int j = 0; j < 2; ++j)
#pragma unroll
            for (int e = 0; e < 16; ++e) acc[i][j][e] = 0.f;
    const int lrow = wid * 8 + (lane >> 3);
    const int lkc = (lane & 7) ^ ((lrow >> 1) & 7);
    const bf16_t* ga = A + (size_t)lrow * lda + lkc * 8;
    const bf16_t* gb = B + (size_t)lrow * ldb + lkc * 8;
    LAS char* l3 = (LAS char*)lds;
    const unsigned lbase = (unsigned)(size_t)l3 + (unsigned)__builtin_amdgcn_readfirstlane(wid) * 1024u;
    const int swz = (r >> 1) & 7;
    const int aofs = (wr * (WM * 32) + r) * 128, bofs = 32768 + (wc * 64 + r) * 128;
#define ISSUE3(buf, k0)                                                                               \
    { _Pragma("unroll") for (int i = 0; i < 4; ++i) glds16(ga + (size_t)i * 64 * lda + (k0), lbase + (buf) + i * 8192);          \
      _Pragma("unroll") for (int i = 0; i < NB; ++i) glds16(gb + (size_t)i * 64 * ldb + (k0), lbase + (buf) + 32768 + i * 8192); }
    const int nt = K >> 6;
    ISSUE3(0, 0)
    if (nt > 1) ISSUE3(49152, 64)
    int cur = 0, nxt2 = 98304;
    for (int t = 0; t < nt; ++t) {
        if (t + 1 < nt) { if (NB == 2) asm volatile("s_waitcnt vmcnt(6)" ::: "memory"); else asm volatile("s_waitcnt vmcnt(5)" ::: "memory"); }
        else asm volatile("s_waitcnt vmcnt(0)" ::: "memory");
        asm volatile("s_waitcnt lgkmcnt(0)" ::: "memory");
        __builtin_amdgcn_s_barrier();
        asm volatile("" ::: "memory");
        if (t + 2 < nt) { const int k0 = (t + 2) << 6; ISSUE3(nxt2, k0) }
        bf16x8 af[2][WM], bfr[2][2];
#define LOAD_FRAGS3(slot, ks)                                                                                         \
        { const int co = (((ks) * 2 + h) ^ swz) << 4;                                                                \
          _Pragma("unroll") for (int i = 0; i < WM; ++i) af[slot][i] = *(const LAS bf16x8*)(l3 + cur + aofs + i * 4096 + co);   \
          _Pragma("unroll") for (int j = 0; j < 2; ++j) bfr[slot][j] = *(const LAS bf16x8*)(l3 + cur + bofs + j * 4096 + co); }
        LOAD_FRAGS3(0, 0)
#pragma unroll
        for (int ks = 0; ks < 4; ++ks) {
            if (ks < 3) LOAD_FRAGS3((ks + 1) & 1, ks + 1)
#pragma unroll
            for (int i = 0; i < WM; ++i)
#pragma unroll
                for (int j = 0; j < 2; ++j) acc[i][j] = SWAP ? MFMA(af[ks & 1][i], bfr[ks & 1][j], acc[i][j]) : MFMA(bfr[ks & 1][j], af[ks & 1][i], acc[i][j]);
            __builtin_amdgcn_sched_barrier(0);
        }
#undef LOAD_FRAGS3
        const int tmp = cur; cur = cur == 98304 ? 0 : cur + 49152; nxt2 = tmp;
    }
#undef ISSUE3
    __syncthreads();
}

DI void st_bf16_tile(bf16_t* dst, const f32x16& v, int h) {
#pragma unroll
    for (int q = 0; q < 4; ++q) {
        u32x2 w; w.x = pk_bf16(v[4 * q], v[4 * q + 1]); w.y = pk_bf16(v[4 * q + 2], v[4 * q + 3]);
        *(u32x2*)(dst + 8 * q + 4 * h) = w;
    }
}
DI void st_f32_tile(float* dst, const f32x16& v, int h) {
#pragma unroll
    for (int q = 0; q < 4; ++q) { f32x4 w = {v[4 * q], v[4 * q + 1], v[4 * q + 2], v[4 * q + 3]}; *(f32x4*)(dst + 8 * q + 4 * h) = w; }
}
DI void st_bf16_tile_T(bf16_t* dst, size_t ld, const f32x16& v, int h) {
#pragma unroll
    for (int e = 0; e < 16; ++e) dst[(size_t)crow(e, h) * ld] = to_bf16(v[e]);
}
DI void st_bf16_tile_S(bf16_t* dst, const f32x16& v, int h) {
#pragma unroll
    for (int q = 0; q < 4; ++q) { u32x2 w; w.x = pk_bf16(v[4 * q], v[4 * q + 1]); w.y = pk_bf16(v[4 * q + 2], v[4 * q + 3]); *(u32x2*)(dst + 8 * q + 4 * h) = w; }
}
DI float sumsq16(const f32x16& v) { float s = 0.f;
#pragma unroll
    for (int e = 0; e < 16; ++e) s += v[e] * v[e];
    return s; }

DI const float* win_src(const float* w, int nd) {
    int sc;
    if (nd < 640) sc = nd; else if (nd < 1024) sc = 928 + (nd - 640); else if (nd < 1152) sc = 1312 + (nd - 1024); else if (nd < 1280) sc = 1440 + (nd - 1152);
    else if (nd < 1536) sc = 672 + (nd - 1280); else if (nd < 1568) sc = 640 + (nd - 1536); else return nullptr;
    return w + sc;
}
DI int win_phys2log(int c) { return (c & ~255) + 64 * ((c >> 5) & 3) + 32 * ((c >> 7) & 1) + (c & 31); }
DI void tr_tile(const float* colp, int nsrc, bf16_t* dst, int K, int k0, int nd0, const float* kscale, float* tile) {
    const int tid = ltid() & 255, tn = tid & 63, tk = tid >> 6;
    float tv[16];
#pragma unroll
    for (int i = 0; i < 16; ++i) tv[i] = colp ? __builtin_nontemporal_load(colp + (size_t)(k0 + tk + 4 * i) * nsrc) : 0.f;
    if (kscale) {
#pragma unroll
        for (int i = 0; i < 16; ++i) tv[i] *= kscale[k0 + tk + 4 * i];
    }
#pragma unroll
    for (int i = 0; i < 16; ++i) tile[(tk + 4 * i) * 65 + tn] = tv[i];
    __syncthreads();
    const int rr = tid >> 2, kq = tid & 3;
    u32x4 o0, o1;
    const float* tp = tile + (kq * 16) * 65 + rr;
    o0.x = pk_bf16(tp[0 * 65], tp[1 * 65]); o0.y = pk_bf16(tp[2 * 65], tp[3 * 65]); o0.z = pk_bf16(tp[4 * 65], tp[5 * 65]); o0.w = pk_bf16(tp[6 * 65], tp[7 * 65]);
    o1.x = pk_bf16(tp[8 * 65], tp[9 * 65]); o1.y = pk_bf16(tp[10 * 65], tp[11 * 65]); o1.z = pk_bf16(tp[12 * 65], tp[13 * 65]); o1.w = pk_bf16(tp[14 * 65], tp[15 * 65]);
    bf16_t* d = dst + (size_t)(nd0 + rr) * K + k0 + kq * 16;
    *(u32x4*)d = o0; *(u32x4*)(d + 8) = o1;
    __syncthreads();
}

DI void phase_prologue(KPR p, char* lds) {
    const int tid = ltid(), bid = lbid(), G = gridDim.x;
    float* tile = (float*)lds;
    for (int task = bid; task < 768; task += G) {
        const int l = task / 384, rem = task % 384, kc = rem / 12, cb = rem % 12;
        if (tid < 96) { const int j = tid >> 5, k = kc * 32 + (tid & 31); const float cv = (j == 0) ? p.c_ctx[k] : p.c[(j - 1) * 1024 + k]; tile[tid] = silu(cv); }
        __syncthreads();
        const int n = cb * 512 + tid;
        const float* w = p.w_ada + ((size_t)l * 1024 + kc * 32) * 6144 + n;
        float s0 = 0.f, s1 = 0.f, s2 = 0.f;
        float wv[32];
#pragma unroll
        for (int k = 0; k < 32; ++k) wv[k] = __builtin_nontemporal_load(w + (size_t)k * 6144);
#pragma unroll
        for (int k = 0; k < 32; ++k) { s0 += tile[k] * wv[k]; s1 += tile[32 + k] * wv[k]; s2 += tile[64 + k] * wv[k]; }
        if (kc == 0) { const float bv = p.b_ada[l * 6144 + n]; s0 += bv; s1 += bv; s2 += bv; }
        float* m = p.mod + (size_t)l * 3 * 6144 + n;
        atomicAdd(m, s0); atomicAdd(m + 6144, s1); atomicAdd(m + 2 * 6144, s2);
        __syncthreads();
    }
    tile = (float*)(lds + (tid >> 8) * 16640);
    for (int pp = bid; pp < 2972; pp += G) {
        const int tt = pp * 2 + (tid >> 8);
        const int l = tt / 2972; int t = tt % 2972;
        const int tn = tid & 63;
        if (t < 448) { const int kt = t / 28, nt = t % 28; const float* w = p.w_in + (size_t)l * 1024 * 1568;
            tr_tile(win_src(w, win_phys2log(nt * 64 + tn)), 1568, p.wt_in + l * SZ_WIN, 1024, kt * 64, nt * 64, nullptr, tile); continue; }
        t -= 448;
        if (t < 60) { const int kt = t / 10, nt = t % 10; const float* w = p.w_q_up + (size_t)l * 384 * 576; const int nd = nt * 64 + tn;
            tr_tile(nd < 576 ? w + nd : nullptr, 576, p.wt_qup + l * SZ_QUP, 384, kt * 64, nt * 64, p.g_q_a + l * 384, tile); continue; }
        t -= 60;
        if (t < 96) { const int var = t / 48; t %= 48; const int kt = t / 12, nt = t % 12; const float* w = p.w_kv_up + (size_t)l * 256 * 768;
            tr_tile(w + nt * 64 + tn, 768, (var ? p.wt_kvp : p.wt_kvg) + l * SZ_KV, 256, kt * 64, nt * 64, var ? nullptr : p.g_kv_a + l * 256, tile); continue; }
        t -= 96;
        if (t < 256) { const int kt = t / 16, nt = t % 16; const float* w = p.w_out + (size_t)l * 1024 * 1024;
            tr_tile(w + nt * 64 + tn, 1024, p.wt_out + l * SZ_WOUT, 1024, kt * 64, nt * 64, nullptr, tile); continue; }
        t -= 256;
        if (t < 1408) { const int kt = t / 88, nt = t % 88; const float* w = ((tn & 31) < 16 ? p.w_gate : p.w_up) + (size_t)l * 1024 * 2816 + (nt * 2 + (tn >> 5)) * 16 + (tn & 15);
            tr_tile(w, 2816, p.wt_gu + l * SZ_GU, 1024, kt * 64, nt * 64, nullptr, tile); continue; }
        t -= 1408;
        { const int kt = t / 16, nt = t % 16; const float* w = p.w_down + (size_t)l * 2816 * 1024;
            tr_tile(w + nt * 64 + tn, 1024, p.wt_down + l * SZ_DOWN, 2816, kt * 64, nt * 64, nullptr, tile); }
    }
    const int gt = bid * 512 + tid, GT = G * 512;
    for (int i = gt; i < 2048 * 512; i += GT) {
        const int pp = i >> 9, k8 = (i & 511) * 8; u32x4 o; unsigned w[4];
#pragma unroll
        for (int e = 0; e < 4; ++e) { float v[2];
#pragma unroll
            for (int z = 0; z < 2; ++z) { const int kq = k8 + 2 * e + z; const int m = (pp * (kq & 2047)) & 2047; const float a = (float)m * (1.f / 1024.f);
                v[z] = (kq < 2048 ? cospif(a) : -sinpif(a)) * 0.022097086912079608f; }
            w[e] = pk_bf16(v[0], v[1]); }
        o.x = w[0]; o.y = w[1]; o.z = w[2]; o.w = w[3];
        *(u32x4*)(p.tab2048 + (size_t)pp * 4096 + k8) = o;
    }
    for (int i = gt; i < 256 * 512; i += GT) { const int pp = i >> 9, kq = i & 511; const int m = (pp * (kq & 255)) & 255; const float a = (float)m * (1.f / 128.f);
        p.tab256[i] = to_bf16((kq < 256 ? cospif(a) : -sinpif(a)) * 0.0625f); }
    for (int i = gt; i < 128 * 64; i += GT) { const int n = i >> 6, k = i & 63; const int m = ((n & 63) * k) & 63; const float a = (float)m * (1.f / 32.f);
        p.bt_ch[i] = to_bf16((n < 64 ? cospif(a) : sinpif(a)) * 0.125f); }
    for (int i = gt; i < 2048 * 32; i += GT) { const int t = i >> 5, pr = i & 31; const float inv = powf(10000.f, -(float)(pr & 15) * (1.f / 16.f));
        const float pos = (float)(pr < 16 ? (t >> 6) : (t & 63)); const float ang = pos * inv; f32x2 cs = {cosf(ang), sinf(ang)}; p.rope_g[i] = cs; }
    for (int i = gt; i < 2048 * 16; i += GT) { const int t = i >> 4, pr = i & 15; const float inv = powf(10000.f, -(float)(pr & 7) * (1.f / 8.f));
        const float pos = (float)(pr < 8 ? (t >> 6) : (t & 63)); const float ang = pos * inv; f32x2 cs = {cosf(ang), sinf(ang)}; p.rope_m[i] = cs; }
    for (int i = gt; i < 2 * 2 * 256 * 256; i += GT) p.ckv_cache[i] = to_bf16(p.c_ckv[i]);
    for (int i = gt; i < 2 * 2 * 256 * 32; i += GT) {
        const int d = i & 31, s = (i >> 5) & 255, l = (i >> 13) & 1, b = i >> 14; const bf16_t v = to_bf16(p.c_krope[i]);
        bf16_t* dst = p.kmla_den + ((size_t)((l * 2 + b) * 2304 + s) * 6) * 96 + 64 + d;
#pragma unroll
        for (int hh = 0; hh < 6; ++hh) dst[hh * 96] = v;
    }
    for (int i = gt; i < 2 * 2 * 256 * 128; i += GT) {
        const int d = i & 63, hk = (i >> 6) & 1, s = (i >> 7) & 255, l = (i >> 15) & 1, b = i >> 16;
        p.kgqa_den[((size_t)((l * 2 + b) * 2304 + s) * 2 + hk) * 64 + d] = to_bf16(p.c_gk[i]);
        p.vtgqa_den[((size_t)((l * 2 + b) * 2 + hk) * 64 + d) * 2304 + s] = to_bf16(p.c_gv[i]);
    }
}

DI void phase_norm(KPR p, const float* xc, const float* xd, const float* g, const float* modl, int shift_off, int scale_off, int bias_l) {
    const int lane = ltid() & 63, gw = lbid() * 8 + (ltid() >> 6), nw = gridDim.x * 8;
    for (int T0 = gw; T0 < NTOK; T0 += 4 * nw) {
        f32x4 v[4][4];
#pragma unroll
        for (int rr = 0; rr < 4; ++rr) {
            const int T = T0 + rr * nw;
            if (T < NTOK) {
                const float* xr = T < NCTX ? xc + (size_t)T * D : xd + (size_t)(T - NCTX) * D;
#pragma unroll
                for (int i = 0; i < 4; ++i) v[rr][i] = __builtin_nontemporal_load((const f32x4*)(xr + lane * 4 + i * 256));
            }
        }
#pragma unroll
        for (int rr = 0; rr < 4; ++rr) {
            const int T = T0 + rr * nw;
            if (T < NTOK) {
                const float* mj = modl + (T < NCTX ? 0 : 1 + ((T - NCTX) >> 11)) * 6144;
                float ss = 0.f;
#pragma unroll
                for (int i = 0; i < 4; ++i) ss += v[rr][i].x * v[rr][i].x + v[rr][i].y * v[rr][i].y + v[rr][i].z * v[rr][i].z + v[rr][i].w * v[rr][i].w;
#pragma unroll
                for (int o = 32; o >= 1; o >>= 1) ss += __shfl_xor(ss, o);
                const float rs = rsqrtf(ss * (1.f / 1024.f) + EPS);
#pragma unroll
                for (int i = 0; i < 4; ++i) {
                    const int c = lane * 4 + i * 256;
                    const f32x4 gg = *(const f32x4*)(g + c), sc = *(const f32x4*)(mj + scale_off + c), sh = *(const f32x4*)(mj + shift_off + c);
                    const f32x4 x = v[rr][i];
                    u32x2 w; w.x = pk_bf16(x.x * rs * gg.x * (1.f + sc.x) + sh.x, x.y * rs * gg.y * (1.f + sc.y) + sh.y);
                    w.y = pk_bf16(x.z * rs * gg.z * (1.f + sc.z) + sh.z, x.w * rs * gg.w * (1.f + sc.w) + sh.w);
                    *(u32x2*)(p.h + (size_t)T * D + c) = w;
                }
            }
        }
    }
    if (bias_l >= 0) {
        for (int rb = gw; rb < 13056; rb += 7 * nw) {
            u32x4 w0[7], w1[7];
#pragma unroll
            for (int rr = 0; rr < 7; ++rr) {
                const int row = rb + rr * nw;
                if (row < 13056) {
                    const bf16_t* wrow = row < 5632 ? p.wt_gu + (size_t)row * D : (row < 11264 ? p.wt_gu + SZ_GU + (size_t)(row - 5632) * D : p.wt_in + SZ_WIN + (size_t)(row - 11264) * D);
                    w0[rr] = *(const u32x4*)(wrow + lane * 16); w1[rr] = *(const u32x4*)(wrow + lane * 16 + 8);
                }
            }
#pragma unroll
            for (int rr = 0; rr < 7; ++rr) {
                const int row = rb + rr * nw;
                if (row < 13056) {
                    const float* sh = row < 5632 ? p.mod + 3072 : (row < 11264 ? p.mod + 3 * 6144 + 3072 : p.mod + 3 * 6144);
                    float wf[16]; const unsigned ww[8] = {w0[rr].x, w0[rr].y, w0[rr].z, w0[rr].w, w1[rr].x, w1[rr].y, w1[rr].z, w1[rr].w};
#pragma unroll
                    for (int e = 0; e < 8; ++e) { wf[2 * e] = __uint_as_float(ww[e] << 16); wf[2 * e + 1] = __uint_as_float(ww[e] & 0xffff0000u); }
                    float a3[3];
#pragma unroll
                    for (int j = 0; j < 3; ++j) {
                        float a = 0.f;
#pragma unroll
                        for (int q = 0; q < 4; ++q) { const f32x4 sv = *(const f32x4*)(sh + j * 6144 + lane * 16 + q * 4); a += sv.x * wf[4 * q] + sv.y * wf[4 * q + 1] + sv.z * wf[4 * q + 2] + sv.w * wf[4 * q + 3]; }
#pragma unroll
                        for (int o = 32; o >= 1; o >>= 1) a += __shfl_xor(a, o);
                        a3[j] = a;
                    }
                    if (lane < 3) {
                        float* dst = row < 5632 ? p.bias_gu + (size_t)lane * 5632 + row : (row < 11264 ? p.bias_gu + (size_t)(3 + lane) * 5632 + (row - 5632) : p.bias_in + (size_t)lane * 1792 + (row - 11264));
                        *dst = lane == 0 ? a3[0] : (lane == 1 ? a3[1] : a3[2]);
                    }
                }
            }
        }
    }
}

DI void phase_final(KPR p, const float* x) {
    const float* h_g_final = p.g_final;
    float* h_out = p.out;

    const int lane = ltid() & 63, gw = lbid() * 8 + (ltid() >> 6), nw = gridDim.x * 8;
    for (int T0 = gw; T0 < NTOK; T0 += 4 * nw) {
        f32x4 v[4][4];
#pragma unroll
        for (int rr = 0; rr < 4; ++rr) {
            const int T = T0 + rr * nw;
            if (T < NTOK) {
#pragma unroll
                for (int i = 0; i < 4; ++i) v[rr][i] = *(const f32x4*)(x + (size_t)T * D + lane * 4 + i * 256);
            }
        }
#pragma unroll
        for (int rr = 0; rr < 4; ++rr) {
            const int T = T0 + rr * nw;
            if (T < NTOK) {
                float ss = 0.f;
#pragma unroll
                for (int i = 0; i < 4; ++i) ss += v[rr][i].x * v[rr][i].x + v[rr][i].y * v[rr][i].y + v[rr][i].z * v[rr][i].z + v[rr][i].w * v[rr][i].w;
#pragma unroll
                for (int o = 32; o >= 1; o >>= 1) ss += __shfl_xor(ss, o);
                const float rs = rsqrtf(ss * (1.f / 1024.f) + EPS);
#pragma unroll
                for (int i = 0; i < 4; ++i) { const int c = lane * 4 + i * 256; const f32x4 gg = *(const f32x4*)(h_g_final + c); const f32x4 xx = v[rr][i];
                    f32x4 o = {xx.x * rs * gg.x, xx.y * rs * gg.y, xx.z * rs * gg.z, xx.w * rs * gg.w}; __builtin_nontemporal_store(o, (f32x4*)(h_out + (size_t)T * D + c)); }
            }
        }
    }
}

DI void rope_pair(float& x1, float& x2, const f32x2 cs) { const float a = x1 * cs.x - x2 * cs.y, b = x2 * cs.x + x1 * cs.y; x1 = a; x2 = b; }
template <int WM>
DI void epi_win(KPR p, int l, f32x16 (&acc)[WM][2], int tok0, int cb, int r, int h) {
#pragma unroll
    for (int i = 0; i < WM; ++i) {
        __builtin_amdgcn_sched_barrier(0);
        const int T = tok0 + i * 32 + r; const bool den = T >= NCTX;
        int b, s; if (!den) { b = T >> 8; s = T & 255; } else { b = (T - NCTX) >> 11; s = (T - NCTX) & 2047; }
        if (cb < 640) {
            float ss = sumsq16(acc[i][0]) + sumsq16(acc[i][1]); ss += __shfl_xor(ss, 32);
            if (cb < 384) {
                bf16_t* dst = p.cq + (size_t)T * 384 + cb; st_bf16_tile(dst, acc[i][0], h); st_bf16_tile(dst + 32, acc[i][1], h);
                if (h == 0) p.ssq_q[T * 6 + (cb >> 6)] = ss;
            } else {
                const int c0 = cb - 384; bf16_t* dst = p.ckv + (size_t)T * 256 + c0; st_bf16_tile(dst, acc[i][0], h); st_bf16_tile(dst + 32, acc[i][1], h);
                if (h == 0) p.ssq_kv[T * 4 + (c0 >> 6)] = ss;
                if (!den) { float* o = p.out + OFF_CKV + ((size_t)((b * 2 + l) * 256 + s)) * 256 + c0; st_f32_tile(o, acc[i][0], h); st_f32_tile(o + 32, acc[i][1], h); }
            }
        } else if (cb < 1152) {
            float ss = sumsq16(acc[i][0]) + sumsq16(acc[i][1]); ss += __shfl_xor(ss, 32);
            const float rs = rsqrtf(ss * (1.f / 64.f) + EPS);
            const bool isq = cb < 1024;
            const float* g = (isq ? p.g_q_head : p.g_k_head) + l * 64;
            const int hk = (cb - 1024) >> 6;
            float* o32 = p.out + OFF_GK + ((size_t)(((b * 2 + l) * 256 + s) * 2 + hk)) * 64;
            bf16_t* dst = isq ? p.gq + (size_t)T * 384 + (cb - 640)
                              : (den ? p.kgqa_den + ((size_t)((l * 2 + b) * 2304 + 256 + s) * 2 + hk) * 64 : p.kgqa_ctx + ((size_t)(b * 256 + s) * 2 + hk) * 64);
            const float qs = isq ? 0.125f * LOG2E : 1.f;
#pragma unroll
            for (int q = 0; q < 4; ++q) {
                const int d0 = 8 * q + 4 * h;
                const f32x4 g0 = *(const f32x4*)(g + d0), g1 = *(const f32x4*)(g + 32 + d0);
                float x1[4], x2[4];
#pragma unroll
                for (int z = 0; z < 4; ++z) { x1[z] = acc[i][0][4 * q + z] * rs * g0[z]; x2[z] = acc[i][1][4 * q + z] * rs * g1[z]; }
                if (!isq && !den) { f32x4 w0 = {x1[0], x1[1], x1[2], x1[3]}, w1 = {x2[0], x2[1], x2[2], x2[3]}; *(f32x4*)(o32 + d0) = w0; *(f32x4*)(o32 + 32 + d0) = w1; }
                if (den) {
                    const f32x4 ca = *(const f32x4*)(p.rope_g + s * 32 + d0), cb2 = *(const f32x4*)(p.rope_g + s * 32 + d0 + 2);
                    { f32x2 cs = {ca[0], ca[1]}; rope_pair(x1[0], x2[0], cs); } { f32x2 cs = {ca[2], ca[3]}; rope_pair(x1[1], x2[1], cs); }
                    { f32x2 cs = {cb2[0], cb2[1]}; rope_pair(x1[2], x2[2], cs); } { f32x2 cs = {cb2[2], cb2[3]}; rope_pair(x1[3], x2[3], cs); }
                }
                u32x2 w0, w1; w0.x = pk_bf16(x1[0] * qs, x1[1] * qs); w0.y = pk_bf16(x1[2] * qs, x1[3] * qs); w1.x = pk_bf16(x2[0] * qs, x2[1] * qs); w1.y = pk_bf16(x2[2] * qs, x2[3] * qs);
                *(u32x2*)(dst + d0) = w0; *(u32x2*)(dst + 32 + d0) = w1;
                __builtin_amdgcn_sched_barrier(0);
            }
        } else if (cb < 1280) {
            const int hk = (cb - 1152) >> 6;
            if (!den) {
                float* o = p.out + OFF_GV + ((size_t)(((b * 2 + l) * 256 + s) * 2 + hk)) * 64; st_f32_tile(o, acc[i][0], h); st_f32_tile(o + 32, acc[i][1], h);
                bf16_t* dst = p.vtgqa_ctx + ((size_t)(b * 2 + hk) * 64) * 256 + s; st_bf16_tile_T(dst, 256, acc[i][0], h); st_bf16_tile_T(dst + 32 * 256, 256, acc[i][1], h);
            } else {
                bf16_t* dst = p.vtgqa_den + ((size_t)((l * 2 + b) * 2 + hk) * 64) * 2304 + 256 + s; st_bf16_tile_T(dst, 2304, acc[i][0], h); st_bf16_tile_T(dst + 32 * 2304, 2304, acc[i][1], h);
            }
        } else if (cb < 1536) {
            bf16_t* dst = p.u + (size_t)T * 256 + (cb - 1280); st_bf16_tile(dst, acc[i][0], h); st_bf16_tile(dst + 32, acc[i][1], h);
        } else if (cb == 1536) {
            f32x16 v = acc[i][0];
            if (!den) {
                float* o = p.out + OFF_KROPE + ((size_t)((b * 2 + l) * 256 + s)) * 32; st_f32_tile(o, v, h);
                bf16_t* dst = p.kmla_ctx + ((size_t)(b * 256 + s) * 6) * 96 + 64;
#pragma unroll
                for (int hh = 0; hh < 6; ++hh) st_bf16_tile(dst + hh * 96, v, h);
            } else {
#pragma unroll
                for (int e = 0; e < 8; ++e) { const f32x2 cs = p.rope_m[s * 16 + crow(e, h)]; float x1 = v[e], x2 = v[e + 8]; rope_pair(x1, x2, cs); v[e] = x1; v[e + 8] = x2; }
                bf16_t* dst = p.kmla_den + ((size_t)((l * 2 + b) * 2304 + 256 + s) * 6) * 96 + 64;
#pragma unroll
                for (int hh = 0; hh < 6; ++hh) st_bf16_tile(dst + hh * 96, v, h);
            }
        }
    }
}

#ifndef TILEMAP
#define TILEMAP 0
#endif
#if TILEMAP == 0
#define FOR_TILES_32M(NT, mvar, nvar)                                                             \
    for (int _lid = (lbid() >> 3), mvar = 4 * (lbid() & 7) + (_lid & 3), nvar = _lid >> 2; _lid < 4 * (NT);     \
         _lid += (int)(gridDim.x >> 3), mvar = 4 * (lbid() & 7) + (_lid & 3), nvar = _lid >> 2)
#else
#define FOR_TILES_32M(NT, mvar, nvar)                                                             \
    for (int _lid = (lbid() & 31), mvar = 4 * (lbid() >> 5) + (_lid & 3), nvar = _lid >> 2; _lid < 4 * (NT);     \
         _lid += 32, mvar = 4 * (lbid() >> 5) + (_lid & 3), nvar = _lid >> 2)
#endif

struct EpiWin {
    static constexpr bool PERM = true, AFTER_DRAIN = false;
    KP pp; int l; const float* lrs; const float* lbias; const f32x2* ropeR; const f32x2* ropeC;
    DI void operator()(const pg8::f32x4 (&acc)[2][2][4][2], const pg8::Unit& u, int wr, int wc, int fr, int fq) const {
        struct { bf16_t *cq, *ckv, *gq, *u, *kgqa_den, *kgqa_ctx, *vtgqa_den, *vtgqa_ctx, *kmla_den, *kmla_ctx; float *ssq_q, *ssq_kv, *out; const float *g_q_head, *g_k_head; const f32x2* rope_m; } p;
        { KPR q = *pp; p.cq = q.cq; p.ckv = q.ckv; p.gq = q.gq; p.u = q.u; p.kgqa_den = q.kgqa_den; p.kgqa_ctx = q.kgqa_ctx; p.vtgqa_den = q.vtgqa_den; p.vtgqa_ctx = q.vtgqa_ctx;
          p.kmla_den = q.kmla_den; p.kmla_ctx = q.kmla_ctx; p.ssq_q = q.ssq_q; p.ssq_kv = q.ssq_kv; p.out = q.out; p.g_q_head = q.g_q_head; p.g_k_head = q.g_k_head; p.rope_m = q.rope_m; }
        const int cb = u.pn * 256 + wc * 64, d0 = 8 * fq;
        if (cb >= 1568) return;
#pragma unroll
        for (int ai = 0; ai < 2; ++ai)
#pragma unroll
            for (int m = 0; m < 4; ++m) {
                const int T = u.pm * 256 + ai * 128 + wr * 64 + m * 16 + fr; const bool den = T >= NCTX;
                int b, s; if (!den) { b = T >> 8; s = T & 255; } else { b = (T - NCTX) >> 11; s = (T - NCTX) & 2047; }
                float v[2][8];
#pragma unroll
                for (int bj = 0; bj < 2; ++bj)
#pragma unroll
                    for (int n = 0; n < 2; ++n)
#pragma unroll
                        for (int j = 0; j < 4; ++j) v[bj][4 * n + j] = acc[ai][bj][m][n][j];
                if (lrs) {
                    const float rs = lrs[ai * 128 + wr * 64 + m * 16 + fr];
#pragma unroll
                    for (int bj = 0; bj < 2; ++bj) {
                        const f32x4 b0 = *(const f32x4*)(lbias + bj * 128 + wc * 32 + d0), b1 = *(const f32x4*)(lbias + bj * 128 + wc * 32 + d0 + 4);
#pragma unroll
                        for (int z = 0; z < 4; ++z) { v[bj][z] = v[bj][z] * rs + b0[z]; v[bj][4 + z] = v[bj][4 + z] * rs + b1[z]; }
                    }
                }
                float ss = 0.f;
                if (cb < 1152) {
#pragma unroll
                    for (int bj = 0; bj < 2; ++bj)
#pragma unroll
                        for (int z = 0; z < 8; ++z) ss += v[bj][z] * v[bj][z];
                    ss += __shfl_xor(ss, 16); ss += __shfl_xor(ss, 32);
                }
                auto st8 = [&](bf16_t* dst, const float* x) { u32x4 w; w.x = pk_bf16(x[0], x[1]); w.y = pk_bf16(x[2], x[3]); w.z = pk_bf16(x[4], x[5]); w.w = pk_bf16(x[6], x[7]); *(u32x4*)dst = w; };
                auto st8f = [&](float* dst, const float* x) { f32x4 a = {x[0], x[1], x[2], x[3]}, c = {x[4], x[5], x[6], x[7]}; *(f32x4*)dst = a; *(f32x4*)(dst + 4) = c; };
                if (cb < 384) {
                    bf16_t* dst = p.cq + (size_t)T * 384 + cb + d0; st8(dst, v[0]); st8(dst + 32, v[1]);
                    if (fq == 0) p.ssq_q[T * 6 + (cb >> 6)] = ss;
                } else if (cb < 640) {
                    const int c0 = cb - 384; bf16_t* dst = p.ckv + (size_t)T * 256 + c0 + d0; st8(dst, v[0]); st8(dst + 32, v[1]);
                    if (fq == 0) p.ssq_kv[T * 4 + (c0 >> 6)] = ss;
                    if (!den) { float* o = p.out + OFF_CKV + ((size_t)((b * 2 + l) * 256 + s)) * 256 + c0 + d0; st8f(o, v[0]); st8f(o + 32, v[1]); }
                } else if (cb < 1152) {
                    const float rs = rsqrtf(ss * (1.f / 64.f) + EPS);
                    const bool isq = cb < 1024;
                    const float* g = (isq ? p.g_q_head : p.g_k_head) + l * 64 + d0;
                    const int hk = (cb - 1024) >> 6;
                    {
                        const f32x4 ga = *(const f32x4*)g, gb2 = *(const f32x4*)(g + 4), gc = *(const f32x4*)(g + 32), gd = *(const f32x4*)(g + 36);
#pragma unroll
                        for (int z = 0; z < 4; ++z) { v[0][z] *= rs * ga[z]; v[0][4 + z] *= rs * gb2[z]; v[1][z] *= rs * gc[z]; v[1][4 + z] *= rs * gd[z]; }
                    }
                    if (!isq && !den) { float* o = p.out + OFF_GK + ((size_t)(((b * 2 + l) * 256 + s) * 2 + hk)) * 64 + d0; st8f(o, v[0]); st8f(o + 32, v[1]); }
                    if (den) {
                        const f32x2* rp = (fq < 2 ? ropeR + (s >> 6) * 16 : ropeC + (s & 63) * 16) + (fq & 1) * 8;
#pragma unroll
                        for (int z = 0; z < 8; z += 2) { const f32x4 c2 = *(const f32x4*)(rp + z); { f32x2 cs = {c2[0], c2[1]}; rope_pair(v[0][z], v[1][z], cs); } { f32x2 cs = {c2[2], c2[3]}; rope_pair(v[0][z + 1], v[1][z + 1], cs); } }
                    }
                    if (isq) {
                        const float qs = 0.125f * LOG2E;
#pragma unroll
                        for (int z = 0; z < 8; ++z) { v[0][z] *= qs; v[1][z] *= qs; }
                        bf16_t* dst = p.gq + (size_t)T * 384 + (cb - 640) + d0; st8(dst, v[0]); st8(dst + 32, v[1]);
                    } else {
                        bf16_t* dst = (den ? p.kgqa_den + ((size_t)((l * 2 + b) * 2304 + 256 + s) * 2 + hk) * 64 : p.kgqa_ctx + ((size_t)(b * 256 + s) * 2 + hk) * 64) + d0;
                        st8(dst, v[0]); st8(dst + 32, v[1]);
                    }
                } else if (cb < 1280) {
                    const int hk = (cb - 1152) >> 6;
                    if (!den) { float* o = p.out + OFF_GV + ((size_t)(((b * 2 + l) * 256 + s) * 2 + hk)) * 64 + d0; st8f(o, v[0]); st8f(o + 32, v[1]); }
                    bf16_t* dst = den ? p.vtgqa_den + ((size_t)((l * 2 + b) * 2 + hk) * 64 + d0) * 2304 + 256 + s : p.vtgqa_ctx + ((size_t)(b * 2 + hk) * 64 + d0) * 256 + s;
                    const size_t ld = den ? 2304 : 256;
#pragma unroll
                    for (int bj = 0; bj < 2; ++bj)
#pragma unroll
                        for (int z = 0; z < 8; ++z) dst[(size_t)(32 * bj + z) * ld] = to_bf16(v[bj][z]);
                } else if (cb < 1536) {
                    bf16_t* dst = p.u + (size_t)T * 256 + (cb - 1280) + d0; st8(dst, v[0]); st8(dst + 32, v[1]);
                } else {
                    if (!den) {
                        st8f(p.out + OFF_KROPE + ((size_t)((b * 2 + l) * 256 + s)) * 32 + d0, v[0]);
                    } else {
                        float xp[8];
#pragma unroll
                        for (int z = 0; z < 8; ++z) xp[z] = __shfl_xor(v[0][z], 32);
                        const int pbase = (fq & 1) * 8;
                        const f32x2* rp = p.rope_m + s * 16 + pbase;
#pragma unroll
                        for (int z = 0; z < 8; ++z) { const f32x2 cs = rp[z]; v[0][z] = fq < 2 ? v[0][z] * cs.x - xp[z] * cs.y : v[0][z] * cs.x + xp[z] * cs.y; }
                    }
                    bf16_t* dst = (den ? p.kmla_den + ((size_t)((l * 2 + b) * 2304 + 256 + s) * 6) * 96 : p.kmla_ctx + ((size_t)(b * 256 + s) * 6) * 96) + 64 + d0;
#pragma unroll
                    for (int hh = 0; hh < 6; ++hh) st8(dst + hh * 96, v[0]);
                }
            }
    }
};
DI void phase_win(KPR p, KP pp, int l, char* lds) {
    pg8::Gemm g; g.A = p.h; g.Bt = p.wt_in + l * SZ_WIN; g.M = NTOK; g.N = NINP; g.K = D;
    pg8::XcdOrder S; S.nN = 7; S.x = lbid() & 7; S.j = lbid() >> 3; S.step = (int)(gridDim.x >> 3);
    EpiWin E; E.pp = pp; E.l = l; E.lrs = nullptr; E.lbias = nullptr;
    {
        f32x2* rR = (f32x2*)(lds + 131072 + 2048); f32x2* rC = rR + 512;
        for (int i = ltid(); i < 1536; i += 512) { if (i < 512) rR[i] = p.rope_g[(size_t)((i >> 4) * 64) * 32 + (i & 15)]; else { const int q = i - 512; rC[q] = p.rope_g[(size_t)(q >> 4) * 32 + 16 + (q & 15)]; } }
        E.ropeR = rR; E.ropeC = rC;
        if (l != 1) __syncthreads();
    }
    if (l == 1) {
        float* lrs = (float*)(lds + 131072); float* lbias = lrs + 256;
        const int tid = ltid(), pm = 4 * S.x + (S.j & 3), jmod = pm < 16 ? 0 : 1 + ((pm - 16) >> 3);
        if (tid < 256) {
            const float* sp = p.ssq_x + (size_t)(pm * 256 + tid) * 8; const f32x4 a = *(const f32x4*)sp, b = *(const f32x4*)(sp + 4);
            lrs[tid] = rsqrtf((((a.x + a.y) + (a.z + a.w)) + ((b.x + b.y) + (b.z + b.w))) * (1.f / 1024.f) + EPS);
        } else if (S.j < 28) lbias[tid - 256] = p.bias_in[(size_t)jmod * 1792 + (S.j >> 2) * 256 + (tid - 256)];
        __syncthreads();
        E.lrs = lrs; E.lbias = lbias;
    }
    pg8::gemm_phase<EpiWin, pg8::XcdOrder>((PG8_LAS unsigned char*)lds, g, S, E, nullptr);
    __syncthreads();
}

DI void phase_mid(KPR p, int l, char* lds, bool rep = false) {
    float* h_ssq_q = p.ssq_q;
    float* h_ssq_kv = p.ssq_kv;
    f32x2* h_rope_m = p.rope_m;
    bf16_t* h_qmla = p.qmla;
    bf16_t* h_kmla_ctx = p.kmla_ctx;
    bf16_t* h_kmla_den = p.kmla_den;
    bf16_t* h_vtmla_ctx = p.vtmla_ctx;
    bf16_t* h_vtmla_den = p.vtmla_den;
    bf16_t* h_zt_ctx = p.zt_ctx;
    bf16_t* h_zt_den = p.zt_den;
    float* h_out = p.out;
    const float* h_g_kv_a = p.g_kv_a;
    bf16_t* h_ckv = p.ckv;
    bf16_t* h_ckv_cache = p.ckv_cache;
    bf16_t* h_wt_kvg = p.wt_kvg;
    bf16_t* h_wt_kvp = p.wt_kvp;
    bf16_t* h_cq = p.cq;
    bf16_t* h_wt_qup = p.wt_qup;
    bf16_t* h_u = p.u;
    bf16_t* h_bt_ch = p.bt_ch;

    const int tid = ltid(), lane = tid & 63, wid = tid >> 6, wr = wid >> 1, wc = wid & 1, r = lane & 31, h = lane >> 5;
    for (int t = lbid(); t < 492; t += gridDim.x) {
        f32x16 acc[2][2];
        if (t < 160) {
            const int m = t / 5, n = t % 5;
            gemm_tile3<2>(h_cq + (size_t)m * 256 * 384, 384, h_wt_qup + l * SZ_QUP + (size_t)n * 128 * 384, 384, 384, lds, acc);
            const int cb = n * 128 + wc * 64;
#pragma unroll
            for (int i = 0; i < 2; ++i) {
                const int T = m * 256 + wr * 64 + i * 32 + r; const bool den = T >= NCTX; const int s = (T - NCTX) & 2047;
                float ss = 0.f;
#pragma unroll
                for (int k = 0; k < 6; ++k) ss += h_ssq_q[T * 6 + k];
                const float rs = rsqrtf(ss * (1.f / 384.f) + EPS) * (0.10206207261596575f * LOG2E);
#pragma unroll
                for (int j = 0; j < 2; ++j) {
                    const int ct = (cb >> 5) + j; if (ct >= 18) continue;
                    f32x16 v;
#pragma unroll
                    for (int e = 0; e < 16; ++e) v[e] = acc[i][j][e] * rs;
                    if ((ct % 3) == 2 && den) {
#pragma unroll
                        for (int e = 0; e < 8; ++e) { const f32x2 cs = h_rope_m[s * 16 + crow(e, h)]; float x1 = v[e], x2 = v[e + 8]; rope_pair(x1, x2, cs); v[e] = x1; v[e + 8] = x2; }
                    }
                    st_bf16_tile(h_qmla + (size_t)T * 576 + ct * 32, v, h);
                }
            }
        } else if (t < 364) {
            const int tt = t - 160, mt = tt / 6, hd = tt % 6;
            const bf16_t* A; const bf16_t* W; int kind, b = 0, s0 = 0, T0 = 0;
            if (mt < 32) { T0 = mt * 256; A = h_ckv + (size_t)T0 * 256; W = h_wt_kvg; kind = mt < 16 ? 0 : 1; if (kind == 0) { b = T0 >> 8; s0 = 0; } else { b = (T0 - NCTX) >> 11; s0 = 256 + ((T0 - NCTX) & 2047); } }
            else { b = mt - 32; s0 = 0; A = h_ckv_cache + ((size_t)(b * 2 + l) * 256) * 256; W = h_wt_kvp; kind = 2; }
            if (wc == 1) gemm_tile3<2, true>(A, 256, W + l * SZ_KV + (size_t)hd * 128 * 256, 256, 256, lds, acc);
            else gemm_tile3<2, false>(A, 256, W + l * SZ_KV + (size_t)hd * 128 * 256, 256, 256, lds, acc);
#pragma unroll
            for (int i = 0; i < 2; ++i) {
                const int ro = wr * 64 + i * 32 + r; float rs = 1.f;
                if (kind < 2) { const int T = T0 + ro; const float ss = h_ssq_kv[T * 4] + h_ssq_kv[T * 4 + 1] + h_ssq_kv[T * 4 + 2] + h_ssq_kv[T * 4 + 3]; rs = rsqrtf(ss * (1.f / 256.f) + EPS); }
                const int key = s0 + ro;
                f32x16 v0, v1;
                if (wc == 0) {
#pragma unroll
                    for (int e = 0; e < 16; ++e) { v0[e] = acc[i][0][e] * rs; v1[e] = acc[i][1][e] * rs; }
                    bf16_t* dst = kind == 0 ? h_kmla_ctx + ((size_t)(b * 256 + key) * 6 + hd) * 96 : h_kmla_den + ((size_t)((l * 2 + b) * 2304 + key) * 6 + hd) * 96;
                    st_bf16_tile(dst, v0, h); st_bf16_tile(dst + 32, v1, h);
                } else {
#pragma unroll
                    for (int e = 0; e < 16; ++e) { const float rse = __shfl(rs, crow(e, h)); v0[e] = acc[i][0][e] * rse; v1[e] = acc[i][1][e] * rse; }
                    const int kb = s0 + wr * 64 + i * 32;
                    if (kind == 0) { bf16_t* dst = h_vtmla_ctx + ((size_t)(b * 6 + hd) * 64 + r) * 256 + kb; st_bf16_tile_S(dst, v0, h); st_bf16_tile_S(dst + 32 * 256, v1, h); }
                    else { bf16_t* dst = h_vtmla_den + ((size_t)((l * 2 + b) * 6 + hd) * 64 + r) * 2304 + kb; st_bf16_tile_S(dst, v0, h); st_bf16_tile_S(dst + 32 * 2304, v1, h); }
                }
            }
        } else {
            const int tt = t - 364, m = tt >> 2, g = tt & 3;
            gemm_tile3<2, true>(h_u + (size_t)m * 256 * 256 + g * 64, 256, h_bt_ch, 64, 64, lds, acc);
#pragma unroll
            for (int i = 0; i < 2; ++i) {
                const int T = m * 256 + wr * 64 + i * 32; const bool den = T >= NCTX;
#pragma unroll
                for (int j = 0; j < 2; ++j) {
                    const int c = g * 64 + j * 32 + r;
                    if (!den) { const int b = T >> 8, s = T & 255; st_bf16_tile_S(h_zt_ctx + ((size_t)(b * 256 + c)) * 512 + wc * 256 + s, acc[i][j], h); }
                    else { const int b = (T - NCTX) >> 11, s = (T - NCTX) & 2047; st_bf16_tile_S(h_zt_den + ((size_t)(b * 256 + c)) * 4096 + wc * 2048 + s, acc[i][j], h); }
                }
            }
        }
    }
    if (!rep)
    for (int i = lbid() * 512 + tid; i < NCTX * 64; i += gridDim.x * 512) {
        const int T = i >> 6, c = (i & 63) * 4, b = T >> 8, s = T & 255;
        const float ss = h_ssq_kv[T * 4] + h_ssq_kv[T * 4 + 1] + h_ssq_kv[T * 4 + 2] + h_ssq_kv[T * 4 + 3]; const float rs = rsqrtf(ss * (1.f / 256.f) + EPS);
        float* o = h_out + OFF_CKV + ((size_t)((b * 2 + l) * 256 + s)) * 256 + c; f32x4 v = *(f32x4*)o; const f32x4 g = *(const f32x4*)(h_g_kv_a + l * 256 + c);
        v.x *= rs * g.x; v.y *= rs * g.y; v.z *= rs * g.z; v.w *= rs * g.w; *(f32x4*)o = v;
    }
}

template <int DQK>
DI void attn_item(const bf16_t* __restrict__ Q, int ldq, const bf16_t* __restrict__ Kp, int ldk, const bf16_t* __restrict__ Vt, int ldv, int Sk, bf16_t* O, int ldo, char* lds) {
    constexpr int KSTR = DQK * 2 + 16, VSTR = 136, KBYTES = 64 * KSTR, STAGE = KBYTES + 64 * VSTR, KCH = DQK / 8;
    int tid = ltid();
    const int lane = tid & 63, w = tid >> 6, r = lane & 31, h = lane >> 5;
    bf16x8 qf[DQK / 16];
#pragma unroll
    for (int ks = 0; ks < DQK / 16; ++ks) qf[ks] = *(const bf16x8*)(Q + (size_t)(w * 32 + r) * ldq + ks * 16 + h * 8);
    f32x16 oacc[2];
#pragma unroll
    for (int e = 0; e < 16; ++e) { oacc[0][e] = 0.f; oacc[1][e] = 0.f; }
    float mrun = -INFINITY, lrun = 0.f;
    u32x4 rk[2], rv;
    const bool k2 = (DQK == 96) && tid < 256;
    const int kr0 = tid / KCH, kc0 = tid % KCH, kr1 = (tid + 512) / KCH, kc1 = (tid + 512) % KCH;
    const int vrow = tid >> 3, vch = tid & 7;
    auto gload = [&](int kt) {
        rk[0] = *(const u32x4*)(Kp + (size_t)(kt * 64 + kr0) * ldk + kc0 * 8);
        if (k2) rk[1] = *(const u32x4*)(Kp + (size_t)(kt * 64 + kr1) * ldk + kc1 * 8);
        rv = *(const u32x4*)(Vt + (size_t)vrow * ldv + kt * 64 + vch * 8);
    };
    auto lstore = [&](int buf) {
        char* base = lds + buf * STAGE;
        *(u32x4*)(base + kr0 * KSTR + kc0 * 16) = rk[0];
        if (k2) *(u32x4*)(base + kr1 * KSTR + kc1 * 16) = rk[1];
        char* d = base + KBYTES + vrow * VSTR + vch * 16; u32x2 lo = {rv.x, rv.y}, hi = {rv.z, rv.w}; *(u32x2*)d = lo; *(u32x2*)(d + 8) = hi;
    };
    gload(0); lstore(0); __syncthreads();
    const int nkt = Sk >> 6;
    for (int kt = 0; kt < nkt; ++kt) {
        const char* kb = lds + (kt & 1) * STAGE; const char* vb = kb + KBYTES;
        if (kt + 1 < nkt) gload(kt + 1);
        f32x16 sacc[2];
        {
            bf16x8 kf[2][DQK / 16];
#pragma unroll
            for (int sub = 0; sub < 2; ++sub)
#pragma unroll
                for (int ks = 0; ks < DQK / 16; ++ks) kf[sub][ks] = *(const bf16x8*)(kb + (sub * 32 + r) * KSTR + (ks * 2 + h) * 16);
            __builtin_amdgcn_s_setprio(1);
#pragma unroll
            for (int sub = 0; sub < 2; ++sub) {
#pragma unroll
                for (int e = 0; e < 16; ++e) sacc[sub][e] = 0.f;
#pragma unroll
                for (int ks = 0; ks < DQK / 16; ++ks) sacc[sub] = MFMA(kf[sub][ks], qf[ks], sacc[sub]);
            }
        }
        __builtin_amdgcn_s_setprio(0);
        __builtin_amdgcn_sched_barrier(0);
        s16x4 vlo[2][4], vhi[2][4];
#pragma unroll
        for (int g = 0; g < 4; ++g)
#pragma unroll
            for (int dvt = 0; dvt < 2; ++dvt) {
                const char* va = vb + (dvt * 32 + r) * VSTR + (g * 16 + 4 * h) * 2;
                vlo[dvt][g] = *(const s16x4*)va; vhi[dvt][g] = *(const s16x4*)(va + 16);
            }
        float mx;
        {
            float m0 = fmaxf(fmaxf(sacc[0][0], sacc[0][1]), sacc[0][2]), m1 = fmaxf(fmaxf(sacc[1][0], sacc[1][1]), sacc[1][2]);
#pragma unroll
            for (int e = 3; e < 15; e += 2) { m0 = fmaxf(fmaxf(m0, sacc[0][e]), sacc[0][e + 1]); m1 = fmaxf(fmaxf(m1, sacc[1][e]), sacc[1][e + 1]); }
            mx = fmaxf(fmaxf(m0, m1), fmaxf(sacc[0][15], sacc[1][15]));
        }
        mx = fmaxf(mx, __shfl_xor(mx, 32));
        if (__builtin_amdgcn_ballot_w64(mx - mrun > 64.f) != 0ull) {
            const float mnew = fmaxf(mrun, mx);
            const float alpha = __builtin_amdgcn_exp2f(mrun - mnew);
            mrun = mnew; lrun *= alpha;
#pragma unroll
            for (int e = 0; e < 16; ++e) { oacc[0][e] *= alpha; oacc[1][e] *= alpha; }
        }
        {
            const f32x2 mm = {mrun, mrun}; f32x2 ps = {0.f, 0.f};
#pragma unroll
            for (int sub = 0; sub < 2; ++sub)
#pragma unroll
                for (int e = 0; e < 16; e += 2) {
                    f32x2 d = {sacc[sub][e], sacc[sub][e + 1]}; d = d - mm;
                    f32x2 pv = {__builtin_amdgcn_exp2f(d.x), __builtin_amdgcn_exp2f(d.y)};
                    sacc[sub][e] = pv.x; sacc[sub][e + 1] = pv.y; ps = ps + pv;
                }
            lrun += ps.x + ps.y;
        }
#pragma unroll
        for (int sub = 0; sub < 2; ++sub)
#pragma unroll
            for (int s2 = 0; s2 < 2; ++s2) {
                u32x4 pw; pw.x = pk_bf16(sacc[sub][8 * s2 + 0], sacc[sub][8 * s2 + 1]); pw.y = pk_bf16(sacc[sub][8 * s2 + 2], sacc[sub][8 * s2 + 3]);
                pw.z = pk_bf16(sacc[sub][8 * s2 + 4], sacc[sub][8 * s2 + 5]); pw.w = pk_bf16(sacc[sub][8 * s2 + 6], sacc[sub][8 * s2 + 7]);
                const bf16x8 pf = __builtin_bit_cast(bf16x8, pw);
#pragma unroll
                for (int dvt = 0; dvt < 2; ++dvt) {
                    const bf16x8 vf = __builtin_shufflevector(vlo[dvt][sub * 2 + s2], vhi[dvt][sub * 2 + s2], 0, 1, 2, 3, 4, 5, 6, 7);
                    oacc[dvt] = MFMA(vf, pf, oacc[dvt]);
                }
            }
        __builtin_amdgcn_sched_barrier(0);
        if (kt + 1 < nkt) lstore((kt + 1) & 1);
        __syncthreads();
    }
    lrun += __shfl_xor(lrun, 32);
    const float inv = 1.f / lrun;
#pragma unroll
    for (int dvt = 0; dvt < 2; ++dvt) {
        f32x16 v;
#pragma unroll
        for (int e = 0; e < 16; ++e) v[e] = oacc[dvt][e] * inv;
        st_bf16_tile(O + (size_t)(w * 32 + r) * ldo + dvt * 32, v, h);
    }
}

DI void phase_mix(KPR p, int l, char* lds, unsigned* ctr) {
    const int tid = ltid(), lane = tid & 63, wid = tid >> 6, wr = wid >> 1, wc = wid & 1, r = lane & 31, h = lane >> 5;
    __shared__ unsigned sitem_s; volatile unsigned* sitem = &sitem_s;
    for (;;) {
        __syncthreads();
        if (tid == 0) *sitem = atomicAdd(ctr, 1u);
        __syncthreads();
        const int it = (int)*sitem;
        if (it >= 480) break;
        if (it < 64) {
            f32x16 acc[1][2];
            const int b = it >> 5, m = (it >> 2) & 7, n = it & 3;
            gemm_tile3<1>(p.tab2048 + (size_t)m * 256 * 4096, 4096, p.zt_den + ((size_t)(b * 256 + n * 64)) * 4096, 4096, 4096, lds, acc);
            const int T = NCTX + b * 2048 + m * 256 + wid * 32 + r;
            bf16_t* dst = p.mix + (size_t)T * D + 384 + n * 64;
            st_bf16_tile(dst, acc[0][0], h); st_bf16_tile(dst + 32, acc[0][1], h);
        } else if (it >= 256 && it < 288) {
            f32x16 acc[2][2];
            const int q = it - 256, b = q >> 1, n = q & 1;
            gemm_tile3<2>(p.tab256, 512, p.zt_ctx + ((size_t)(b * 256 + n * 128)) * 512, 512, 512, lds, acc);
#pragma unroll
            for (int i = 0; i < 2; ++i) {
                const int T = b * 256 + wr * 64 + i * 32 + r;
                bf16_t* dst = p.mix + (size_t)T * D + 384 + n * 128 + wc * 64;
                st_bf16_tile(dst, acc[i][0], h); st_bf16_tile(dst + 32, acc[i][1], h);
            }
        } else {
            int b, hd, qb, den;
            if (it < 256) { const int q = it - 64; den = 1; qb = q & 7; hd = (q >> 3) % 12; b = q / 96; } else { const int q = it - 288; den = 0; qb = 0; hd = q % 12; b = q / 12; }
            const int T0 = den ? NCTX + b * 2048 + qb * 256 : b * 256;
            const int Sk = den ? 2304 : 256;
            if (hd < 6) {
                const bf16_t* K = den ? p.kmla_den + ((size_t)(l * 2 + b) * 2304 * 6 + hd) * 96 : p.kmla_ctx + ((size_t)b * 256 * 6 + hd) * 96;
                const bf16_t* V = den ? p.vtmla_den + ((size_t)((l * 2 + b) * 6 + hd) * 64) * 2304 : p.vtmla_ctx + ((size_t)(b * 6 + hd) * 64) * 256;
                attn_item<96>(p.qmla + (size_t)T0 * 576 + hd * 96, 576, K, 576, V, Sk, Sk, p.mix + (size_t)T0 * D + hd * 64, D, lds);
            } else {
                const int hq = hd - 6, hk = hq / 3;
                const bf16_t* K = den ? p.kgqa_den + ((size_t)(l * 2 + b) * 2304 * 2 + hk) * 64 : p.kgqa_ctx + ((size_t)b * 256 * 2 + hk) * 64;
                const bf16_t* V = den ? p.vtgqa_den + ((size_t)((l * 2 + b) * 2 + hk) * 64) * 2304 : p.vtgqa_ctx + ((size_t)(b * 2 + hk) * 64) * 256;
                attn_item<64>(p.gq + (size_t)T0 * 384 + hq * 64, 384, K, 128, V, Sk, Sk, p.mix + (size_t)T0 * D + 640 + hq * 64, D, lds);
            }
        }
    }
}

DI void phase_resid(KPR p, const bf16_t* A, int K, const bf16_t* W, const float* xc, const float* xd, float* xout, const float* gate, const float* gs_g, const float* gs_scale, char* lds) {
    bf16_t* h_h = p.h;
    float* h_ssq_x = p.ssq_x;

    const int tid = ltid(), lane = tid & 63, wid = tid >> 6, wr = wid >> 1, wc = wid & 1, r = lane & 31, h = lane >> 5;
    const int col4 = (tid & 31) * 4, row0 = tid >> 5;
    float* ft = (float*)lds;
    FOR_TILES_32M(8, m, n) {
        f32x16 acc[2][2];
        const int Tt = m * 256;
        const float* xbase = (Tt < NCTX ? xc + (size_t)Tt * D : xd + (size_t)(Tt - NCTX) * D) + n * 128 + col4;
        const float* gj = gate + (Tt < NCTX ? 0 : 1 + ((Tt - NCTX) >> 11)) * 6144 + n * 128 + col4;
        f32x4 xpre[16];
#pragma unroll
        for (int k = 0; k < 16; ++k) xpre[k] = __builtin_nontemporal_load((const f32x4*)(xbase + (size_t)(row0 + 16 * k) * D));
        gemm_tile3<2>(A + (size_t)m * 256 * K, K, W + (size_t)n * 128 * K, K, K, lds, acc);
#pragma unroll
        for (int i = 0; i < 2; ++i)
#pragma unroll
            for (int j = 0; j < 2; ++j)
#pragma unroll
                for (int q = 0; q < 4; ++q) {
                    f32x4 v = {acc[i][j][4 * q], acc[i][j][4 * q + 1], acc[i][j][4 * q + 2], acc[i][j][4 * q + 3]};
                    *(f32x4*)(ft + (wr * 64 + i * 32 + r) * 132 + wc * 64 + j * 32 + 8 * q + 4 * h) = v;
                }
        __syncthreads();
        const f32x4 gv = *(const f32x4*)gj;
        float* obase = xout + (size_t)Tt * D + n * 128 + col4;
        f32x4 gsv = {0.f, 0.f, 0.f, 0.f};
        if (gs_g) { const f32x4 gg = *(const f32x4*)(gs_g + n * 128 + col4), sc = *(const f32x4*)(gs_scale + (gj - gate) ); gsv = (f32x4){gg.x * (1.f + sc.x), gg.y * (1.f + sc.y), gg.z * (1.f + sc.z), gg.w * (1.f + sc.w)}; }
#pragma unroll
        for (int k = 0; k < 16; ++k) {
            const int row = row0 + 16 * k;
            const f32x4 v = *(const f32x4*)(ft + row * 132 + col4), xv = xpre[k];
            f32x4 o = {xv.x + gv.x * v.x, xv.y + gv.y * v.y, xv.z + gv.z * v.z, xv.w + gv.w * v.w};
            *(f32x4*)(obase + (size_t)row * D) = o;
            if (gs_g) {
                u32x2 w; w.x = pk_bf16(o.x * gsv.x, o.y * gsv.y); w.y = pk_bf16(o.z * gsv.z, o.w * gsv.w);
                *(u32x2*)(h_h + (size_t)(Tt + row) * D + n * 128 + col4) = w;
                float ss = (o.x * o.x + o.y * o.y) + (o.z * o.z + o.w * o.w);
                ss += __shfl_xor(ss, 1); ss += __shfl_xor(ss, 2); ss += __shfl_xor(ss, 4); ss += __shfl_xor(ss, 8); ss += __shfl_xor(ss, 16);
                if ((tid & 31) == 0) h_ssq_x[(Tt + row) * 8 + n] = ss;
            }
        }
        __syncthreads();
    }
}
struct EpiGu {
    static constexpr bool PERM = false, AFTER_DRAIN = false;
    bf16_t* hid; const float* lrs; const float* lbias; int j;
    DI void operator()(const pg8::f32x4 (&acc)[2][2][4][2], const pg8::Unit& u, int wr, int wc, int fr, int fq) const {
        const int ui = (u.pn * 4 + (j & 3) - j) >> 5;
        const float* bi = lbias + ui * 256 + wc * 32 + fq * 4;
        pg8::f32x4 bv[2][2];
#pragma unroll
        for (int bj = 0; bj < 2; ++bj)
#pragma unroll
            for (int n = 0; n < 2; ++n) bv[bj][n] = *(const pg8::f32x4*)(bi + bj * 128 + n * 16);
#pragma unroll
        for (int ai = 0; ai < 2; ++ai)
#pragma unroll
            for (int m = 0; m < 4; ++m) {
                const int rl = ai * 128 + wr * 64 + m * 16 + fr;
                const int T = u.pm * 256 + rl;
                const float rs = lrs[rl];
#pragma unroll
                for (int bj = 0; bj < 2; ++bj) {
                    const int hc = u.pn * 128 + bj * 64 + wc * 16 + fq * 4;
                    const pg8::f32x4 g = acc[ai][bj][m][0] * rs + bv[bj][0], up = acc[ai][bj][m][1] * rs + bv[bj][1];
                    u32x2 w; w.x = pk_bf16(silu(g[0]) * up[0], silu(g[1]) * up[1]); w.y = pk_bf16(silu(g[2]) * up[2], silu(g[3]) * up[3]);
                    *(u32x2*)(hid + (size_t)T * DFF + hc) = w;
                }
            }
    }
};
DI void phase_gu(KPR p, int l, char* lds) {
    pg8::Gemm g; g.A = p.h; g.Bt = p.wt_gu + l * SZ_GU; g.M = NTOK; g.N = 5632; g.K = D;
    pg8::XcdOrder S; S.nN = 22; S.x = lbid() & 7; S.j = lbid() >> 3; S.step = (int)(gridDim.x >> 3);
    float* lrs = (float*)(lds + 131072); float* lbias = lrs + 256;
    {
        const int tid = ltid(), pm = 4 * S.x + (S.j & 3), jmod = pm < 16 ? 0 : 1 + ((pm - 16) >> 3);
        if (tid < 256) {
            const float* sp = p.ssq_x + (size_t)(pm * 256 + tid) * 8; const f32x4 a = *(const f32x4*)sp, b = *(const f32x4*)(sp + 4);
            lrs[tid] = rsqrtf((((a.x + a.y) + (a.z + a.w)) + ((b.x + b.y) + (b.z + b.w))) * (1.f / 1024.f) + EPS);
        } else {
            const int c = tid - 256;
#pragma unroll
            for (int i = 0; i < 3; ++i) { const int lid = S.j + i * S.step; if (lid < 88) lbias[i * 256 + c] = p.bias_gu[(size_t)(l * 3 + jmod) * 5632 + (lid >> 2) * 256 + c]; }
        }
        __syncthreads();
    }
    EpiGu E; E.hid = p.hid; E.lrs = lrs; E.lbias = lbias; E.j = S.j;
    pg8::gemm_phase<EpiGu, pg8::XcdOrder>((PG8_LAS unsigned char*)lds, g, S, E, nullptr);
    __syncthreads();
}

constexpr int NPHASE = 15;
template <int PM>
__global__ void __launch_bounds__(512, 2) fwd_megakernel(P p_arg) {
    KP kp0 = (KP)__builtin_amdgcn_kernarg_segment_ptr();
    __shared__ __attribute__((aligned(16))) char lds[147456];
    __shared__ uint4 xbw;
    if (kp0->never) cg::this_grid().sync();
    if (threadIdx.x == 0) xbw = make_uint4(0u, 0u, 0u, 0u);
    __syncthreads();
    XcdBarrier xb;
    if (!MULTI_LAUNCH) xb = xcd_barrier_post(kp0->bar, (volatile LAS unsigned*)&xbw);
    const int ph0 = kp0->ph0, ph1 = kp0->ph1;
    for (int ph = ph0; ph < ph1; ++ph) {
        KP kp = kp0; asm volatile("" : "+s"(kp));
        KPR p = *kp;
        if (ph == 0) { if (PM & 1) phase_prologue(p, lds); }
        else if (ph == 1) { if (PM & 4) phase_norm(p, p.x_prompt, p.x_sample, p.g_norm1, p.mod, 0, 1024, 0); }
        else if (ph == 14) { if (PM & 2) phase_final(p, p.xa); }
        else {
            const int l = (ph - 2) / 6, s = (ph - 2) % 6;
            const float* modl = p.mod + (size_t)l * 3 * 6144;
            const float* xc = l == 0 ? p.x_prompt : p.xa;
            const float* xd = l == 0 ? p.x_sample : p.xa + (size_t)NCTX * D;
            switch (s) {
                case 0: if (PM & 8) phase_win(p, kp, l, lds); break;
                case 1: if (PM & 16) phase_mid(p, l, lds); break;
                case 2: if (PM & 32) phase_mix(p, l, lds, p.ctr + 64 * l); break;
                case 3: if (PM & 64) phase_resid(p, p.mix, D, p.wt_out + l * SZ_WOUT, xc, xd, p.xb, modl + 2048, p.g_norm2 + l * D, modl + 4096, lds); break;
                case 4: if (PM & 128) phase_gu(p, l, lds); break;
                case 5: if (PM & 64) phase_resid(p, p.hid, DFF, p.wt_down + l * SZ_DOWN, p.xb, p.xb + (size_t)NCTX * D, p.xa, modl + 5120,
                                                 l == 0 ? p.g_norm1 + D : nullptr, p.mod + 3 * 6144 + 1024, lds); break;
            }
        }
        if (!MULTI_LAUNCH && ph + 1 < ph1) xcd_barrier(xb);
    }
}

extern "C" void kernel_launch(void* const* d_in, const int* in_sizes, int n_in, void* d_out, int out_size, void* d_ws, size_t ws_size, hipStream_t stream) {
    static int grid_blocks = 0;
    if (!grid_blocks) {
        int dev = 0, cus = 0, per_cu = 0;
        hipGetDevice(&dev);
        hipDeviceGetAttribute(&cus, hipDeviceAttributeMultiprocessorCount, dev);
        hipOccupancyMaxActiveBlocksPerMultiprocessor(&per_cu, fwd_megakernel<(MULTI_LAUNCH ? 32 : FUSEMASK)>, 512, 0);
        if (per_cu > 1) per_cu = 1;
        if (per_cu < 1) per_cu = 1;
        grid_blocks = cus * per_cu;
        grid_blocks &= ~7;
    }
    P p{};
    const float* const* in = (const float* const*)d_in;
    p.x_prompt = in[0]; p.x_sample = in[1]; p.c_ckv = in[2]; p.c_krope = in[3]; p.c_gk = in[4]; p.c_gv = in[5]; p.c = in[6]; p.c_ctx = in[7]; p.w_ada = in[8]; p.b_ada = in[9];
    p.g_norm1 = in[10]; p.g_norm2 = in[11]; p.w_in = in[12]; p.g_q_a = in[13]; p.w_q_up = in[14]; p.g_kv_a = in[15]; p.w_kv_up = in[16]; p.g_q_head = in[17]; p.g_k_head = in[18];
    p.w_out = in[19]; p.w_gate = in[20]; p.w_up = in[21]; p.w_down = in[22]; p.g_final = in[23];
    p.out = (float*)d_out;
    char* ws = (char*)d_ws; size_t off = 0;
    auto alloc = [&](size_t bytes) { char* r = ws + off; off += (bytes + 255) & ~(size_t)255; return r; };
    p.bar = (unsigned*)alloc(XCD_BAR_WORDS * 4); p.ctr = (unsigned*)alloc(1024); p.mod = (float*)alloc(2 * 3 * 6144 * 4);
    const size_t zero_bytes = off;
    p.wt_in = (bf16_t*)alloc(2 * SZ_WIN * 2); p.wt_qup = (bf16_t*)alloc(2 * SZ_QUP * 2); p.wt_kvg = (bf16_t*)alloc(2 * SZ_KV * 2); p.wt_kvp = (bf16_t*)alloc(2 * SZ_KV * 2);
    p.wt_out = (bf16_t*)alloc(2 * SZ_WOUT * 2); p.wt_gu = (bf16_t*)alloc(2 * SZ_GU * 2); p.wt_down = (bf16_t*)alloc(2 * SZ_DOWN * 2);
    p.tab2048 = (bf16_t*)alloc((size_t)2048 * 4096 * 2); p.tab256 = (bf16_t*)alloc(256 * 512 * 2); p.bt_ch = (bf16_t*)alloc(128 * 64 * 2);
    p.rope_g = (f32x2*)alloc(2048 * 32 * 8); p.rope_m = (f32x2*)alloc(2048 * 16 * 8);
    p.ckv_cache = (bf16_t*)alloc(2 * 2 * 256 * 256 * 2);
    p.h = (bf16_t*)alloc((size_t)NTOK * D * 2);
    p.ssq_q = (float*)alloc(NTOK * 6 * 4); p.ssq_kv = (float*)alloc(NTOK * 4 * 4); p.ssq_x = (float*)alloc(NTOK * 16 * 4); p.bias_gu = (float*)alloc(2 * 3 * 5632 * 4); p.bias_in = (float*)alloc(3 * 1792 * 4);
    p.xa = (float*)alloc((size_t)NTOK * D * 4); p.xb = (float*)alloc((size_t)NTOK * D * 4);
    p.kmla_ctx = (bf16_t*)alloc((size_t)16 * 256 * 576 * 2); p.vtmla_ctx = (bf16_t*)alloc((size_t)16 * 6 * 64 * 256 * 2);
    p.kgqa_ctx = (bf16_t*)alloc((size_t)16 * 256 * 128 * 2); p.vtgqa_ctx = (bf16_t*)alloc((size_t)16 * 2 * 64 * 256 * 2);
    p.kmla_den = (bf16_t*)alloc((size_t)4 * 2304 * 576 * 2); p.vtmla_den = (bf16_t*)alloc((size_t)4 * 6 * 64 * 2304 * 2);
    p.kgqa_den = (bf16_t*)alloc((size_t)4 * 2304 * 128 * 2); p.vtgqa_den = (bf16_t*)alloc((size_t)4 * 2 * 64 * 2304 * 2);
    p.zt_ctx = (bf16_t*)alloc((size_t)16 * 256 * 512 * 2); p.zt_den = (bf16_t*)alloc((size_t)2 * 256 * 4096 * 2);
    const size_t ov = off;
    p.cq = (bf16_t*)alloc((size_t)NTOK * 384 * 2); p.ckv = (bf16_t*)alloc((size_t)NTOK * 256 * 2); p.u = (bf16_t*)alloc((size_t)NTOK * 256 * 2);
    p.gq = (bf16_t*)alloc((size_t)NTOK * 384 * 2); p.qmla = (bf16_t*)alloc((size_t)NTOK * 576 * 2); p.mix = (bf16_t*)alloc((size_t)NTOK * D * 2);
    p.hid = (bf16_t*)(ws + ov);
    if (off - ov < (size_t)NTOK * DFF * 2) off = ov + (size_t)NTOK * DFF * 2;
    if (off > ws_size) { fprintf(stderr, "workspace too small: need %zu have %zu\n", off, ws_size); return; }
    hipMemsetAsync(ws, 0, zero_bytes, stream);
#if MULTI_LAUNCH
    for (int ph = 0; ph < NPHASE; ++ph) {
        P q = p; q.ph0 = ph; q.ph1 = ph + 1;
        const int s = (ph - 1) & 7;
        if (ph == 0) hipLaunchKernelGGL(fwd_megakernel<1>, dim3(grid_blocks), dim3(512), 0, stream, q);
        else if (ph == 17) hipLaunchKernelGGL(fwd_megakernel<2>, dim3(grid_blocks), dim3(512), 0, stream, q);
        else if (s == 0 || s == 5) hipLaunchKernelGGL(fwd_megakernel<4>, dim3(grid_blocks), dim3(512), 0, stream, q);
        else if (s == 1) hipLaunchKernelGGL(fwd_megakernel<8>, dim3(grid_blocks), dim3(512), 0, stream, q);
        else if (s == 2) hipLaunchKernelGGL(fwd_megakernel<16>, dim3(grid_blocks), dim3(512), 0, stream, q);
        else if (s == 3) hipLaunchKernelGGL(fwd_megakernel<32>, dim3(grid_blocks), dim3(512), 0, stream, q);
        else if (s == 4 || s == 7) hipLaunchKernelGGL(fwd_megakernel<64>, dim3(grid_blocks), dim3(512), 0, stream, q);
        else hipLaunchKernelGGL(fwd_megakernel<128>, dim3(grid_blocks), dim3(512), 0, stream, q);
    }
#else
    p.ph0 = 0; p.ph1 = NPHASE;
    void* args[] = {&p};
    hipError_t e = hipLaunchCooperativeKernel((void*)fwd_megakernel<FUSEMASK>, dim3(grid_blocks), dim3(512), args, 0, stream);
    if (e != hipSuccess) fprintf(stderr, "cooperative launch failed: %s (grid %d)\n", hipGetErrorString(e), grid_blocks);
#endif
}
```
